# Optimizing an MI355X kernel written in HIP

```python
import math
import jax
import jax.numpy as jnp
from jax import lax
import numpy as np

D_MODEL = 1024
BATCH = 8
SEQ = 8192
DEPTH = 1
DEC_BATCH = 128
DEC_SEQ = 4
PAST_LEN = 8192
PAGE_SIZE = 128

HEAD_DIM = 128
HEADS_PER_GROUP = 4
GROUP_WINDOWS = (128, 512, 2048)
GROUP_DILATIONS = (1, 4, 16)
N_GROUPS = 3
N_HEADS_A = N_GROUPS * HEADS_PER_GROUP
ATT_WIDTH = N_HEADS_A * HEAD_DIM
MERGE_WIDTH = HEADS_PER_GROUP * HEAD_DIM
ATT_SCALE = HEAD_DIM ** -0.5
LRU_WIDTH = D_MODEL
LRU_BLOCKS = 16
LRU_BLOCK = LRU_WIDTH // LRU_BLOCKS
CONV_WIDTH = 4
RG_C = 8.0
D_FF = 4 * D_MODEL
PLE_DIM = 256
REL_BUCKETS = 32
REL_MAX_DIST = 2048
NORM_EPS = 1e-6
NEG_INF = -1e30
SPLITS = (ATT_WIDTH, 2 * ATT_WIDTH, 3 * ATT_WIDTH, 3 * ATT_WIDTH + LRU_WIDTH,
          3 * ATT_WIDTH + 2 * LRU_WIDTH, 3 * ATT_WIDTH + 2 * LRU_WIDTH + D_MODEL)
IN_WIDTH = 3 * ATT_WIDTH + 2 * LRU_WIDTH + 2 * D_MODEL

kernel_name = 'dilated_swa_rglru_hybrid_step'


def _rms_norm(x, gain):
    x32 = x.astype(jnp.float32)
    y = x32 * lax.rsqrt(jnp.mean(x32 * x32, axis=-1, keepdims=True) + NORM_EPS)
    return (y * gain.astype(jnp.float32)).astype(x.dtype)


def _softmax_lse(logits):
    m = jnp.max(logits, axis=-1, keepdims=True)
    p = jnp.exp(logits - m)
    s = jnp.sum(p, axis=-1, keepdims=True)
    return p / s, (m + jnp.log(s))[..., 0]


def _t5_bucket(dist):
    max_exact = REL_BUCKETS // 2
    d = jnp.maximum(dist, 1).astype(jnp.float32)
    large = max_exact + (jnp.log(d / max_exact) / math.log(REL_MAX_DIST / max_exact)
                         * (REL_BUCKETS - max_exact)).astype(jnp.int32)
    large = jnp.minimum(large, REL_BUCKETS - 1)
    return jnp.where(dist < max_exact, dist, large)


def _slot_bias(rel_bias, g):
    dil, win = GROUP_DILATIONS[g], GROUP_WINDOWS[g]
    dist = dil * jnp.arange(win // dil + 1, dtype=jnp.int32)
    hs = slice(g * HEADS_PER_GROUP, (g + 1) * HEADS_PER_GROUP)
    return rel_bias[_t5_bucket(dist)][:, hs].astype(jnp.float32)


def _band_dilated_attention(q, k, v, bias, dil, win):
    bsz, seq, nh, hd = q.shape
    qb = win // dil
    span = dil * qb
    s_pad = -(-seq // span) * span
    n_blk = s_pad // span
    m_len = s_pad // dil

    def to_blocks(t):
        t = jnp.pad(t, ((0, 0), (0, s_pad - seq), (0, 0), (0, 0)))
        t = t.reshape(bsz, m_len, dil, nh, hd).transpose(0, 2, 1, 3, 4)
        return t.reshape(bsz, dil, n_blk, qb, nh, hd)

    def with_prev(t):
        prev = jnp.pad(t, ((0, 0), (0, 0), (1, 0), (0, 0), (0, 0), (0, 0)))[:, :, :-1]
        return jnp.concatenate([prev, t], axis=3)

    qs = to_blocks(q)
    ks = with_prev(to_blocks(k))
    vs = with_prev(to_blocks(v))
    iq = jnp.arange(qb)[:, None]
    ik = jnp.arange(2 * qb)[None, :]
    slot = qb + iq - ik
    in_band = (slot >= 0) & (slot <= qb)
    has_key = (jnp.arange(n_blk)[:, None, None] > 0) | (ik >= qb)[None]
    mask = in_band[None, None] & has_key[:, None]
    band_bias = jnp.transpose(bias[jnp.clip(slot, 0, qb)], (2, 0, 1))
    logits = jnp.einsum('brnqhd,brnkhd->brnhqk', qs, ks) * ATT_SCALE + band_bias
    probs, lse = _softmax_lse(jnp.where(mask, logits, NEG_INF))
    o = jnp.einsum('brnhqk,brnkhd->brnqhd', probs, vs)
    o = o.reshape(bsz, dil, m_len, nh, hd).transpose(0, 2, 1, 3, 4).reshape(bsz, s_pad, nh, hd)[:, :seq]
    lse = jnp.swapaxes(lse, 3, 4).reshape(bsz, dil, m_len, nh).transpose(0, 2, 1, 3)
    lse = lse.reshape(bsz, s_pad, nh)[:, :seq]
    return o, lse


def _gather_dilated_attention(q, k_all, v_all, bias, dil, win, n_buf):
    t = q.shape[1]
    nk = win // dil + 1
    idx = n_buf + jnp.arange(t)[:, None] - dil * jnp.arange(nk)[None, :]
    valid = idx >= 0
    idx_c = jnp.maximum(idx, 0)
    kg = k_all[:, idx_c]
    vg = v_all[:, idx_c]
    logits = jnp.einsum('bthd,btkhd->bthk', q, kg) * ATT_SCALE + bias.T
    probs, lse = _softmax_lse(jnp.where(valid[None, :, None, :], logits, NEG_INF))
    o = jnp.einsum('bthk,btkhd->bthd', probs, vg)
    return o, lse


def _combine_groups(outs, lses):
    w = jax.nn.softmax(jnp.stack(lses, 0), axis=0)
    return jnp.sum(w[..., None] * jnp.stack(outs, 0), axis=0)


def _prompt_attend(q, k, v, biases):
    outs, lses, rows = [], [], []
    f32 = jnp.float32
    for g in range(N_GROUPS):
        hs = slice(g * HEADS_PER_GROUP, (g + 1) * HEADS_PER_GROUP)
        qg, kg, vg = q[:, :, hs], k[:, :, hs], v[:, :, hs]
        o, lse = _band_dilated_attention(qg.astype(f32), kg.astype(f32), vg.astype(f32), biases[g],
                                         GROUP_DILATIONS[g], GROUP_WINDOWS[g])
        outs.append(o)
        lses.append(lse)
        keep = min(GROUP_WINDOWS[g], q.shape[1])
        rows.append(jnp.stack([kg, vg], axis=2)[:, -keep:])
    return _combine_groups(outs, lses), rows


def _sample_attend(q, k, v, biases, bufs):
    outs, lses, rows = [], [], []
    f32 = jnp.float32
    for g in range(N_GROUPS):
        hs = slice(g * HEADS_PER_GROUP, (g + 1) * HEADS_PER_GROUP)
        qg, kg, vg = q[:, :, hs], k[:, :, hs], v[:, :, hs]
        buf = bufs[g]
        k_all = jnp.concatenate([buf[:, :, 0].astype(kg.dtype), kg], axis=1)
        v_all = jnp.concatenate([buf[:, :, 1].astype(vg.dtype), vg], axis=1)
        o, lse = _gather_dilated_attention(qg.astype(f32), k_all.astype(f32), v_all.astype(f32), biases[g],
                                           GROUP_DILATIONS[g], GROUP_WINDOWS[g], buf.shape[1])
        outs.append(o)
        lses.append(lse)
        rows.append(jnp.stack([kg, vg], axis=2))
    return _combine_groups(outs, lses), rows


def _lin_combine(left, right):
    a1, b1 = left
    a2, b2 = right
    return a1 * a2, a2 * b1 + b2


def _conv_rglru(xb, conv_prev, h0, w_conv, b_conv, w_rg_a, b_rg_a, w_rg_i, b_rg_i, lam):
    t = xb.shape[1]
    xcat = jnp.concatenate([conv_prev.astype(xb.dtype), xb], axis=1)
    xc = b_conv
    for j in range(CONV_WIDTH):
        xc = xc + w_conv[j] * xcat[:, j:j + t]
    new_conv = xcat[:, t:]
    x32 = xc.astype(jnp.float32)
    xblk = x32.reshape(x32.shape[0], t, LRU_BLOCKS, LRU_BLOCK)
    r = jax.nn.sigmoid(jnp.einsum('btni,nij->btnj', xblk, w_rg_a.astype(jnp.float32)).reshape(x32.shape) + b_rg_a)
    i = jax.nn.sigmoid(jnp.einsum('btni,nij->btnj', xblk, w_rg_i.astype(jnp.float32)).reshape(x32.shape) + b_rg_i)
    log_a = RG_C * r * jax.nn.log_sigmoid(lam.astype(jnp.float32))
    a = jnp.exp(log_a)
    b = jnp.sqrt(-jnp.expm1(2.0 * log_a)) * (i * x32)
    b = b.at[:, 0].add(a[:, 0] * h0)
    _, h = lax.associative_scan(_lin_combine, (a, b), axis=1)
    return h, new_conv, h[:, -1]


def _layer(x, pe, attend, conv_prev, h0, g_mix, w_in, g_q, g_k, w_oa, w_conv, b_conv, w_rg_a, b_rg_a,
           w_rg_i, b_rg_i, lam, w_ob, w_o, g_mlp, w_up, w_down, g_ple, w_ple_gate, w_ple_in):
    bsz, t = x.shape[0], x.shape[1]
    h = _rms_norm(x, g_mix)
    q, k, v, xb, yb, ga, gb = jnp.split(h @ w_in, SPLITS, axis=-1)
    q = _rms_norm(q.reshape(bsz, t, N_HEADS_A, HEAD_DIM), g_q)
    k = _rms_norm(k.reshape(bsz, t, N_HEADS_A, HEAD_DIM), g_k)
    v = v.reshape(bsz, t, N_HEADS_A, HEAD_DIM)
    att, kv_rows = attend(q, k, v)
    a_out = att.reshape(bsz, t, MERGE_WIDTH).astype(x.dtype) @ w_oa
    hr, conv_new, h_last = _conv_rglru(xb, conv_prev, h0, w_conv, b_conv, w_rg_a, b_rg_a, w_rg_i, b_rg_i, lam)
    b_out = (hr.astype(x.dtype) * jax.nn.gelu(yb)) @ w_ob
    x = x + (jax.nn.sigmoid(ga) * a_out + jax.nn.sigmoid(gb) * b_out) @ w_o
    x = x + jnp.square(jax.nn.relu(_rms_norm(x, g_mlp) @ w_up)) @ w_down
    x = x + jax.nn.sigmoid(_rms_norm(x, g_ple) @ w_ple_gate) * (pe @ w_ple_in)
    return x, kv_rows, conv_new, h_last


def setup_inputs(seed: int = 0) -> dict:
    key = jax.random.key(seed)
    k = jax.random.split(key, 32)
    f32 = jnp.float32

    def nrm(i, shape, scale):
        return scale * jax.random.normal(k[i], shape, f32)

    wb = [min(w, PAST_LEN) for w in GROUP_WINDOWS]
    u = jax.random.uniform(k[31], (DEPTH, LRU_WIDTH), f32, 0.9, 0.999)
    return {
        'x_prompt': nrm(0, (BATCH, SEQ, D_MODEL), 1.0),
        'x_sample': nrm(1, (DEC_BATCH, DEC_SEQ, D_MODEL), 1.0),
        'p_prompt': nrm(2, (DEPTH, BATCH, SEQ, PLE_DIM), 1.0),
        'p_sample': nrm(3, (DEPTH, DEC_BATCH, DEC_SEQ, PLE_DIM), 1.0),
        'cache_kv1': nrm(4, (DEPTH, DEC_BATCH, wb[0], 2, HEADS_PER_GROUP, HEAD_DIM), 1.0),
        'cache_kv2': nrm(5, (DEPTH, DEC_BATCH, wb[1], 2, HEADS_PER_GROUP, HEAD_DIM), 1.0),
        'cache_kv3': nrm(6, (DEPTH, DEC_BATCH, wb[2], 2, HEADS_PER_GROUP, HEAD_DIM), 1.0),
        'state_conv': nrm(7, (DEPTH, DEC_BATCH, CONV_WIDTH - 1, LRU_WIDTH), 1.0),
        'state_lru': nrm(8, (DEPTH, DEC_BATCH, LRU_WIDTH), 0.5),
        'rel_bias': nrm(9, (REL_BUCKETS, N_HEADS_A), 0.5),
        'g_mix': 1.0 + nrm(10, (DEPTH, D_MODEL), 0.05),
        'w_in': nrm(11, (DEPTH, D_MODEL, IN_WIDTH), D_MODEL ** -0.5),
        'g_q': 1.0 + nrm(12, (DEPTH, HEAD_DIM), 0.05),
        'g_k': 1.0 + nrm(13, (DEPTH, HEAD_DIM), 0.05),
        'w_oa': nrm(14, (DEPTH, MERGE_WIDTH, D_MODEL), MERGE_WIDTH ** -0.5),
        'w_conv': nrm(15, (DEPTH, CONV_WIDTH, LRU_WIDTH), CONV_WIDTH ** -0.5),
        'b_conv': nrm(16, (DEPTH, LRU_WIDTH), 0.05),
        'w_rg_a': nrm(17, (DEPTH, LRU_BLOCKS, LRU_BLOCK, LRU_BLOCK), LRU_BLOCK ** -0.5),
        'b_rg_a': nrm(18, (DEPTH, LRU_WIDTH), 0.1),
        'w_rg_i': nrm(19, (DEPTH, LRU_BLOCKS, LRU_BLOCK, LRU_BLOCK), LRU_BLOCK ** -0.5),
        'b_rg_i': nrm(20, (DEPTH, LRU_WIDTH), 0.1),
        'lam': jnp.log(u) - jnp.log1p(-u),
        'w_ob': nrm(21, (DEPTH, LRU_WIDTH, D_MODEL), LRU_WIDTH ** -0.5),
        'w_o': nrm(22, (DEPTH, D_MODEL, D_MODEL), D_MODEL ** -0.5),
        'g_mlp': 1.0 + nrm(23, (DEPTH, D_MODEL), 0.05),
        'w_up': nrm(24, (DEPTH, D_MODEL, D_FF), D_MODEL ** -0.5),
        'w_down': nrm(25, (DEPTH, D_FF, D_MODEL), D_FF ** -0.5),
        'g_ple': 1.0 + nrm(26, (DEPTH, D_MODEL), 0.05),
        'w_ple_gate': nrm(27, (DEPTH, D_MODEL, D_MODEL), D_MODEL ** -0.5),
        'w_ple_in': nrm(28, (DEPTH, PLE_DIM, D_MODEL), PLE_DIM ** -0.5),
    }


def reference(x_prompt, x_sample, p_prompt, p_sample, cache_kv1, cache_kv2, cache_kv3, state_conv, state_lru,
              rel_bias, g_mix, w_in, g_q, g_k, w_oa, w_conv, b_conv, w_rg_a, b_rg_a, w_rg_i, b_rg_i, lam,
              w_ob, w_o, g_mlp, w_up, w_down, g_ple, w_ple_gate, w_ple_in):
    biases = [_slot_bias(rel_bias, g) for g in range(N_GROUPS)]
    yp, ys = x_prompt, x_sample
    kvp = [[], [], []]
    kvs = [[], [], []]
    convp, lrup, convs, lrus = [], [], [], []
    for i in range(DEPTH):
        lp = (g_mix[i], w_in[i], g_q[i], g_k[i], w_oa[i], w_conv[i], b_conv[i], w_rg_a[i], b_rg_a[i],
              w_rg_i[i], b_rg_i[i], lam[i], w_ob[i], w_o[i], g_mlp[i], w_up[i], w_down[i], g_ple[i],
              w_ple_gate[i], w_ple_in[i])
        conv0 = jnp.zeros((yp.shape[0], CONV_WIDTH - 1, LRU_WIDTH), yp.dtype)
        h00 = jnp.zeros((yp.shape[0], LRU_WIDTH), jnp.float32)
        yp, rows_p, c_p, h_p = _layer(yp, p_prompt[i], lambda q, k, v: _prompt_attend(q, k, v, biases),
                                      conv0, h00, *lp)
        bufs = (cache_kv1[i], cache_kv2[i], cache_kv3[i])
        ys, rows_s, c_s, h_s = _layer(ys, p_sample[i], lambda q, k, v: _sample_attend(q, k, v, biases, bufs),
                                      state_conv[i], state_lru[i].astype(jnp.float32), *lp)
        for g in range(N_GROUPS):
            kvp[g].append(rows_p[g])
            kvs[g].append(rows_s[g])
        convp.append(c_p)
        lrup.append(h_p)
        convs.append(c_s)
        lrus.append(h_s)
    kv1_p, kv2_p, kv3_p = jnp.stack(kvp[0]), jnp.stack(kvp[1]), jnp.stack(kvp[2])
    kv1_s, kv2_s, kv3_s = jnp.stack(kvs[0]), jnp.stack(kvs[1]), jnp.stack(kvs[2])
    conv_p, lru_p = jnp.stack(convp), jnp.stack(lrup)
    conv_s, lru_s = jnp.stack(convs), jnp.stack(lrus)
    return (yp, ys, kv1_p, kv2_p, kv3_p, conv_p, lru_p, kv1_s, kv2_s, kv3_s, conv_s, lru_s)
```

```cpp
#include <hip/hip_runtime.h>
#include <cstdio>
#include <cstdint>
#include <cmath>
#define MK_N_LAUNCHES 1
constexpr int NWAVES = 8;
#ifndef MK_N_LAUNCHES
#define MK_N_LAUNCHES 1
#endif
constexpr int N_LAUNCHES = MK_N_LAUNCHES;
constexpr int PER_PHASE = 9;

constexpr int DM = 1024, NBATCH = 8, SEQ = 8192, DBATCH = 128, DSEQ = 4;
constexpr int MP = NBATCH * SEQ, MS = DBATCH * DSEQ, M = MP + MS;
constexpr int NIN = 8704, FF = 4096, PLE = 256, AW = 1536, MW = 512;
static_assert(M % 256 == 0 && NIN % 256 == 0, "tile shapes");

constexpr size_t MiB = 1u << 20;
constexpr size_t al(size_t x) { return (x + MiB - 1) / MiB * MiB; }
constexpr size_t WS_CTL = 0, CTL_ZERO_BYTES = 1 * MiB;
constexpr size_t WS_WIN = 1 * MiB;
constexpr size_t WS_WOA = WS_WIN + al((size_t)NIN * DM * 2);
constexpr size_t WS_WOB = WS_WOA + al((size_t)DM * MW * 2);
constexpr size_t WS_WO = WS_WOB + al((size_t)DM * DM * 2);
constexpr size_t WS_WUP = WS_WO + al((size_t)DM * DM * 2);
constexpr size_t WS_WDN = WS_WUP + al((size_t)FF * DM * 2);
constexpr size_t WS_WPG = WS_WDN + al((size_t)FF * DM * 2);
constexpr size_t WS_WPE = WS_WPG + al((size_t)DM * DM * 2);
constexpr size_t WS_WRG = WS_WPE + al((size_t)DM * PLE * 2);
constexpr size_t WS_TAB = WS_WRG + MiB;
constexpr size_t WS_HB = WS_TAB + MiB;
constexpr size_t ACT = al((size_t)M * DM * 2);
constexpr size_t WS_Q = WS_HB + ACT;
constexpr size_t QKV = (size_t)MP * AW * 2;
constexpr size_t WS_K = WS_Q + QKV, WS_V = WS_K + QKV;
constexpr size_t WS_XB = WS_V + QKV, WS_GY = WS_XB + ACT, WS_SGA = WS_GY + ACT, WS_SGB = WS_SGA + ACT;
constexpr size_t WS_QS = WS_SGB + ACT;
constexpr size_t WS_XBS = WS_QS + al((size_t)MS * AW * 4);
constexpr size_t WS_OG = WS_XBS + al((size_t)MS * DM * 4);
constexpr size_t WS_LSE = WS_OG + al((size_t)3 * MP * MW * 2);
constexpr size_t WS_ATT = WS_LSE + al((size_t)3 * MP * 4 * 4);
constexpr size_t WS_HRG = WS_ATT + al((size_t)M * MW * 2);
constexpr size_t WS_AMIX = WS_HRG + ACT, WS_MIX = WS_AMIX + ACT, WS_X1B = WS_MIX + ACT, WS_X2B = WS_X1B + ACT;
constexpr size_t WS_U = WS_X2B + ACT;
constexpr size_t WS_PB = WS_U + al((size_t)M * FF * 2);
constexpr size_t WS_PEP = WS_PB + al((size_t)M * PLE * 2);
constexpr size_t WS_SS1 = WS_PEP + ACT;
constexpr size_t WS_SS2 = WS_SS1 + al((size_t)M * 4 * 4);
constexpr size_t WS_END = WS_SS2 + al((size_t)M * 4 * 4);
constexpr int CW_BAR = 4096;

constexpr int RING_OFF = 0, RING_BYTES = 131072;
constexpr int XCH_OFF = 131072;
constexpr int MISC_OFF = 139264;
constexpr int LDS_BYTES = 147456;

#define GAS __attribute__((address_space(1)))
#define LAS __attribute__((address_space(3)))
typedef unsigned short bf16;
typedef unsigned v4u __attribute__((ext_vector_type(4)));
typedef unsigned v2u __attribute__((ext_vector_type(2)));
typedef float f32x4 __attribute__((ext_vector_type(4)));
typedef float f32x16 __attribute__((ext_vector_type(16)));
typedef short bf16x8 __attribute__((ext_vector_type(8)));
typedef short s16x4 __attribute__((ext_vector_type(4)));
typedef GAS unsigned gu32;
#define RLX_AGENT __ATOMIC_RELAXED, __HIP_MEMORY_SCOPE_AGENT
#define LDS_WAIT() asm volatile("s_waitcnt lgkmcnt(0)" ::: "memory")
#define VM_WAIT() asm volatile("s_waitcnt vmcnt(0)" ::: "memory")
__device__ __forceinline__ unsigned f2bf(float f) { unsigned u = __builtin_bit_cast(unsigned, f); return (u + 0x7fffu + ((u >> 16) & 1u)) >> 16; }
__device__ __forceinline__ unsigned pk2(float lo, float hi) { return f2bf(lo) | (f2bf(hi) << 16); }
__device__ __forceinline__ float bflo(unsigned w) { return __uint_as_float(w << 16); }
__device__ __forceinline__ float bfhi(unsigned w) { return __uint_as_float(w & 0xffff0000u); }
__device__ __forceinline__ float fexp2(float x) { return __builtin_amdgcn_exp2f(x); }
__device__ __forceinline__ float frcp(float x) { return __builtin_amdgcn_rcpf(x); }
__device__ __forceinline__ float sigm(float x) { return frcp(1.0f + fexp2(-1.4426950408889634f * x)); }
namespace pg8 {
#define PG8_LAS __attribute__((address_space(3)))
typedef unsigned short bf16_t;
typedef short bf16x8 __attribute__((ext_vector_type(8)));
typedef float f32x4 __attribute__((ext_vector_type(4)));
typedef unsigned u32x4 __attribute__((ext_vector_type(4)));
constexpr int BM = 256, BK = 64, HALF = 128, HTB = HALF * BK * 2  , STAGE_BYTES = 8 * HTB, NXCD = 8, WGM = 8;

__host__ __device__ __forceinline__ int lds_byte(int r, int c) { const int st = (r >> 4) * 2 + (c >> 5), rr = r & 15, cc = c & 31, ob = rr * 64 + cc * 2; return st * 1024 + (ob ^ (((ob >> 9) & 1) << 5)); }
__host__ __device__ __forceinline__ void stage_rc(int b, int& R, int& C) { const int st = b / 1024, sb = b % 1024, swz = sb ^ (((sb >> 9) & 1) << 5); R = (st >> 1) * 16 + swz / 64; C = (st & 1) * 32 + (swz % 64) / 2; }
__host__ __device__ __forceinline__ int perm32(int rho) { const int n = rho >> 4, i = rho & 15; return 8 * (i >> 2) + 4 * n + (i & 3); }

struct Unit { int pm, pn; };
struct Gemm { const bf16_t* A; const bf16_t* Bt; int M, N, K; };

struct StaticOrder {
    int nM, nN, nwg, G, c;
    __host__ __device__ void init(int M, int N, int G_, int c_) { nM = M / BM; nN = N / BM; nwg = nM * nN; G = G_; c = c_; }
    __host__ __device__ bool next(int i, Unit& u) const {
        const long L = (long)i * G + c; if (L >= nwg) return false;
        int wgid = (int)L; { const int q = nwg / NXCD, r = nwg % NXCD, xcd = wgid % NXCD, off = wgid / NXCD; wgid = (xcd < r ? xcd * (q + 1) : r * (q + 1) + (xcd - r) * q) + off; }
        const int nig = WGM * nN, gid = wgid / nig, fm = gid * WGM, gsz = (nM - fm) < WGM ? (nM - fm) : WGM;
        u.pm = fm + ((wgid % nig) % gsz); u.pn = (wgid % nig) / gsz; return true;
    }
    __device__ __forceinline__ void a_ready(const Unit&) const {}
    __device__ __forceinline__ void done(const Unit&) const {}
};
__device__ __forceinline__ unsigned cvt_pk_bf16(float lo, float hi) { unsigned r; asm volatile("v_cvt_pk_bf16_f32 %0, %1, %2" : "=v"(r) : "v"(lo), "v"(hi)); return r; }
typedef float f32x2 __attribute__((ext_vector_type(2)));
typedef unsigned u32x2 __attribute__((ext_vector_type(2)));
constexpr float RMS_EPS = 1e-6f;
constexpr float QSCALE = 0.08838834764831845f * 1.4426950408889634f;
constexpr size_t O_YP = 0, O_YS = 67108864, O_KV1P = 67633152, O_KV2P = 68681728, O_KV3P = 72876032, O_CONVP = 89653248, O_LRUP = 89677824,
                 O_KV1S = 89686016, O_KV2S = 90210304, O_KV3S = 90734592, O_CONVS = 91258880, O_LRUS = 91652096, O_END = 91783168;
__device__ __forceinline__ size_t kvp_off(int g) { return g == 0 ? O_KV1P : (g == 1 ? O_KV2P : O_KV3P); }
__device__ __forceinline__ size_t kvs_off(int g) { return g == 0 ? O_KV1S : (g == 1 ? O_KV2S : O_KV3S); }

__device__ __forceinline__ float fsigmoid(float x) { return __builtin_amdgcn_rcpf(1.0f + __builtin_amdgcn_exp2f(-1.4426950408889634f * x)); }
__device__ __forceinline__ float fgelu_tanh(float x) { const float u = x + 0.044715f * x * x * x; return x * __builtin_amdgcn_rcpf(1.0f + __builtin_amdgcn_exp2f(-2.3022082232f * u)); }
__device__ __forceinline__ float bf_lo(unsigned w) { return __uint_as_float(w << 16); }
__device__ __forceinline__ float bf_hi(unsigned w) { return __uint_as_float(w & 0xffff0000u); }
__device__ __forceinline__ u32x4 pack8(const f32x4& a, const f32x4& b) { u32x4 w; w.x = cvt_pk_bf16(a[0], a[1]); w.y = cvt_pk_bf16(a[2], a[3]); w.z = cvt_pk_bf16(b[0], b[1]); w.w = cvt_pk_bf16(b[2], b[3]); return w; }
__device__ __forceinline__ void unpack8(const u32x4& w, f32x4& a, f32x4& b) { a = (f32x4){bf_lo(w.x), bf_hi(w.x), bf_lo(w.y), bf_hi(w.y)}; b = (f32x4){bf_lo(w.z), bf_hi(w.z), bf_lo(w.w), bf_hi(w.w)}; }
__device__ __forceinline__ float sq8(const f32x4& a, const f32x4& b) { return (a[0] * a[0] + a[1] * a[1]) + (a[2] * a[2] + a[3] * a[3]) + (b[0] * b[0] + b[1] * b[1]) + (b[2] * b[2] + b[3] * b[3]); }

__device__ __forceinline__ void rowss_exchange(float (&ss)[2][4][2], PG8_LAS float* P, int wr, int wc, int fr, int fq) {
#pragma unroll
    for (int ai = 0; ai < 2; ++ai)
#pragma unroll
        for (int m = 0; m < 4; ++m)
#pragma unroll
            for (int bj = 0; bj < 2; ++bj) { float s = ss[ai][m][bj]; s += __shfl_xor(s, 16); s += __shfl_xor(s, 32);
                if (fq == 0) P[(ai * HALF + wr * 64 + m * 16 + fr) * 8 + bj * 4 + wc] = s; }
    asm volatile("s_waitcnt lgkmcnt(0)" ::: "memory"); __builtin_amdgcn_s_barrier(); asm volatile("" ::: "memory");
#pragma unroll
    for (int ai = 0; ai < 2; ++ai)
#pragma unroll
        for (int m = 0; m < 4; ++m) { const PG8_LAS f32x4* p = (const PG8_LAS f32x4*)(P + (ai * HALF + wr * 64 + m * 16 + fr) * 8);
            const f32x4 a = p[0], b = p[1]; ss[ai][m][0] = (a[0] + a[1]) + (a[2] + a[3]); ss[ai][m][1] = (b[0] + b[1]) + (b[2] + b[3]); }
}

struct Epi1 {
    static constexpr bool PERM = true, AFTER_DRAIN = false;
    unsigned char* ws; float* out; const float *gq, *gk; PG8_LAS float* P;
    __device__ __forceinline__ void operator()(const f32x4 (&acc)[2][2][4][2], const Unit& u, int wr, int wc, int fr, int fq) const {
        const int pn = u.pn; const bool sample = u.pm >= 256;
        const int colw = wc * 32 + fq * 8;
        const int row0 = u.pm * BM + wr * 64 + fr;
        if (pn < 12) {
            const bool isq = pn < 6; const int hbase = 2 * (isq ? pn : pn - 6);
            float ss[2][4][2];
#pragma unroll
            for (int ai = 0; ai < 2; ++ai)
#pragma unroll
                for (int m = 0; m < 4; ++m)
#pragma unroll
                    for (int bj = 0; bj < 2; ++bj) ss[ai][m][bj] = sq8(acc[ai][bj][m][0], acc[ai][bj][m][1]);
            rowss_exchange(ss, P, wr, wc, fr, fq);
            const f32x4 gq0 = *(const f32x4*)(gq + colw), gq1 = *(const f32x4*)(gq + colw + 4), gk0 = *(const f32x4*)(gk + colw), gk1 = *(const f32x4*)(gk + colw + 4);
            f32x4 g0, g1;
#pragma unroll
            for (int e = 0; e < 4; ++e) { g0[e] = isq ? gq0[e] * QSCALE : gk0[e]; g1[e] = isq ? gq1[e] * QSCALE : gk1[e]; }
            bf16_t* const QK = (bf16_t*)(ws + (isq ? WS_Q : WS_K)); float* const QS = (float*)(ws + WS_QS);
#pragma unroll
            for (int ai = 0; ai < 2; ++ai)
#pragma unroll
                for (int m = 0; m < 4; ++m) { const int R = row0 + ai * HALF + m * 16;
#pragma unroll
                    for (int bj = 0; bj < 2; ++bj) { const int hh = hbase + bj, grp = hh >> 2, gsh = 2 * grp;
                        const float rs = __builtin_amdgcn_rsqf(ss[ai][m][bj] * (1.0f / 128.0f) + RMS_EPS);
                        const f32x4 v0 = acc[ai][bj][m][0] * rs * g0, v1 = acc[ai][bj][m][1] * rs * g1;
                        if (!sample) { const int b = R >> 13, t = R & 8191; const int rr = t & ((1 << gsh) - 1), mm = t >> gsh;
                            const size_t rowp = ((size_t)(b * 12 + hh) << 13) + (size_t)(rr << (13 - gsh)) + mm;
                            *(u32x4*)(QK + rowp * 128 + colw) = pack8(v0, v1);
                            if (!isq) { const int W = 128 << gsh, trel = t - (8192 - W);
                                if (trel >= 0) { float* o = out + kvp_off(grp) + ((((size_t)b * W + trel) * 2 + 0) * 4 + (hh & 3)) * 128 + colw; *(f32x4*)o = v0; *(f32x4*)(o + 4) = v1; } }
                        } else { const int s = R - MP;
                            float* o = isq ? QS + (size_t)s * 1536 + hh * 128 + colw : out + kvs_off(grp) + (((size_t)s * 2 + 0) * 4 + (hh & 3)) * 128 + colw;
                            *(f32x4*)o = v0; *(f32x4*)(o + 4) = v1; } } }
        } else if (pn < 18) {
            const int hbase = 2 * (pn - 12); bf16_t* const V = (bf16_t*)(ws + WS_V);
#pragma unroll
            for (int ai = 0; ai < 2; ++ai)
#pragma unroll
                for (int m = 0; m < 4; ++m) { const int R = row0 + ai * HALF + m * 16;
#pragma unroll
                    for (int bj = 0; bj < 2; ++bj) { const int hh = hbase + bj, grp = hh >> 2, gsh = 2 * grp;
                        const f32x4 v0 = acc[ai][bj][m][0], v1 = acc[ai][bj][m][1];
                        if (!sample) { const int b = R >> 13, t = R & 8191; const int rr = t & ((1 << gsh) - 1), mm = t >> gsh;
                            const size_t rowp = ((size_t)(b * 12 + hh) << 13) + (size_t)(rr << (13 - gsh)) + mm;
                            *(u32x4*)(V + rowp * 128 + colw) = pack8(v0, v1);
                            const int W = 128 << gsh, trel = t - (8192 - W);
                            if (trel >= 0) { float* o = out + kvp_off(grp) + ((((size_t)b * W + trel) * 2 + 1) * 4 + (hh & 3)) * 128 + colw; *(f32x4*)o = v0; *(f32x4*)(o + 4) = v1; }
                        } else { const int s = R - MP;
                            float* o = out + kvs_off(grp) + (((size_t)s * 2 + 1) * 4 + (hh & 3)) * 128 + colw; *(f32x4*)o = v0; *(f32x4*)(o + 4) = v1; } } }
        } else if (pn < 22) {
            const int cb = (pn - 18) * BM + colw; bf16_t* const XB = (bf16_t*)(ws + WS_XB); float* const XBS = (float*)(ws + WS_XBS);
#pragma unroll
            for (int ai = 0; ai < 2; ++ai)
#pragma unroll
                for (int m = 0; m < 4; ++m) { const int R = row0 + ai * HALF + m * 16;
#pragma unroll
                    for (int bj = 0; bj < 2; ++bj) { const int col = cb + bj * HALF; const f32x4 v0 = acc[ai][bj][m][0], v1 = acc[ai][bj][m][1];
                        if (!sample) { const int b = R >> 13, t = R & 8191;
                            *(u32x4*)(XB + (size_t)R * 1024 + col) = pack8(v0, v1);
                            if (t >= 8189) { float* o = out + O_CONVP + ((size_t)b * 3 + (t - 8189)) * 1024 + col; *(f32x4*)o = v0; *(f32x4*)(o + 4) = v1; }
                        } else { const int s = R - MP, b = s >> 2, t = s & 3;
                            float* o = XBS + (size_t)s * 1024 + col; *(f32x4*)o = v0; *(f32x4*)(o + 4) = v1;
                            if (t >= 1) { float* o2 = out + O_CONVS + ((size_t)b * 3 + (t - 1)) * 1024 + col; *(f32x4*)o2 = v0; *(f32x4*)(o2 + 4) = v1; } } } }
        } else {
            const int seg = (pn - 22) >> 2; const int cb = ((pn - 22) & 3) * BM + colw; bf16_t* const dst = (bf16_t*)(ws + (seg == 0 ? WS_GY : (seg == 1 ? WS_SGA : WS_SGB)));
#pragma unroll
            for (int ai = 0; ai < 2; ++ai)
#pragma unroll
                for (int m = 0; m < 4; ++m) { const int R = row0 + ai * HALF + m * 16;
#pragma unroll
                    for (int bj = 0; bj < 2; ++bj) { const int col = cb + bj * HALF; f32x4 v0 = acc[ai][bj][m][0], v1 = acc[ai][bj][m][1];
                        if (seg == 0) {
#pragma unroll
                            for (int e = 0; e < 4; ++e) { v0[e] = fgelu_tanh(v0[e]); v1[e] = fgelu_tanh(v1[e]); }
                        } else {
#pragma unroll
                            for (int e = 0; e < 4; ++e) { v0[e] = fsigmoid(v0[e]); v1[e] = fsigmoid(v1[e]); }
                        }
                        *(u32x4*)(dst + (size_t)R * 1024 + col) = pack8(v0, v1); } }
        }
    }
};

enum { E_AMIX = 0, E_MIX = 1, E_X1 = 2, E_UP = 3, E_X2 = 4, E_PE = 5, E_Y = 6 };
template <int MODE> struct Epi2 {
    static constexpr bool PERM = true, AFTER_DRAIN = false;
    const bf16_t* g1; const bf16_t* g2; bf16_t* o1; float* of; const float* xp; const float* xs; float* ss_out; const float* ss_in; PG8_LAS float* P;
    __device__ __forceinline__ void operator()(const f32x4 (&acc)[2][2][4][2], const Unit& u, int wr, int wc, int fr, int fq) const {
        const int colw = u.pn * BM + wc * 32 + fq * 8; const int row0 = u.pm * BM + wr * 64 + fr;
        float ss[2][4][2];
#pragma unroll
        for (int ai = 0; ai < 2; ++ai)
#pragma unroll
            for (int m = 0; m < 4; ++m) { const int R = row0 + ai * HALF + m * 16;
                float rs = 1.0f;
                if (MODE == E_UP || MODE == E_Y) { const f32x4 q = *(const f32x4*)(ss_in + (size_t)R * 4); rs = __builtin_amdgcn_rsqf(((q[0] + q[1]) + (q[2] + q[3])) * (1.0f / 1024.0f) + RMS_EPS); }
#pragma unroll
                for (int bj = 0; bj < 2; ++bj) { const int col = colw + bj * HALF; const size_t idx = (size_t)R * 1024 + col;
                    const f32x4 a0 = acc[ai][bj][m][0], a1 = acc[ai][bj][m][1];
                    if (MODE == E_AMIX) { f32x4 s0, s1; unpack8(*(const u32x4*)(g1 + idx), s0, s1); *(u32x4*)(o1 + idx) = pack8(s0 * a0, s1 * a1); }
                    else if (MODE == E_MIX) { f32x4 s0, s1, p0, p1; unpack8(*(const u32x4*)(g1 + idx), s0, s1); unpack8(*(const u32x4*)(g2 + idx), p0, p1); *(u32x4*)(o1 + idx) = pack8(p0 + s0 * a0, p1 + s1 * a1); }
                    else if (MODE == E_X1) { const float* xr = (R < MP) ? xp + idx : xs + (idx - (size_t)MP * 1024);
                        const f32x4 v0 = *(const f32x4*)xr + a0, v1 = *(const f32x4*)(xr + 4) + a1;
                        *(f32x4*)(of + idx) = v0; *(f32x4*)(of + idx + 4) = v1; *(u32x4*)(o1 + idx) = pack8(v0, v1); ss[ai][m][bj] = sq8(v0, v1); }
                    else if (MODE == E_UP) { f32x4 v0 = a0 * rs, v1 = a1 * rs;
#pragma unroll
                        for (int e = 0; e < 4; ++e) { const float p = fmaxf(v0[e], 0.f), q = fmaxf(v1[e], 0.f); v0[e] = p * p; v1[e] = q * q; }
                        *(u32x4*)(o1 + (size_t)R * 4096 + col) = pack8(v0, v1); }
                    else if (MODE == E_X2) { const f32x4 v0 = *(const f32x4*)(of + idx) + a0, v1 = *(const f32x4*)(of + idx + 4) + a1;
                        *(f32x4*)(of + idx) = v0; *(f32x4*)(of + idx + 4) = v1; *(u32x4*)(o1 + idx) = pack8(v0, v1); ss[ai][m][bj] = sq8(v0, v1); }
                    else if (MODE == E_PE) { *(u32x4*)(o1 + idx) = pack8(a0, a1); }
                    else { f32x4 p0, p1; unpack8(*(const u32x4*)(g1 + idx), p0, p1); f32x4 v0 = *(const f32x4*)(of + idx), v1 = *(const f32x4*)(of + idx + 4);
#pragma unroll
                        for (int e = 0; e < 4; ++e) { v0[e] += fsigmoid(a0[e] * rs) * p0[e]; v1[e] += fsigmoid(a1[e] * rs) * p1[e]; }
                        *(f32x4*)(of + idx) = v0; *(f32x4*)(of + idx + 4) = v1; } }
                if (MODE != E_UP && MODE != E_PE) asm volatile("" ::: "memory"); }
        if (MODE == E_X1 || MODE == E_X2) {
            rowss_exchange(ss, P, wr, wc, fr, fq);
            if (wc == 0 && fq == 0) {
#pragma unroll
                for (int ai = 0; ai < 2; ++ai)
#pragma unroll
                    for (int m = 0; m < 4; ++m) ss_out[(size_t)(row0 + ai * HALF + m * 16) * 4 + u.pn] = ss[ai][m][0] + ss[ai][m][1]; }
        }
    }
};
template <class Epi, class Sched, bool ALIGN_EPI = false, bool SP2 = false>
__device__ __forceinline__ void gemm_phase(PG8_LAS unsigned char* lds, const Gemm g, const Sched& S, const Epi& E, const int wave0) {
    int tid_ = (wave0 << 6) | (int)__builtin_amdgcn_mbcnt_hi(~0u, __builtin_amdgcn_mbcnt_lo(~0u, 0u)); asm volatile("" : "+v"(tid_));
    const int tid = tid_, wid = __builtin_amdgcn_readfirstlane(tid >> 6), lane = tid & 63, wr = wid >> 2, wc = wid & 3, fr = lane & 15, fq = lane >> 4;
    const int K = g.K, nt = K / BK;
    unsigned voffA[2], voffB[2];
#pragma unroll
    for (int i = 0; i < 2; ++i) { int R, C; stage_rc(tid * 16 + i * 8192, R, C); const int Rb = Epi::PERM ? ((R & ~31) + perm32(R & 31)) : R;
        voffA[i] = (unsigned)(R * K + C) * 2u; voffB[i] = (unsigned)(Rb * K + C) * 2u; }
    const size_t kstep = (size_t)(BK * 2);
    const size_t hstep = (size_t)HALF * K * 2;
    const size_t tstep = 2 * hstep;
    const unsigned ldsw = (unsigned)wid * 1024u;
    const int aoff = lds_byte(wr * 64 + fr, fq * 8), boff = lds_byte(wc * 32 + fr, fq * 8);
#define PG8_SA(b, h) (((b) * 2 + (h)) * HTB)
#define PG8_SB(b, h) ((4 + (b) * 2 + (h)) * HTB)
#define PG8_STAGE(bufoff, gbase, voff) do { _Pragma("unroll") for (int _i = 0; _i < 2; ++_i) \
        __builtin_amdgcn_global_load_lds((const unsigned*)((const char*)(gbase) + (voff)[_i]), (PG8_LAS unsigned*)(lds + (bufoff) + ldsw + _i * 8192), 16, 0, 0); } while (0)
#define PG8_LDA(dst, b, h) do { _Pragma("unroll") for (int m = 0; m < 4; ++m) _Pragma("unroll") for (int k = 0; k < 2; ++k) dst[m][k] = *(const PG8_LAS bf16x8*)(lds + PG8_SA(b, h) + aoff + m * 2048 + k * 1024); } while (0)
#define PG8_LDB(dst, b, h) do { _Pragma("unroll") for (int n = 0; n < 2; ++n) _Pragma("unroll") for (int k = 0; k < 2; ++k) dst[n][k] = *(const PG8_LAS bf16x8*)(lds + PG8_SB(b, h) + boff + n * 2048 + k * 1024); } while (0)
#define PG8_MMA(ai, bj, At, Bt) do { __builtin_amdgcn_s_setprio(1); _Pragma("unroll") for (int m = 0; m < 4; ++m) _Pragma("unroll") for (int n = 0; n < 2; ++n) _Pragma("unroll") for (int k = 0; k < 2; ++k) \
        acc[ai][bj][m][n] = __builtin_amdgcn_mfma_f32_16x16x32_bf16(Bt[n][k], At[m][k], acc[ai][bj][m][n], 0, 0, 0); __builtin_amdgcn_s_setprio(0); } while (0)
#define PG8_WAIT_V(n) asm volatile("s_waitcnt vmcnt(" #n ")" ::: "memory")
#define PG8_WAIT_L(n) asm volatile("s_waitcnt lgkmcnt(" #n ")" ::: "memory")
#define PG8_BAR __builtin_amdgcn_s_barrier()
#define PG8_SCHED __builtin_amdgcn_sched_barrier(0)
    Unit cur, nxt; int ui = 0;
    if (!S.next(0, cur)) return;
    f32x4 acc[2][2][4][2];
#pragma unroll
    for (int a = 0; a < 2; ++a)
#pragma unroll
        for (int b = 0; b < 2; ++b)
#pragma unroll
            for (int m = 0; m < 4; ++m)
#pragma unroll
                for (int n = 0; n < 2; ++n) acc[a][b][m][n] = (f32x4){0.f, 0.f, 0.f, 0.f};
    bf16x8 At[4][2], B0[2][2], B1[2][2];
    const char* cA = (const char*)g.A + (size_t)cur.pm * tstep; const char* cB = (const char*)g.Bt + (size_t)cur.pn * tstep;
    S.a_ready(cur);
    if constexpr (SP2) {
        PG8_STAGE(PG8_SB(0, 0), cB, voffB); PG8_STAGE(PG8_SB(0, 1), cB + hstep, voffB); PG8_STAGE(PG8_SA(0, 0), cA, voffA); PG8_STAGE(PG8_SA(0, 1), cA + hstep, voffA);
        if (wr == 1) PG8_BAR;
        PG8_WAIT_V(2); PG8_BAR;
        PG8_STAGE(PG8_SB(1, 0), cB + kstep, voffB); PG8_STAGE(PG8_SA(1, 0), cA + kstep, voffA); PG8_STAGE(PG8_SB(1, 1), cB + hstep + kstep, voffB);
        PG8_WAIT_V(6); PG8_BAR;
    } else {
        PG8_STAGE(PG8_SB(0, 0), cB, voffB); PG8_STAGE(PG8_SA(0, 0), cA, voffA); PG8_STAGE(PG8_SB(0, 1), cB + hstep, voffB); PG8_STAGE(PG8_SA(0, 1), cA + hstep, voffA);
        if (wr == 1) PG8_BAR;
        PG8_WAIT_V(4); PG8_BAR;
        PG8_STAGE(PG8_SB(1, 0), cB + kstep, voffB); PG8_STAGE(PG8_SA(1, 0), cA + kstep, voffA); PG8_STAGE(PG8_SB(1, 1), cB + hstep + kstep, voffB);
        PG8_WAIT_V(6); PG8_BAR;
    }
    for (;;) {
        const bool has_next = S.next(ui + 1, nxt);
        const char* nA = has_next ? (const char*)g.A + (size_t)nxt.pm * tstep : cA; const char* nB = has_next ? (const char*)g.Bt + (size_t)nxt.pn * tstep : cB;
        for (int t = 0; t < nt; t += 2) {
            const bool last = (t == nt - 2);
            const char* a1 = cA + (size_t)(t + 1) * kstep;
            const char* a2 = last ? nA : cA + (size_t)(t + 2) * kstep; const char* b2 = last ? nB : cB + (size_t)(t + 2) * kstep;
            const char* a3 = a2 + kstep; const char* b3 = b2 + kstep;
            if (last && has_next) S.a_ready(nxt);
            if constexpr (SP2) {
            PG8_LDB(B0, 0, 0); PG8_LDB(B1, 0, 1); PG8_SCHED; PG8_LDA(At, 0, 0); PG8_STAGE(PG8_SA(1, 1), a1 + hstep, voffA);
            PG8_WAIT_V(8); PG8_WAIT_L(0); PG8_BAR; PG8_MMA(0, 0, At, B0); PG8_MMA(0, 1, At, B1); PG8_BAR; PG8_SCHED;
            PG8_LDA(At, 0, 1); PG8_STAGE(PG8_SB(0, 0), b2, voffB); PG8_STAGE(PG8_SB(0, 1), b2 + hstep, voffB); PG8_STAGE(PG8_SA(0, 0), a2, voffA);
            PG8_WAIT_V(8); PG8_WAIT_L(0); PG8_BAR; PG8_MMA(1, 0, At, B0); PG8_MMA(1, 1, At, B1); PG8_BAR; PG8_SCHED;
            PG8_LDB(B0, 1, 0); PG8_LDB(B1, 1, 1); PG8_SCHED; PG8_LDA(At, 1, 0); PG8_STAGE(PG8_SA(0, 1), a2 + hstep, voffA);
            PG8_WAIT_V(8); PG8_WAIT_L(0); PG8_BAR; PG8_MMA(0, 0, At, B0); PG8_MMA(0, 1, At, B1); PG8_BAR; PG8_SCHED;
            PG8_LDA(At, 1, 1); PG8_STAGE(PG8_SB(1, 0), b3, voffB); PG8_STAGE(PG8_SB(1, 1), b3 + hstep, voffB); PG8_STAGE(PG8_SA(1, 0), a3, voffA);
            PG8_WAIT_V(8); PG8_WAIT_L(0); PG8_BAR; PG8_MMA(1, 0, At, B0); PG8_MMA(1, 1, At, B1); PG8_BAR; PG8_SCHED;
            } else {
            PG8_LDB(B0, 0, 0); PG8_SCHED; PG8_LDA(At, 0, 0); PG8_STAGE(PG8_SA(1, 1), a1 + hstep, voffA);
            PG8_WAIT_L(8); PG8_BAR; PG8_WAIT_L(0); PG8_MMA(0, 0, At, B0); PG8_BAR; PG8_SCHED;
            PG8_LDB(B1, 0, 1); PG8_STAGE(PG8_SB(0, 0), b2, voffB);
            PG8_BAR; PG8_WAIT_L(0); PG8_MMA(0, 1, At, B1); PG8_BAR;
            PG8_LDA(At, 0, 1); PG8_STAGE(PG8_SA(0, 0), a2, voffA);
            PG8_BAR; PG8_WAIT_L(0); PG8_MMA(1, 0, At, B0); PG8_BAR; PG8_SCHED;
            PG8_STAGE(PG8_SB(0, 1), b2 + hstep, voffB);
            PG8_WAIT_V(6); PG8_BAR; PG8_MMA(1, 1, At, B1); PG8_BAR;
            PG8_LDB(B0, 1, 0); PG8_SCHED; PG8_LDA(At, 1, 0); PG8_STAGE(PG8_SA(0, 1), a2 + hstep, voffA);
            PG8_WAIT_L(8); PG8_BAR; PG8_WAIT_L(0); PG8_MMA(0, 0, At, B0); PG8_BAR; PG8_SCHED;
            PG8_LDB(B1, 1, 1); PG8_STAGE(PG8_SB(1, 0), b3, voffB);
            PG8_BAR; PG8_WAIT_L(0); PG8_MMA(0, 1, At, B1); PG8_BAR;
            PG8_LDA(At, 1, 1); PG8_STAGE(PG8_SA(1, 0), a3, voffA);
            PG8_BAR; PG8_WAIT_L(0); PG8_MMA(1, 0, At, B0); PG8_BAR; PG8_SCHED;
            PG8_STAGE(PG8_SB(1, 1), b3 + hstep, voffB);
            PG8_WAIT_V(6); PG8_BAR; PG8_MMA(1, 1, At, B1); PG8_BAR;
            }
        }
        if constexpr (ALIGN_EPI) { if (wr == 0) PG8_BAR; }
        if constexpr (!Epi::AFTER_DRAIN) { E(acc, cur, wr, wc, fr, fq); S.done(cur); }
        if (!has_next) break;
#pragma unroll
        for (int a = 0; a < 2; ++a)
#pragma unroll
            for (int b = 0; b < 2; ++b)
#pragma unroll
                for (int m = 0; m < 4; ++m)
#pragma unroll
                    for (int n = 0; n < 2; ++n) acc[a][b][m][n] = (f32x4){0.f, 0.f, 0.f, 0.f};
        cur = nxt; cA = nA; cB = nB; ++ui;
        if constexpr (ALIGN_EPI) { if (wr == 1) PG8_BAR; }
    }
    PG8_WAIT_V(0);
    if constexpr (!ALIGN_EPI) { if (wr == 0) PG8_BAR; }
    PG8_BAR;
    if constexpr (Epi::AFTER_DRAIN) { E.fused(acc, cur, wr, wc, fr, fq, lds, wid, lane); S.done(cur); }
#undef PG8_SA
#undef PG8_SB
#undef PG8_STAGE
#undef PG8_LDA
#undef PG8_LDB
#undef PG8_MMA
#undef PG8_WAIT_V
#undef PG8_WAIT_L
#undef PG8_BAR
#undef PG8_SCHED
}
}
#define XB_TMO      128
#define XB_XCNT(j)  (256  + 64 * (j))
#define XB_XSUB(j)  (1280 + 64 * (j))
#define XB_XGEN(j)  (2304 + 64 * (j))
#define XB_TOP      3328
#define XB_TOPGEN   3392
#define XCD_BAR_WORDS 3456
#define XB_SPIN_CAP (1u << 18)

__device__ __forceinline__ unsigned xb_ld(unsigned* p)              { return __hip_atomic_load(p, __ATOMIC_RELAXED, __HIP_MEMORY_SCOPE_AGENT); }
__device__ __forceinline__ unsigned xb_add(unsigned* p, unsigned v) { return __hip_atomic_fetch_add(p, v, __ATOMIC_RELAXED, __HIP_MEMORY_SCOPE_AGENT); }
__device__ __forceinline__ unsigned xb_xcc_id() { return (unsigned)__builtin_amdgcn_s_getreg((3 << 11) | 20) & 0xFu; }
#define XB_SPIN(cond, bar) do { unsigned _sp = 0; while (cond) { __builtin_amdgcn_s_sleep(1); \
    if ((++_sp & 255u) == 0u) { if (xb_ld(&(bar)[XB_TMO])) break; if (_sp > XB_SPIN_CAP) { atomicAdd(&(bar)[XB_TMO], 1u); break; } } } } while (0)

struct XcdBarrier {
    unsigned* bar; unsigned x;
    volatile LAS unsigned* st;
};

__device__ __forceinline__ XcdBarrier xcd_barrier_post(unsigned* bar, volatile LAS unsigned* st) {
    XcdBarrier b; b.bar = bar; b.x = xb_xcc_id(); b.st = st;
    if (threadIdx.x == 0) (void)xb_add(&bar[XB_XCNT(b.x)], 1u);
    return b;
}
__device__ __forceinline__ void xcd_barrier_complete(unsigned* bar, unsigned x, unsigned& nloc, unsigned& nx) {
    const unsigned G = gridDim.x * gridDim.y * gridDim.z;
    unsigned sum, cnt, mine, sp = 0u;
    for (;;) {
        sum = 0u; cnt = 0u; mine = 0u;
#pragma unroll
        for (unsigned j = 0; j < 16; ++j) { const unsigned c = xb_ld(&bar[XB_XCNT(j)]); sum += c; cnt += (c > 0u) ? 1u : 0u; mine = (j == x) ? c : mine; }
        if (sum == G) break;
        __builtin_amdgcn_s_sleep(1);
        if ((++sp & 255u) == 0u) { if (xb_ld(&bar[XB_TMO])) break; if (sp > XB_SPIN_CAP) { atomicAdd(&bar[XB_TMO], 1u); break; } }
    }
    nloc = mine > 0u ? mine : 1u; nx = cnt > 0u ? cnt : 1u;
}

__device__ __forceinline__ void xcd_barrier(const XcdBarrier& b) {
    asm volatile("s_waitcnt vmcnt(0)" ::: "memory");
    __syncthreads();
    if (threadIdx.x == 0) {
        unsigned* bar = b.bar;
        __builtin_amdgcn_s_waitcnt(0);
        unsigned nloc = b.st[0], nx = b.st[1];
        if (nloc == 0u) { xcd_barrier_complete(bar, b.x, nloc, nx); b.st[0] = nloc; b.st[1] = nx; }
        const unsigned old = xb_add(&bar[XB_XSUB(b.x)], 1u);
        const unsigned gen = old / nloc;
        if (old + 1u == (gen + 1u) * nloc) {
            __builtin_amdgcn_fence(__ATOMIC_RELEASE, "agent");
            asm volatile("s_waitcnt vmcnt(0)" ::: "memory");
            const unsigned og = xb_add(&bar[XB_TOP], 1u);
            const unsigned tg = og / nx;
            if (og + 1u == (tg + 1u) * nx) xb_add(&bar[XB_TOPGEN], 1u);
            else XB_SPIN(xb_ld(&bar[XB_TOPGEN]) == tg, bar);
            __builtin_amdgcn_fence(__ATOMIC_ACQUIRE, "agent");
            xb_add(&bar[XB_XGEN(b.x)], 1u);
            asm volatile("s_waitcnt vmcnt(0)" ::: "memory");
        } else {
            XB_SPIN(xb_ld(&bar[XB_XGEN(b.x)]) == gen, bar);
            __builtin_amdgcn_fence(__ATOMIC_ACQUIRE, "agent");
            asm volatile("s_waitcnt vmcnt(0)" ::: "memory");
        }
    }
    __syncthreads();
}
__device__ __forceinline__ float wave_sum(float v) {
#pragma unroll
    for (int o = 1; o < 64; o <<= 1) v += __shfl_xor(v, o);
    return v;
}
__device__ __forceinline__ float wave_max(float v) {
#pragma unroll
    for (int o = 1; o < 64; o <<= 1) v = fmaxf(v, __shfl_xor(v, o));
    return v;
}
__device__ __forceinline__ void p0_transpose_item(const float* W, int K, int N, bf16* WT, const float* ks, LAS float* scr, int item, int lane) {
    const int nblk = N / 32, kb = item / nblk, nb = item % nblk, k0 = 64 * kb, n0 = 32 * nb;
#pragma unroll 8
    for (int i = 0; i < 32; ++i) { const int kk = 2 * i + (lane >> 5); float w = W[(size_t)(k0 + kk) * N + n0 + (lane & 31)]; if (ks) w *= ks[k0 + kk]; scr[kk * 33 + (lane & 31)] = w; }
    LDS_WAIT(); asm volatile("" ::: "memory");
    const int c = lane & 7;
#pragma unroll
    for (int j = 0; j < 4; ++j) { const int n = (lane >> 3) + 8 * j; const LAS float* s = scr + (8 * c) * 33 + n;
        v4u o; o.x = pk2(s[0 * 33], s[1 * 33]); o.y = pk2(s[2 * 33], s[3 * 33]); o.z = pk2(s[4 * 33], s[5 * 33]); o.w = pk2(s[6 * 33], s[7 * 33]);
        *(GAS v4u*)(WT + (size_t)(n0 + n) * K + k0 + 8 * c) = o; }
    LDS_WAIT(); asm volatile("" ::: "memory");
}

struct Ptrs {
    const float* in[30]; float* out; unsigned char* ws;
};
#define WSP(T, off) ((T*)(P.ws + (off)))

__device__ __forceinline__ void p0_prologue(const Ptrs& P, LAS unsigned char* lds, int tid, int lane, int wave, int vcu, int G) {
    LAS float* scr = (LAS float*)(lds + RING_OFF + wave * 16384);
    const int gw = vcu * NWAVES + wave, NGW = G * NWAVES;
    constexpr int I0 = (DM / 64) * (NIN / 32), I1 = (MW / 64) * (DM / 32), I2 = (DM / 64) * (DM / 32), I3 = I2, I4 = (DM / 64) * (FF / 32), I5 = (FF / 64) * (DM / 32), I6 = I2, I7 = (PLE / 64) * (DM / 32);
    constexpr int NITEMS = I0 + I1 + I2 + I3 + I4 + I5 + I6 + I7;
    for (int it = gw; it < NITEMS; it += NGW) {
        int r = it;
        if (r < I0) { p0_transpose_item(P.in[11], DM, NIN, WSP(bf16, WS_WIN), nullptr, scr, r, lane); continue; } r -= I0;
        if (r < I1) { p0_transpose_item(P.in[14], MW, DM, WSP(bf16, WS_WOA), nullptr, scr, r, lane); continue; } r -= I1;
        if (r < I2) { p0_transpose_item(P.in[22], DM, DM, WSP(bf16, WS_WOB), nullptr, scr, r, lane); continue; } r -= I2;
        if (r < I3) { p0_transpose_item(P.in[23], DM, DM, WSP(bf16, WS_WO), nullptr, scr, r, lane); continue; } r -= I3;
        if (r < I4) { p0_transpose_item(P.in[25], DM, FF, WSP(bf16, WS_WUP), P.in[24], scr, r, lane); continue; } r -= I4;
        if (r < I5) { p0_transpose_item(P.in[26], FF, DM, WSP(bf16, WS_WDN), nullptr, scr, r, lane); continue; } r -= I5;
        if (r < I6) { p0_transpose_item(P.in[28], DM, DM, WSP(bf16, WS_WPG), P.in[27], scr, r, lane); continue; } r -= I6;
        p0_transpose_item(P.in[29], PLE, DM, WSP(bf16, WS_WPE), nullptr, scr, r, lane);
    }
    { const GAS f32x4* gm = (const GAS f32x4*)P.in[10] + lane; f32x4 g[4];
#pragma unroll
      for (int j = 0; j < 4; ++j) g[j] = gm[64 * j];
      bf16* HB = WSP(bf16, WS_HB);
      for (int m = gw; m < M; m += NGW) {
        const float* xrow = (m < MP) ? P.in[0] + (size_t)m * DM : P.in[1] + (size_t)(m - MP) * DM;
        const GAS f32x4* xr = (const GAS f32x4*)xrow + lane; f32x4 v[4]; float s = 0.f;
#pragma unroll
        for (int j = 0; j < 4; ++j) { v[j] = xr[64 * j]; s += (v[j].x * v[j].x + v[j].y * v[j].y) + (v[j].z * v[j].z + v[j].w * v[j].w); }
        const float rs = 1.0f / sqrtf(wave_sum(s) * (1.f / DM) + 1e-6f);
        GAS v2u* o8 = (GAS v2u*)(HB + (size_t)m * DM) + lane;
#pragma unroll
        for (int j = 0; j < 4; ++j) { v2u w; w.x = pk2(v[j].x * rs * g[j].x, v[j].y * rs * g[j].y); w.y = pk2(v[j].z * rs * g[j].z, v[j].w * rs * g[j].w); o8[64 * j] = w; }
      }
      bf16* PB = WSP(bf16, WS_PB);
      for (int m = gw; m < M; m += NGW) {
        const float* prow = (m < MP) ? P.in[2] + (size_t)m * PLE : P.in[3] + (size_t)(m - MP) * PLE;
        const f32x4 v = ((const GAS f32x4*)prow)[lane]; v2u w; w.x = pk2(v.x, v.y); w.y = pk2(v.z, v.w); ((GAS v2u*)(PB + (size_t)m * PLE))[lane] = w;
      }
    }
    const int gt = vcu * (NWAVES * 64) + tid, NT = G * NWAVES * 64;
    { bf16* WRG = WSP(bf16, WS_WRG);
      for (int e = gt; e < 2 * 65536; e += NT) { const int mat = e >> 16, n = (e >> 12) & 15, o = (e >> 6) & 63, i = e & 63;
          WRG[e] = (bf16)f2bf(P.in[mat ? 19 : 17][(n * 64 + i) * 64 + o]); }
      float* TAB = WSP(float, WS_TAB);
      for (int e = gt; e < 12 * 132; e += NT) { const int hh = e / 132, j = e % 132; float v = 0.f;
          if (j <= 128) { const int g = hh >> 2, dist = j << (2 * g); int bk;
              if (dist < 16) bk = dist; else { const double lg = log((double)dist / 16.0) / log(128.0) * 16.0; bk = 16 + (int)lg; if (bk > 31) bk = 31; }
              v = P.in[9][bk * 12 + hh] * 1.4426950408889634f; }
          TAB[e] = v; }
      for (int e = gt; e < 1024; e += NT) { const double x = (double)P.in[21][e]; const double ls = (x >= 0.0) ? -log1p(exp(-x)) : x - log1p(exp(x)); TAB[2048 + e] = (float)(8.0 * ls); }
    }
}

__device__ __forceinline__ unsigned offb(unsigned row, unsigned ch) { return 256u * row + 16u * (ch ^ (((row & 3u) << 2) | ((row >> 2) & 3u))); }
__device__ __forceinline__ s16x4 vtr(LAS const unsigned char* p) { typedef short v4i16_t __attribute__((ext_vector_type(4))); return __builtin_bit_cast(s16x4, __builtin_amdgcn_ds_read_tr16_b64_v4i16((LAS v4i16_t*)p)); }

__device__ __forceinline__ void attn_unit(const Ptrs& P, LAS unsigned char* lds, int uid, int tid, int lane, int w) {
    const int blk = uid & 63, h4 = (uid >> 6) & 3, b = (uid >> 8) & 7, g = uid >> 11;
    const int gsh = 2 * g, hh = 4 * g + h4;
    const bool first = (blk & ((64 >> gsh) - 1)) == 0;
    const size_t qrow0 = ((size_t)(b * 12 + hh) << 13) + (size_t)blk * 128;
    const bf16* Qb = WSP(bf16, WS_Q); const bf16* Kb = WSP(bf16, WS_K); const bf16* Vb = WSP(bf16, WS_V);
    LAS unsigned char* Kimg = lds; LAS unsigned char* Vimg = lds + 65536;
    const LAS float* bias = (const LAS float*)(lds + XCH_OFF) + hh * 132;
    const int qi = lane & 15, g4 = lane >> 4;
    {
        const int lr = lane >> 4, sl = lane & 15;
#pragma unroll
        for (int i = 0; i < 8; ++i) { const int p = w * 8 + i, row = 4 * p + lr; const int ch = sl ^ ((lr << 2) | (p & 3));
            const size_t srow = (first && row < 128) ? qrow0 + row : qrow0 - 128 + row;
            __builtin_amdgcn_global_load_lds((const unsigned*)((const char*)Kb + srow * 256 + ch * 16), (LAS unsigned*)(Kimg + p * 1024), 16, 0, 0);
            __builtin_amdgcn_global_load_lds((const unsigned*)((const char*)Vb + srow * 256 + ch * 16), (LAS unsigned*)(Vimg + p * 1024), 16, 0, 0); }
    }
    bf16x8 Qf[4];
    { const bf16* qp = Qb + (qrow0 + 16 * w + qi) * 128 + 8 * g4;
#pragma unroll
      for (int s = 0; s < 4; ++s) Qf[s] = *(const bf16x8*)(qp + 32 * s); }
    VM_WAIT(); __syncthreads();
    f32x4 S[9];
    { const unsigned fl = ((lane & 3) << 2) | ((lane >> 2) & 3);
      const LAS unsigned char* kp = Kimg + 256 * (16 * w + qi);
#pragma unroll
      for (int jb = 0; jb < 9; ++jb) { S[jb] = (f32x4){0.f, 0.f, 0.f, 0.f};
#pragma unroll
          for (int s = 0; s < 4; ++s) { const bf16x8 a = *(const LAS bf16x8*)(kp + jb * 4096 + 16 * ((4 * s + g4) ^ fl));
              S[jb] = __builtin_amdgcn_mfma_f32_16x16x32_bf16(a, Qf[s], S[jb], 0, 0, 0); } } }
    float mx = -1e30f;
#pragma unroll
    for (int jb = 0; jb < 9; ++jb)
#pragma unroll
        for (int i = 0; i < 4; ++i) { const int ki = 4 * g4 + i, rel = 16 * jb + ki - qi;
            int slot = 128 - rel; slot = slot < 0 ? 0 : (slot > 128 ? 128 : slot);
            bool ok = true; if (jb == 0) ok = rel >= 0; if (jb == 8) ok = rel <= 128;
            if (first) ok = ok && (16 * w + 16 * jb + ki >= 128);
            const float v = ok ? S[jb][i] + bias[slot] : -1e30f; S[jb][i] = v; mx = fmaxf(mx, v); }
    mx = fmaxf(mx, __shfl_xor(mx, 16)); mx = fmaxf(mx, __shfl_xor(mx, 32));
    float tot = 0.f;
#pragma unroll
    for (int jb = 0; jb < 9; ++jb)
#pragma unroll
        for (int i = 0; i < 4; ++i) { const float p = fexp2(S[jb][i] - mx); S[jb][i] = p; tot += p; }
    tot += __shfl_xor(tot, 16); tot += __shfl_xor(tot, 32);
    bf16x8 Pf[5];
#pragma unroll
    for (int ks = 0; ks < 5; ++ks) { v4u pk; pk.x = pk2(S[2 * ks][0], S[2 * ks][1]); pk.y = pk2(S[2 * ks][2], S[2 * ks][3]);
        if (ks < 4) { pk.z = pk2(S[2 * ks + 1][0], S[2 * ks + 1][1]); pk.w = pk2(S[2 * ks + 1][2], S[2 * ks + 1][3]); } else { pk.z = 0u; pk.w = 0u; }
        Pf[ks] = __builtin_bit_cast(bf16x8, pk); }
    f32x4 O[8];
#pragma unroll
    for (int c = 0; c < 8; ++c) O[c] = (f32x4){0.f, 0.f, 0.f, 0.f};
    { const int q = (lane & 15) >> 2, p = lane & 3; const unsigned fl = ((unsigned)q << 2) | (unsigned)g4;
      const LAS unsigned char* vp = Vimg + 256 * (16 * w + 4 * g4 + q) + 8 * (p & 1);
#pragma unroll
      for (int ks = 0; ks < 5; ++ks)
#pragma unroll
          for (int c = 0; c < 8; ++c) { const unsigned co = 16u * (((unsigned)(2 * c + (p >> 1))) ^ fl);
              const s16x4 lo = vtr(vp + 256 * (32 * ks) + co);
              const s16x4 hi = vtr(vp + 256 * (32 * ks + (ks < 4 ? 16 : 0)) + co);
              const bf16x8 a = (bf16x8){lo[0], lo[1], lo[2], lo[3], hi[0], hi[1], hi[2], hi[3]};
              O[c] = __builtin_amdgcn_mfma_f32_16x16x32_bf16(a, Pf[ks], O[c], 0, 0, 0); } }
    const float inv = frcp(tot);
    const int mq = (blk & ((64 >> gsh) - 1)) * 128 + 16 * w + qi, rr = blk >> (6 - gsh);
    const size_t R = (size_t)b * SEQ + ((size_t)mq << gsh) + rr;
    bf16* og = WSP(bf16, WS_OG) + ((size_t)g * MP + R) * MW + h4 * 128 + 4 * g4;
#pragma unroll
    for (int c = 0; c < 8; ++c) { v2u o; o.x = pk2(O[c][0] * inv, O[c][1] * inv); o.y = pk2(O[c][2] * inv, O[c][3] * inv); *(GAS v2u*)(og + 16 * c) = o; }
    if (g4 == 0) WSP(float, WS_LSE)[((size_t)g * MP + R) * 4 + h4] = mx + __log2f(tot);
    __syncthreads();
}

__device__ __forceinline__ void sattn_unit(const Ptrs& P, LAS unsigned char* lds, int su, int tid, int lane, int w) {
    const int b = su >> 2, t = su & 3; const int h = lane >> 4, sub = lane & 15;
    LAS float* LG = (LAS float*)lds;
    LAS float* PART = (LAS float*)(lds + 8192);
    const LAS float* bias = (const LAS float*)(lds + XCH_OFF);
    const float* QS = WSP(float, WS_QS) + (size_t)su * AW;
    const float* caches[3] = {P.in[4], P.in[5], P.in[6]};
#pragma unroll
    for (int g = 0; g < 3; ++g) {
        const int gsh = 2 * g, nbuf = 128 << gsh; const float* cache = caches[g]; const float* knew = P.out + pg8::kvs_off(g);
        const f32x4 q0 = *(const f32x4*)(QS + (4 * g + h) * 128 + 8 * sub), q1 = *(const f32x4*)(QS + (4 * g + h) * 128 + 8 * sub + 4);
        for (int j = w; j < 129; j += 8) { const int ridx = nbuf + t - (j << gsh);
            const float* rp = (ridx >= nbuf) ? knew + (size_t)(b * 4 + (ridx - nbuf)) * 1024 : cache + ((size_t)b * nbuf + ridx) * 1024;
            const f32x4 k0 = *(const f32x4*)(rp + h * 128 + 8 * sub), k1 = *(const f32x4*)(rp + h * 128 + 8 * sub + 4);
            float d = (q0[0] * k0[0] + q0[1] * k0[1]) + (q0[2] * k0[2] + q0[3] * k0[3]) + (q1[0] * k1[0] + q1[1] * k1[1]) + (q1[2] * k1[2] + q1[3] * k1[3]);
            d += __shfl_xor(d, 1); d += __shfl_xor(d, 2); d += __shfl_xor(d, 4); d += __shfl_xor(d, 8);
            if (sub == 0) LG[h * 392 + g * 129 + j] = d + bias[(4 * g + h) * 132 + j]; }
    }
    LDS_WAIT(); __syncthreads();
    float mxh = 0.f, invh = 0.f;
#pragma unroll
    for (int hd = 0; hd < 4; ++hd) { float m = -1e30f;
        for (int i = lane; i < 387; i += 64) m = fmaxf(m, LG[hd * 392 + i]);
        m = wave_max(m); float s = 0.f;
        for (int i = lane; i < 387; i += 64) s += fexp2(LG[hd * 392 + i] - m);
        s = wave_sum(s); if (hd == h) { mxh = m; invh = 1.0f / s; } }
    float acc[8];
#pragma unroll
    for (int i = 0; i < 8; ++i) acc[i] = 0.f;
#pragma unroll
    for (int g = 0; g < 3; ++g) {
        const int gsh = 2 * g, nbuf = 128 << gsh; const float* cache = caches[g]; const float* knew = P.out + pg8::kvs_off(g);
        for (int j = w; j < 129; j += 8) { const int ridx = nbuf + t - (j << gsh);
            const float* rp = (ridx >= nbuf) ? knew + (size_t)(b * 4 + (ridx - nbuf)) * 1024 : cache + ((size_t)b * nbuf + ridx) * 1024;
            const f32x4 v0 = *(const f32x4*)(rp + 512 + h * 128 + 8 * sub), v1 = *(const f32x4*)(rp + 512 + h * 128 + 8 * sub + 4);
            const float p = fexp2(LG[h * 392 + g * 129 + j] - mxh) * invh;
#pragma unroll
            for (int i = 0; i < 4; ++i) { acc[i] += p * v0[i]; acc[4 + i] += p * v1[i]; } }
    }
#pragma unroll
    for (int i = 0; i < 8; ++i) PART[w * 512 + lane * 8 + i] = acc[i];
    LDS_WAIT(); __syncthreads();
    { float s = 0.f;
#pragma unroll
      for (int k = 0; k < 8; ++k) s += PART[k * 512 + tid];
      WSP(bf16, WS_ATT)[(size_t)(MP + su) * MW + tid] = (bf16)f2bf(s); }
    __syncthreads();
}

__device__ __forceinline__ int crow(int r, int hi) { return (r & 3) + 8 * (r >> 2) + 4 * hi; }
template <bool OUT> __device__ __forceinline__ void lru_unit(const Ptrs& P, LAS unsigned char* lds, int b, int n, int rg, int tid, int lane, int w) {
    LAS unsigned char* AIMG = lds;
    LAS float* XC32 = (LAS float*)(lds + 16384);
    LAS float* HST = (LAS float*)(lds + 49152);
    LAS float* SUM = (LAS float*)(lds + 81920);
    LAS float* WC = (LAS float*)(lds + 84992);
    const int ch0 = 64 * n, tb = w >> 1, cb = w & 1, cl = lane & 31, hi = lane >> 5, mych = ch0 + 32 * cb + cl;
    if (tid < 320) { const int k = tid >> 6, i = tid & 63; WC[tid] = (k < 4) ? P.in[15][k * 1024 + ch0 + i] : P.in[16][ch0 + i]; }
    const bf16* WRG = WSP(bf16, WS_WRG);
    bf16x8 Bfa[4], Bfi[4];
#pragma unroll
    for (int s = 0; s < 4; ++s) { Bfa[s] = *(const bf16x8*)(WRG + ((size_t)(n * 64 + 32 * cb + cl) * 64 + 16 * s + 8 * hi));
                                  Bfi[s] = *(const bf16x8*)(WRG + 65536 + ((size_t)(n * 64 + 32 * cb + cl) * 64 + 16 * s + 8 * hi)); }
    const float ba = P.in[18][mych], bi = P.in[20][mych], c8l = WSP(float, WS_TAB)[2048 + mych] * 1.4426950408889634f;
    float hstate = (OUT && rg == 1) ? WSP(float, WS_TAB)[4096 + b * 1024 + mych] : 0.f;
    const int tl = tid >> 2, cg = tid & 3;
    const bf16* XB = WSP(bf16, WS_XB); const bf16* GY = WSP(bf16, WS_GY); bf16* HRG = WSP(bf16, WS_HRG);
    v4u xv[4][2];
    const int tbase = rg * 4096;
    { const int t0 = tbase;
#pragma unroll
      for (int k = 0; k < 4; ++k) { const int t = t0 + tl - 3 + k;
          if (t >= 0) { const v4u* p = (const v4u*)(XB + ((size_t)b * SEQ + t) * DM + ch0 + 16 * cg); xv[k][0] = p[0]; xv[k][1] = p[1]; }
          else { xv[k][0] = (v4u){0u, 0u, 0u, 0u}; xv[k][1] = (v4u){0u, 0u, 0u, 0u}; } } }
    LDS_WAIT(); __syncthreads();
    for (int ci = 0; ci < 32; ++ci) {
        const int t0 = tbase + ci * 128; const size_t R0 = (size_t)b * SEQ + t0;
        {
            float xc[16];
#pragma unroll
            for (int q = 0; q < 4; ++q) { const f32x4 bc = *(const LAS f32x4*)(WC + 256 + 16 * cg + 4 * q); xc[4 * q] = bc[0]; xc[4 * q + 1] = bc[1]; xc[4 * q + 2] = bc[2]; xc[4 * q + 3] = bc[3]; }
#pragma unroll
            for (int k = 0; k < 4; ++k)
#pragma unroll
                for (int q = 0; q < 4; ++q) { const f32x4 wv = *(const LAS f32x4*)(WC + 64 * k + 16 * cg + 4 * q);
                    const unsigned u0 = xv[k][q >> 1][(q & 1) * 2], u1 = xv[k][q >> 1][(q & 1) * 2 + 1];
                    xc[4 * q] += wv[0] * bflo(u0); xc[4 * q + 1] += wv[1] * bfhi(u0); xc[4 * q + 2] += wv[2] * bflo(u1); xc[4 * q + 3] += wv[3] * bfhi(u1); }
#pragma unroll
            for (int q = 0; q < 4; ++q) *(LAS f32x4*)(XC32 + tl * 64 + 16 * cg + 4 * q) = (f32x4){xc[4 * q], xc[4 * q + 1], xc[4 * q + 2], xc[4 * q + 3]};
#pragma unroll
            for (int e = 0; e < 2; ++e) { v4u o; o.x = pk2(xc[8 * e], xc[8 * e + 1]); o.y = pk2(xc[8 * e + 2], xc[8 * e + 3]); o.z = pk2(xc[8 * e + 4], xc[8 * e + 5]); o.w = pk2(xc[8 * e + 6], xc[8 * e + 7]);
                *(LAS v4u*)(AIMG + tl * 128 + 16 * ((2 * cg + e) ^ ((tl >> 1) & 7))) = o; }
        }
        v4u gy0, gy1;
        if (OUT) { const v4u* p = (const v4u*)(GY + (R0 + tl) * DM + ch0 + 16 * cg); gy0 = p[0]; gy1 = p[1]; }
        if (ci + 1 < 32) {
#pragma unroll
            for (int k = 0; k < 4; ++k) { const v4u* p = (const v4u*)(XB + (R0 + 128 + tl - 3 + k) * DM + ch0 + 16 * cg); xv[k][0] = p[0]; xv[k][1] = p[1]; } }
        LDS_WAIT(); __syncthreads();
        f32x16 za, zi;
#pragma unroll
        for (int i = 0; i < 16; ++i) { za[i] = 0.f; zi[i] = 0.f; }
        { const int row = 32 * tb + cl;
#pragma unroll
          for (int s = 0; s < 4; ++s) { const bf16x8 a = *(const LAS bf16x8*)(AIMG + row * 128 + 16 * ((2 * s + hi) ^ ((row >> 1) & 7)));
              za = __builtin_amdgcn_mfma_f32_32x32x16_bf16(a, Bfa[s], za, 0, 0, 0); zi = __builtin_amdgcn_mfma_f32_32x32x16_bf16(a, Bfi[s], zi, 0, 0, 0); } }
        float av[16], bv[16];
#pragma unroll
        for (int i = 0; i < 16; ++i) { const float xcv = XC32[(32 * tb + crow(i, hi)) * 64 + 32 * cb + cl];
            const float r = sigm(za[i] + ba), ig = sigm(zi[i] + bi); const float a = fexp2(c8l * r); av[i] = a; bv[i] = sqrtf(fmaxf(1.0f - a * a, 0.f)) * (ig * xcv); }
        float As[4], Bs[4], pAs[4], pBs[4], preA[4], preB[4];
#pragma unroll
        for (int sg = 0; sg < 4; ++sg) { float A = 1.f, B = 0.f;
#pragma unroll
            for (int e = 0; e < 4; ++e) { B = av[4 * sg + e] * B + bv[4 * sg + e]; A = av[4 * sg + e] * A; }
            As[sg] = A; Bs[sg] = B; pAs[sg] = __shfl_xor(A, 32); pBs[sg] = __shfl_xor(B, 32); }
        float PA = 1.f, PB = 0.f;
#pragma unroll
        for (int sg = 0; sg < 4; ++sg) {
            const float fA = hi ? pAs[sg] : As[sg], fB = hi ? pBs[sg] : Bs[sg], sA = hi ? As[sg] : pAs[sg], sB = hi ? Bs[sg] : pBs[sg];
            const float PB1 = fA * PB + fB, PA1 = fA * PA;
            preA[sg] = hi ? PA1 : PA; preB[sg] = hi ? PB1 : PB;
            PB = sA * PB1 + sB; PA = sA * PA1; }
        if (hi == 0) { SUM[(tb * 64 + 32 * cb + cl) * 2] = PA; SUM[(tb * 64 + 32 * cb + cl) * 2 + 1] = PB; }
        LDS_WAIT(); __syncthreads();
        float hin = hstate, hnew = hstate;
#pragma unroll
        for (int t = 0; t < 4; ++t) { const float A = SUM[(t * 64 + 32 * cb + cl) * 2], B = SUM[(t * 64 + 32 * cb + cl) * 2 + 1];
            hnew = A * hnew + B; if (t < tb) hin = hnew; }
        hstate = hnew;
        if (OUT) {
#pragma unroll
            for (int sg = 0; sg < 4; ++sg) { float hc = preA[sg] * hin + preB[sg];
#pragma unroll
                for (int e = 0; e < 4; ++e) { hc = av[4 * sg + e] * hc + bv[4 * sg + e]; HST[(32 * tb + 8 * sg + 4 * hi + e) * 64 + 32 * cb + cl] = hc; } }
            LDS_WAIT(); __syncthreads();
            f32x4 hv[4];
#pragma unroll
            for (int q = 0; q < 4; ++q) hv[q] = *(const LAS f32x4*)(HST + tl * 64 + 16 * cg + 4 * q);
            v4u o0, o1;
            o0.x = pk2(hv[0][0] * bflo(gy0.x), hv[0][1] * bfhi(gy0.x)); o0.y = pk2(hv[0][2] * bflo(gy0.y), hv[0][3] * bfhi(gy0.y));
            o0.z = pk2(hv[1][0] * bflo(gy0.z), hv[1][1] * bfhi(gy0.z)); o0.w = pk2(hv[1][2] * bflo(gy0.w), hv[1][3] * bfhi(gy0.w));
            o1.x = pk2(hv[2][0] * bflo(gy1.x), hv[2][1] * bfhi(gy1.x)); o1.y = pk2(hv[2][2] * bflo(gy1.y), hv[2][3] * bfhi(gy1.y));
            o1.z = pk2(hv[3][0] * bflo(gy1.z), hv[3][1] * bfhi(gy1.z)); o1.w = pk2(hv[3][2] * bflo(gy1.w), hv[3][3] * bfhi(gy1.w));
            v4u* op = (v4u*)(HRG + (R0 + tl) * DM + ch0 + 16 * cg); op[0] = o0; op[1] = o1;
        }
    }
    if (tb == 0 && hi == 0) {
        if (!OUT) WSP(float, WS_TAB)[4096 + b * 1024 + mych] = hstate;
        else if (rg == 1) P.out[pg8::O_LRUP + (size_t)b * 1024 + mych] = hstate;
    }
    __syncthreads();
}

__device__ __forceinline__ void lru_sample(const Ptrs& P, int gt) {
    const int b = gt >> 10, ch = gt & 1023, n = ch >> 6, o = ch & 63;
    const float* XBS = WSP(float, WS_XBS); const float* sc = P.in[7] + (size_t)b * 3 * 1024; const float* wcv = P.in[15]; const float* bcv = P.in[16];
    float za[4] = {0.f, 0.f, 0.f, 0.f}, zi[4] = {0.f, 0.f, 0.f, 0.f}, xo[4] = {0.f, 0.f, 0.f, 0.f};
    for (int i = 0; i < 64; ++i) { const int c = 64 * n + i;
        float xcat[7];
#pragma unroll
        for (int k = 0; k < 3; ++k) xcat[k] = sc[k * 1024 + c];
#pragma unroll
        for (int k = 0; k < 4; ++k) xcat[3 + k] = XBS[(size_t)(4 * b + k) * 1024 + c];
        const float w0 = wcv[c], w1 = wcv[1024 + c], w2 = wcv[2048 + c], w3 = wcv[3072 + c], bc = bcv[c];
        const float wa = P.in[17][(n * 64 + i) * 64 + o], wi = P.in[19][(n * 64 + i) * 64 + o];
#pragma unroll
        for (int t = 0; t < 4; ++t) { const float xc = bc + w0 * xcat[t] + w1 * xcat[t + 1] + w2 * xcat[t + 2] + w3 * xcat[t + 3];
            za[t] += xc * wa; zi[t] += xc * wi; xo[t] = (i == o) ? xc : xo[t]; } }
    const float ba = P.in[18][ch], bi = P.in[20][ch], c8l = WSP(float, WS_TAB)[2048 + ch] * 1.4426950408889634f;
    float h = P.in[8][(size_t)b * 1024 + ch];
    const bf16* GY = WSP(bf16, WS_GY); bf16* HRG = WSP(bf16, WS_HRG);
#pragma unroll
    for (int t = 0; t < 4; ++t) { const float r = sigm(za[t] + ba), ig = sigm(zi[t] + bi), a = fexp2(c8l * r);
        h = a * h + sqrtf(fmaxf(1.0f - a * a, 0.f)) * (ig * xo[t]);
        const size_t idx = (size_t)(MP + 4 * b + t) * DM + ch;
        HRG[idx] = (bf16)f2bf(h * __uint_as_float((unsigned)GY[idx] << 16)); }
    P.out[pg8::O_LRUS + (size_t)b * 1024 + ch] = h;
}

__device__ __forceinline__ void combine_items(const Ptrs& P, int gt, int NT) {
    const bf16* OG = WSP(bf16, WS_OG); const float* LSE = WSP(float, WS_LSE); bf16* ATT = WSP(bf16, WS_ATT);
    for (int it = gt; it < MP * 64; it += NT) { const int R = it >> 6, ck = it & 63, h4 = ck >> 4;
        const float l0 = LSE[((size_t)0 * MP + R) * 4 + h4], l1 = LSE[((size_t)1 * MP + R) * 4 + h4], l2 = LSE[((size_t)2 * MP + R) * 4 + h4];
        const float mx = fmaxf(l0, fmaxf(l1, l2)); float w0 = fexp2(l0 - mx), w1 = fexp2(l1 - mx), w2 = fexp2(l2 - mx); const float inv = 1.0f / (w0 + w1 + w2); w0 *= inv; w1 *= inv; w2 *= inv;
        const v4u a = *(const v4u*)(OG + ((size_t)0 * MP + R) * MW + ck * 8), bq = *(const v4u*)(OG + ((size_t)1 * MP + R) * MW + ck * 8), c = *(const v4u*)(OG + ((size_t)2 * MP + R) * MW + ck * 8);
        v4u o;
        o.x = pk2(w0 * bflo(a.x) + w1 * bflo(bq.x) + w2 * bflo(c.x), w0 * bfhi(a.x) + w1 * bfhi(bq.x) + w2 * bfhi(c.x));
        o.y = pk2(w0 * bflo(a.y) + w1 * bflo(bq.y) + w2 * bflo(c.y), w0 * bfhi(a.y) + w1 * bfhi(bq.y) + w2 * bfhi(c.y));
        o.z = pk2(w0 * bflo(a.z) + w1 * bflo(bq.z) + w2 * bflo(c.z), w0 * bfhi(a.z) + w1 * bfhi(bq.z) + w2 * bfhi(c.z));
        o.w = pk2(w0 * bflo(a.w) + w1 * bflo(bq.w) + w2 * bflo(c.w), w0 * bfhi(a.w) + w1 * bfhi(bq.w) + w2 * bfhi(c.w));
        *(v4u*)(ATT + (size_t)R * MW + ck * 8) = o; }
}
struct Args { const float* in[30]; float* out; unsigned char* ws; int ph_lo, ph_hi; };
__global__ void __launch_bounds__(NWAVES * 64, 2) fwd_kernel(Args args) {
    extern __shared__ __attribute__((aligned(16))) unsigned char lds_raw[];
    LAS unsigned char* lds = (LAS unsigned char*)lds_raw;
    volatile LAS unsigned* MISC = (volatile LAS unsigned*)(lds + MISC_OFF);
    const int tid0 = threadIdx.x; const int wave0 = __builtin_amdgcn_readfirstlane(tid0 >> 6);
    const int G = gridDim.x, bx = blockIdx.x; const int vcu = (G % 8 == 0) ? (bx % 8) * (G / 8) + bx / 8 : bx;
    typedef __attribute__((address_space(4))) const Args* KArgs;
    KArgs ap0 = (KArgs)__builtin_amdgcn_kernarg_segment_ptr();
    gu32* ctl = (gu32*)(args.ws + WS_CTL);
    for (int u = tid0; u < 32; u += NWAVES * 64) MISC[u] = 0u;
    __syncthreads();
    XcdBarrier bar; bar.bar = (unsigned*)(ctl + CW_BAR); bar.x = 0; bar.st = nullptr;
    if (N_LAUNCHES != PER_PHASE) bar = xcd_barrier_post((unsigned*)(ctl + CW_BAR), MISC + 8);
#define GRID_BAR() do { if (N_LAUNCHES != PER_PHASE) xcd_barrier(bar); } while (0)
    const int lo = args.ph_lo, hi = args.ph_hi;
#ifndef PH_MASK
#define PH_MASK 0x1ff
#endif
#define IN(k) (((PH_MASK >> (k)) & 1) && lo <= (k) && (k) < hi)
#define BOTH(k) (IN(k) && IN((k) + 1))
    LAS float* XCH = (LAS float*)(lds + XCH_OFF);
    const int NT = G * NWAVES * 64;

#define LOAD_P() KArgs ap = ap0; asm volatile("" : "+s"(ap)); Ptrs P; _Pragma("unroll") for (int i_ = 0; i_ < 30; ++i_) P.in[i_] = ap->in[i_]; P.out = ap->out; P.ws = ap->ws
#define OPAQUE_TID() LOAD_P(); int tid = (wave0 << 6) | (int)__builtin_amdgcn_mbcnt_hi(~0u, __builtin_amdgcn_mbcnt_lo(~0u, 0u)); asm volatile("" : "+v"(tid)); const int lane = tid & 63, wave = wave0; const int gt = vcu * (NWAVES * 64) + tid
    if (IN(0)) { OPAQUE_TID(); p0_prologue(P, lds, tid, lane, wave, vcu, G); if (BOTH(0)) GRID_BAR(); }

    if (IN(1)) {
        LOAD_P();
        pg8::Gemm g{WSP(pg8::bf16_t, WS_HB), WSP(pg8::bf16_t, WS_WIN), M, NIN, DM}; pg8::StaticOrder S; S.init(M, NIN, G, bx);
        pg8::Epi1 E{P.ws, P.out, P.in[12], P.in[13], XCH};
        pg8::gemm_phase<pg8::Epi1, pg8::StaticOrder, true, true>(lds + RING_OFF, g, S, E, wave0);
        if (BOTH(1)) GRID_BAR();
    }

    if (IN(2)) {
        OPAQUE_TID();
        { const float* TAB = WSP(float, WS_TAB); for (int e = tid; e < 12 * 132; e += NWAVES * 64) XCH[e] = TAB[e]; }
        LDS_WAIT(); __syncthreads();
        if (vcu < 128) lru_unit<false>(P, lds, vcu >> 4, vcu & 15, 0, tid, lane, wave);
        for (int su = vcu; su < MS; su += G) sattn_unit(P, lds, su, tid, lane, wave);
        { const int per = (6144 + G - 1) / G; const int u0 = vcu * per, u1 = (u0 + per < 6144) ? u0 + per : 6144;
          for (int u = u0; u < u1; ++u) attn_unit(P, lds, u, tid, lane, wave); }
        if (BOTH(2)) GRID_BAR();
    }

    if (IN(3)) {
        OPAQUE_TID();
        for (int u = vcu; u < 256; u += G) lru_unit<true>(P, lds, u >> 5, (u >> 1) & 15, u & 1, tid, lane, wave);
        for (int t = gt; t < DBATCH * 1024; t += NT) lru_sample(P, t);
        combine_items(P, gt, NT);
        if (BOTH(3)) GRID_BAR();
    }

    if (IN(4)) {
        LOAD_P();
        { pg8::Gemm g{WSP(pg8::bf16_t, WS_ATT), WSP(pg8::bf16_t, WS_WOA), M, DM, MW}; pg8::StaticOrder S; S.init(M, DM, G, bx);
          pg8::Epi2<pg8::E_AMIX> E{WSP(pg8::bf16_t, WS_SGA), nullptr, WSP(pg8::bf16_t, WS_AMIX), nullptr, nullptr, nullptr, nullptr, nullptr, XCH};
          pg8::gemm_phase<pg8::Epi2<pg8::E_AMIX>, pg8::StaticOrder, true, true>(lds + RING_OFF, g, S, E, wave0); }
        VM_WAIT(); __syncthreads();
        { pg8::Gemm g{WSP(pg8::bf16_t, WS_HRG), WSP(pg8::bf16_t, WS_WOB), M, DM, DM}; pg8::StaticOrder S; S.init(M, DM, G, bx);
          pg8::Epi2<pg8::E_MIX> E{WSP(pg8::bf16_t, WS_SGB), WSP(pg8::bf16_t, WS_AMIX), WSP(pg8::bf16_t, WS_MIX), nullptr, nullptr, nullptr, nullptr, nullptr, XCH};
          pg8::gemm_phase<pg8::Epi2<pg8::E_MIX>, pg8::StaticOrder, true, true>(lds + RING_OFF, g, S, E, wave0); }
        if (BOTH(4)) GRID_BAR();
    }

    if (IN(5)) {
        LOAD_P();
        pg8::Gemm g{WSP(pg8::bf16_t, WS_MIX), WSP(pg8::bf16_t, WS_WO), M, DM, DM}; pg8::StaticOrder S; S.init(M, DM, G, bx);
        pg8::Epi2<pg8::E_X1> E{nullptr, nullptr, WSP(pg8::bf16_t, WS_X1B), P.out, P.in[0], P.in[1], WSP(float, WS_SS1), nullptr, XCH};
        pg8::gemm_phase<pg8::Epi2<pg8::E_X1>, pg8::StaticOrder, true, true>(lds + RING_OFF, g, S, E, wave0);
        if (BOTH(5)) GRID_BAR();
    }

    if (IN(6)) {
        LOAD_P();
        pg8::Gemm g{WSP(pg8::bf16_t, WS_X1B), WSP(pg8::bf16_t, WS_WUP), M, FF, DM}; pg8::StaticOrder S; S.init(M, FF, G, bx);
        pg8::Epi2<pg8::E_UP> E{nullptr, nullptr, WSP(pg8::bf16_t, WS_U), nullptr, nullptr, nullptr, nullptr, WSP(float, WS_SS1), XCH};
        pg8::gemm_phase<pg8::Epi2<pg8::E_UP>, pg8::StaticOrder, true, true>(lds + RING_OFF, g, S, E, wave0);
        if (BOTH(6)) GRID_BAR();
    }

    if (IN(7)) {
        LOAD_P();
        pg8::Gemm g{WSP(pg8::bf16_t, WS_U), WSP(pg8::bf16_t, WS_WDN), M, DM, FF}; pg8::StaticOrder S; S.init(M, DM, G, bx);
        pg8::Epi2<pg8::E_X2> E{nullptr, nullptr, WSP(pg8::bf16_t, WS_X2B), P.out, nullptr, nullptr, WSP(float, WS_SS2), nullptr, XCH};
        pg8::gemm_phase<pg8::Epi2<pg8::E_X2>, pg8::StaticOrder, true, true>(lds + RING_OFF, g, S, E, wave0);
        if (BOTH(7)) GRID_BAR();
    }

    if (IN(8)) {
        LOAD_P();
        { pg8::Gemm g{WSP(pg8::bf16_t, WS_PB), WSP(pg8::bf16_t, WS_WPE), M, DM, PLE}; pg8::StaticOrder S; S.init(M, DM, G, bx);
          pg8::Epi2<pg8::E_PE> E{nullptr, nullptr, WSP(pg8::bf16_t, WS_PEP), nullptr, nullptr, nullptr, nullptr, nullptr, XCH};
          pg8::gemm_phase<pg8::Epi2<pg8::E_PE>, pg8::StaticOrder, true, true>(lds + RING_OFF, g, S, E, wave0); }
        VM_WAIT(); __syncthreads();
        { pg8::Gemm g{WSP(pg8::bf16_t, WS_X2B), WSP(pg8::bf16_t, WS_WPG), M, DM, DM}; pg8::StaticOrder S; S.init(M, DM, G, bx);
          pg8::Epi2<pg8::E_Y> E{WSP(pg8::bf16_t, WS_PEP), nullptr, nullptr, P.out, nullptr, nullptr, nullptr, WSP(float, WS_SS2), XCH};
          pg8::gemm_phase<pg8::Epi2<pg8::E_Y>, pg8::StaticOrder, true, true>(lds + RING_OFF, g, S, E, wave0); }
    }
#undef IN
#undef BOTH
#undef GRID_BAR
}

extern "C" void kernel_launch(void* const* d_in, const int* in_sizes, int n_in, void* d_out, int out_size, void* d_ws, size_t ws_size, hipStream_t stream) {
    static int grid = 0;
    if (grid == 0) {
        if (n_in != 30 || in_sizes[0] != MP * DM || out_size != (int)pg8::O_END || ws_size < WS_END) {
            fprintf(stderr, "kernel_launch: unexpected shapes (n_in %d, in0 %d, out %d, ws %zu, need %zu); nothing launched\n", n_in, n_in > 0 ? in_sizes[0] : -1, out_size, ws_size, (size_t)WS_END); grid = -1; return; }
        int dev = 0, cus = 0, per_cu = 0;
        if (hipGetDevice(&dev) != hipSuccess || hipDeviceGetAttribute(&cus, hipDeviceAttributeMultiprocessorCount, dev) != hipSuccess) { grid = -1; return; }
        if (hipFuncSetAttribute((const void*)fwd_kernel, hipFuncAttributeMaxDynamicSharedMemorySize, LDS_BYTES) != hipSuccess) { fprintf(stderr, "kernel_launch: hipFuncSetAttribute failed\n"); grid = -1; return; }
        if (hipOccupancyMaxActiveBlocksPerMultiprocessor(&per_cu, (const void*)fwd_kernel, NWAVES * 64, LDS_BYTES) != hipSuccess || per_cu < 1)
            fprintf(stderr, "kernel_launch: note: occupancy query reports %d workgroups per CU\n", per_cu);
        (void)hipGetLastError();
        grid = cus;
    }
    if (grid < 0) return;
    if (hipMemsetAsync((char*)d_ws + WS_CTL, 0, CTL_ZERO_BYTES, stream) != hipSuccess) { fprintf(stderr, "kernel_launch: hipMemsetAsync failed\n"); return; }
    Args a{};
    for (int i = 0; i < 30; ++i) a.in[i] = (const float*)d_in[i];
    a.out = (float*)d_out; a.ws = (unsigned char*)d_ws;
    for (int li = 0; li < N_LAUNCHES; ++li) {
        a.ph_lo = (N_LAUNCHES == PER_PHASE) ? li : 0; a.ph_hi = (N_LAUNCHES == PER_PHASE) ? li + 1 : PER_PHASE;
        hipLaunchKernelGGL(fwd_kernel, dim3(grid), dim3(NWAVES * 64), LDS_BYTES, stream, a);
        const hipError_t le = hipPeekAtLastError();
        if (le != hipSuccess) { fprintf(stderr, "kernel_launch: launch %d failed: %s\n", li, hipGetErrorName(le)); break; }
    }
}
```

```cpp
#include <hip/hip_runtime.h>
#include <cstdio>
#include <cstdint>
#include <cmath>
#define MK_N_LAUNCHES 1

constexpr int NWAVES = 8;
#ifndef MK_N_LAUNCHES
#define MK_N_LAUNCHES 1
#endif
constexpr int N_LAUNCHES = MK_N_LAUNCHES;
constexpr int PER_PHASE = 9;

constexpr int DM = 1024, NBATCH = 8, SEQ = 8192, DBATCH = 128, DSEQ = 4;
constexpr int MP = NBATCH * SEQ, MS = DBATCH * DSEQ, M = MP + MS;
constexpr int NIN = 8704, FF = 4096, PLE = 256, AW = 1536, MW = 512;
static_assert(M % 256 == 0 && NIN % 256 == 0, "tile shapes");

constexpr size_t MiB = 1u << 20;
constexpr size_t al(size_t x) { return (x + MiB - 1) / MiB * MiB; }
constexpr size_t WS_CTL = 0, CTL_ZERO_BYTES = 1 * MiB;
constexpr size_t WS_WIN = 1 * MiB;
constexpr size_t WS_WOA = WS_WIN + al((size_t)NIN * DM * 2);
constexpr size_t WS_WOB = WS_WOA + al((size_t)DM * MW * 2);
constexpr size_t WS_WO = WS_WOB + al((size_t)DM * DM * 2);
constexpr size_t WS_WUP = WS_WO + al((size_t)DM * DM * 2);
constexpr size_t WS_WDN = WS_WUP + al((size_t)FF * DM * 2);
constexpr size_t WS_WPG = WS_WDN + al((size_t)FF * DM * 2);
constexpr size_t WS_WPE = WS_WPG + al((size_t)DM * DM * 2);
constexpr size_t WS_WRG = WS_WPE + al((size_t)DM * PLE * 2);
constexpr size_t WS_TAB = WS_WRG + MiB;
constexpr size_t WS_HB = WS_TAB + MiB;
constexpr size_t ACT = al((size_t)M * DM * 2);
constexpr size_t WS_Q = WS_HB + ACT;
constexpr size_t QKV = (size_t)MP * AW * 2;
constexpr size_t WS_K = WS_Q + QKV, WS_V = WS_K + QKV;
constexpr size_t WS_XB = WS_V + QKV, WS_GY = WS_XB + ACT, WS_SGA = WS_GY + ACT, WS_SGB = WS_SGA + ACT;
constexpr size_t WS_QS = WS_SGB + ACT;
constexpr size_t WS_XBS = WS_QS + al((size_t)MS * AW * 4);
constexpr size_t WS_OG = WS_XBS + al((size_t)MS * DM * 4);
constexpr size_t WS_LSE = WS_OG + al((size_t)3 * MP * MW * 2);
constexpr size_t WS_ATT = WS_LSE + al((size_t)3 * MP * 4 * 4);
constexpr size_t WS_HRG = WS_ATT + al((size_t)M * MW * 2);
constexpr size_t WS_AMIX = WS_HRG + ACT, WS_MIX = WS_AMIX + ACT, WS_X1B = WS_MIX + ACT, WS_X2B = WS_X1B + ACT;
constexpr size_t WS_U = WS_X2B + ACT;
constexpr size_t WS_PB = WS_U + al((size_t)M * FF * 2);
constexpr size_t WS_PEP = WS_PB + al((size_t)M * PLE * 2);
constexpr size_t WS_SS1 = WS_PEP + ACT;
constexpr size_t WS_SS2 = WS_SS1 + al((size_t)M * 4 * 4);
constexpr size_t WS_END = WS_SS2 + al((size_t)M * 4 * 4);
constexpr int CW_BAR = 4096;

constexpr int RING_OFF = 0, RING_BYTES = 131072;
constexpr int XCH_OFF = 131072;
constexpr int MISC_OFF = 139264;
constexpr int LDS_BYTES = 147456;

#define GAS __attribute__((address_space(1)))
#define LAS __attribute__((address_space(3)))
typedef unsigned short bf16;
typedef unsigned v4u __attribute__((ext_vector_type(4)));
typedef unsigned v2u __attribute__((ext_vector_type(2)));
typedef float f32x4 __attribute__((ext_vector_type(4)));
typedef float f32x16 __attribute__((ext_vector_type(16)));
typedef short bf16x8 __attribute__((ext_vector_type(8)));
typedef short s16x4 __attribute__((ext_vector_type(4)));
typedef GAS unsigned gu32;
#define RLX_AGENT __ATOMIC_RELAXED, __HIP_MEMORY_SCOPE_AGENT
#define LDS_WAIT() asm volatile("s_waitcnt lgkmcnt(0)" ::: "memory")
#define VM_WAIT() asm volatile("s_waitcnt vmcnt(0)" ::: "memory")
__device__ __forceinline__ unsigned f2bf(float f) { unsigned u = __builtin_bit_cast(unsigned, f); return (u + 0x7fffu + ((u >> 16) & 1u)) >> 16; }
__device__ __forceinline__ unsigned pk2(float lo, float hi) { return f2bf(lo) | (f2bf(hi) << 16); }
__device__ __forceinline__ float bflo(unsigned w) { return __uint_as_float(w << 16); }
__device__ __forceinline__ float bfhi(unsigned w) { return __uint_as_float(w & 0xffff0000u); }
__device__ __forceinline__ float fexp2(float x) { return __builtin_amdgcn_exp2f(x); }
__device__ __forceinline__ float frcp(float x) { return __builtin_amdgcn_rcpf(x); }
__device__ __forceinline__ float sigm(float x) { return frcp(1.0f + fexp2(-1.4426950408889634f * x)); }
namespace pg8 {
#define PG8_LAS __attribute__((address_space(3)))
typedef unsigned short bf16_t;
typedef short bf16x8 __attribute__((ext_vector_type(8)));
typedef float f32x4 __attribute__((ext_vector_type(4)));
typedef unsigned u32x4 __attribute__((ext_vector_type(4)));
constexpr int BM = 256, BK = 64, HALF = 128, HTB = HALF * BK * 2  , STAGE_BYTES = 8 * HTB, NXCD = 8, WGM = 8;

__host__ __device__ __forceinline__ int lds_byte(int r, int c) { const int st = (r >> 4) * 2 + (c >> 5), rr = r & 15, cc = c & 31, ob = rr * 64 + cc * 2; return st * 1024 + (ob ^ (((ob >> 9) & 1) << 5)); }
__host__ __device__ __forceinline__ void stage_rc(int b, int& R, int& C) { const int st = b / 1024, sb = b % 1024, swz = sb ^ (((sb >> 9) & 1) << 5); R = (st >> 1) * 16 + swz / 64; C = (st & 1) * 32 + (swz % 64) / 2; }
__host__ __device__ __forceinline__ int perm32(int rho) { const int n = rho >> 4, i = rho & 15; return 8 * (i >> 2) + 4 * n + (i & 3); }

struct Unit { int pm, pn; };
struct Gemm { const bf16_t* A; const bf16_t* Bt; int M, N, K; };

struct StaticOrder {
    int nM, nN, nwg, G, c;
    __host__ __device__ void init(int M, int N, int G_, int c_) { nM = M / BM; nN = N / BM; nwg = nM * nN; G = G_; c = c_; }
    __host__ __device__ bool next(int i, Unit& u) const {
        const long L = (long)i * G + c; if (L >= nwg) return false;
        int wgid = (int)L; { const int q = nwg / NXCD, r = nwg % NXCD, xcd = wgid % NXCD, off = wgid / NXCD; wgid = (xcd < r ? xcd * (q + 1) : r * (q + 1) + (xcd - r) * q) + off; }
        const int nig = WGM * nN, gid = wgid / nig, fm = gid * WGM, gsz = (nM - fm) < WGM ? (nM - fm) : WGM;
        u.pm = fm + ((wgid % nig) % gsz); u.pn = (wgid % nig) / gsz; return true;
    }
    __device__ __forceinline__ void a_ready(const Unit&) const {}
    __device__ __forceinline__ void done(const Unit&) const {}
};
__device__ __forceinline__ unsigned cvt_pk_bf16(float lo, float hi) { unsigned r; asm volatile("v_cvt_pk_bf16_f32 %0, %1, %2" : "=v"(r) : "v"(lo), "v"(hi)); return r; }
typedef float f32x2 __attribute__((ext_vector_type(2)));
typedef unsigned u32x2 __attribute__((ext_vector_type(2)));
constexpr float RMS_EPS = 1e-6f;
constexpr float QSCALE = 0.08838834764831845f * 1.4426950408889634f;
constexpr size_t O_YP = 0, O_YS = 67108864, O_KV1P = 67633152, O_KV2P = 68681728, O_KV3P = 72876032, O_CONVP = 89653248, O_LRUP = 89677824,
                 O_KV1S = 89686016, O_KV2S = 90210304, O_KV3S = 90734592, O_CONVS = 91258880, O_LRUS = 91652096, O_END = 91783168;
__device__ __forceinline__ size_t kvp_off(int g) { return g == 0 ? O_KV1P : (g == 1 ? O_KV2P : O_KV3P); }
__device__ __forceinline__ size_t kvs_off(int g) { return g == 0 ? O_KV1S : (g == 1 ? O_KV2S : O_KV3S); }

__device__ __forceinline__ float fsigmoid(float x) { return __builtin_amdgcn_rcpf(1.0f + __builtin_amdgcn_exp2f(-1.4426950408889634f * x)); }
__device__ __forceinline__ float fgelu_tanh(float x) { const float u = x + 0.044715f * x * x * x; return x * __builtin_amdgcn_rcpf(1.0f + __builtin_amdgcn_exp2f(-2.3022082232f * u)); }
__device__ __forceinline__ float bf_lo(unsigned w) { return __uint_as_float(w << 16); }
__device__ __forceinline__ float bf_hi(unsigned w) { return __uint_as_float(w & 0xffff0000u); }
__device__ __forceinline__ u32x4 pack8(const f32x4& a, const f32x4& b) { u32x4 w; w.x = cvt_pk_bf16(a[0], a[1]); w.y = cvt_pk_bf16(a[2], a[3]); w.z = cvt_pk_bf16(b[0], b[1]); w.w = cvt_pk_bf16(b[2], b[3]); return w; }
__device__ __forceinline__ void unpack8(const u32x4& w, f32x4& a, f32x4& b) { a = (f32x4){bf_lo(w.x), bf_hi(w.x), bf_lo(w.y), bf_hi(w.y)}; b = (f32x4){bf_lo(w.z), bf_hi(w.z), bf_lo(w.w), bf_hi(w.w)}; }
__device__ __forceinline__ float sq8(const f32x4& a, const f32x4& b) { return (a[0] * a[0] + a[1] * a[1]) + (a[2] * a[2] + a[3] * a[3]) + (b[0] * b[0] + b[1] * b[1]) + (b[2] * b[2] + b[3] * b[3]); }

__device__ __forceinline__ void rowss_exchange(float (&ss)[2][4][2], PG8_LAS float* P, int wr, int wc, int fr, int fq) {
#pragma unroll
    for (int ai = 0; ai < 2; ++ai)
#pragma unroll
        for (int m = 0; m < 4; ++m)
#pragma unroll
            for (int bj = 0; bj < 2; ++bj) { float s = ss[ai][m][bj]; s += __shfl_xor(s, 16); s += __shfl_xor(s, 32);
                if (fq == 0) P[(ai * HALF + wr * 64 + m * 16 + fr) * 8 + bj * 4 + wc] = s; }
    asm volatile("s_waitcnt lgkmcnt(0)" ::: "memory"); __builtin_amdgcn_s_barrier(); asm volatile("" ::: "memory");
#pragma unroll
    for (int ai = 0; ai < 2; ++ai)
#pragma unroll
        for (int m = 0; m < 4; ++m) { const PG8_LAS f32x4* p = (const PG8_LAS f32x4*)(P + (ai * HALF + wr * 64 + m * 16 + fr) * 8);
            const f32x4 a = p[0], b = p[1]; ss[ai][m][0] = (a[0] + a[1]) + (a[2] + a[3]); ss[ai][m][1] = (b[0] + b[1]) + (b[2] + b[3]); }
}

struct Epi1 {
    static constexpr bool PERM = true, AFTER_DRAIN = false;
    unsigned char* ws; float* out; const float *gq, *gk; PG8_LAS float* P;
    __device__ __forceinline__ void operator()(const f32x4 (&acc)[2][2][4][2], const Unit& u, int wr, int wc, int fr, int fq) const {
        const int pn = u.pn; const bool sample = u.pm >= 256;
        const int colw = wc * 32 + fq * 8;
        const int row0 = u.pm * BM + wr * 64 + fr;
        if (pn < 12) {
            const bool isq = pn < 6; const int hbase = 2 * (isq ? pn : pn - 6);
            float ss[2][4][2];
#pragma unroll
            for (int ai = 0; ai < 2; ++ai)
#pragma unroll
                for (int m = 0; m < 4; ++m)
#pragma unroll
                    for (int bj = 0; bj < 2; ++bj) ss[ai][m][bj] = sq8(acc[ai][bj][m][0], acc[ai][bj][m][1]);
            rowss_exchange(ss, P, wr, wc, fr, fq);
            const f32x4 gq0 = *(const f32x4*)(gq + colw), gq1 = *(const f32x4*)(gq + colw + 4), gk0 = *(const f32x4*)(gk + colw), gk1 = *(const f32x4*)(gk + colw + 4);
            f32x4 g0, g1;
#pragma unroll
            for (int e = 0; e < 4; ++e) { g0[e] = isq ? gq0[e] * QSCALE : gk0[e]; g1[e] = isq ? gq1[e] * QSCALE : gk1[e]; }
            bf16_t* const QK = (bf16_t*)(ws + (isq ? WS_Q : WS_K)); float* const QS = (float*)(ws + WS_QS);
#pragma unroll
            for (int ai = 0; ai < 2; ++ai)
#pragma unroll
                for (int m = 0; m < 4; ++m) { const int R = row0 + ai * HALF + m * 16;
#pragma unroll
                    for (int bj = 0; bj < 2; ++bj) { const int hh = hbase + bj, grp = hh >> 2, gsh = 2 * grp;
                        const float rs = __builtin_amdgcn_rsqf(ss[ai][m][bj] * (1.0f / 128.0f) + RMS_EPS);
                        const f32x4 v0 = acc[ai][bj][m][0] * rs * g0, v1 = acc[ai][bj][m][1] * rs * g1;
                        if (!sample) { const int b = R >> 13, t = R & 8191; const int rr = t & ((1 << gsh) - 1), mm = t >> gsh;
                            const size_t rowp = ((size_t)(b * 12 + hh) << 13) + (size_t)(rr << (13 - gsh)) + mm;
                            *(u32x4*)(QK + rowp * 128 + colw) = pack8(v0, v1);
                            if (!isq) { const int W = 128 << gsh, trel = t - (8192 - W);
                                if (trel >= 0) { float* o = out + kvp_off(grp) + ((((size_t)b * W + trel) * 2 + 0) * 4 + (hh & 3)) * 128 + colw; *(f32x4*)o = v0; *(f32x4*)(o + 4) = v1; } }
                        } else { const int s = R - MP;
                            float* o = isq ? QS + (size_t)s * 1536 + hh * 128 + colw : out + kvs_off(grp) + (((size_t)s * 2 + 0) * 4 + (hh & 3)) * 128 + colw;
                            *(f32x4*)o = v0; *(f32x4*)(o + 4) = v1; } } }
        } else if (pn < 18) {
            const int hbase = 2 * (pn - 12); bf16_t* const V = (bf16_t*)(ws + WS_V);
#pragma unroll
            for (int ai = 0; ai < 2; ++ai)
#pragma unroll
                for (int m = 0; m < 4; ++m) { const int R = row0 + ai * HALF + m * 16;
#pragma unroll
                    for (int bj = 0; bj < 2; ++bj) { const int hh = hbase + bj, grp = hh >> 2, gsh = 2 * grp;
                        const f32x4 v0 = acc[ai][bj][m][0], v1 = acc[ai][bj][m][1];
                        if (!sample) { const int b = R >> 13, t = R & 8191; const int rr = t & ((1 << gsh) - 1), mm = t >> gsh;
                            const size_t rowp = ((size_t)(b * 12 + hh) << 13) + (size_t)(rr << (13 - gsh)) + mm;
                            *(u32x4*)(V + rowp * 128 + colw) = pack8(v0, v1);
                            const int W = 128 << gsh, trel = t - (8192 - W);
                            if (trel >= 0) { float* o = out + kvp_off(grp) + ((((size_t)b * W + trel) * 2 + 1) * 4 + (hh & 3)) * 128 + colw; *(f32x4*)o = v0; *(f32x4*)(o + 4) = v1; }
                        } else { const int s = R - MP;
                            float* o = out + kvs_off(grp) + (((size_t)s * 2 + 1) * 4 + (hh & 3)) * 128 + colw; *(f32x4*)o = v0; *(f32x4*)(o + 4) = v1; } } }
        } else if (pn < 22) {
            const int cb = (pn - 18) * BM + colw; bf16_t* const XB = (bf16_t*)(ws + WS_XB); float* const XBS = (float*)(ws + WS_XBS);
#pragma unroll
            for (int ai = 0; ai < 2; ++ai)
#pragma unroll
                for (int m = 0; m < 4; ++m) { const int R = row0 + ai * HALF + m * 16;
#pragma unroll
                    for (int bj = 0; bj < 2; ++bj) { const int col = cb + bj * HALF; const f32x4 v0 = acc[ai][bj][m][0], v1 = acc[ai][bj][m][1];
                        if (!sample) { const int b = R >> 13, t = R & 8191;
                            *(u32x4*)(XB + (size_t)R * 1024 + col) = pack8(v0, v1);
                            if (t >= 8189) { float* o = out + O_CONVP + ((size_t)b * 3 + (t - 8189)) * 1024 + col; *(f32x4*)o = v0; *(f32x4*)(o + 4) = v1; }
                        } else { const int s = R - MP, b = s >> 2, t = s & 3;
                            float* o = XBS + (size_t)s * 1024 + col; *(f32x4*)o = v0; *(f32x4*)(o + 4) = v1;
                            if (t >= 1) { float* o2 = out + O_CONVS + ((size_t)b * 3 + (t - 1)) * 1024 + col; *(f32x4*)o2 = v0; *(f32x4*)(o2 + 4) = v1; } } } }
        } else {
            const int seg = (pn - 22) >> 2; const int cb = ((pn - 22) & 3) * BM + colw; bf16_t* const dst = (bf16_t*)(ws + (seg == 0 ? WS_GY : (seg == 1 ? WS_SGA : WS_SGB)));
#pragma unroll
            for (int ai = 0; ai < 2; ++ai)
#pragma unroll
                for (int m = 0; m < 4; ++m) { const int R = row0 + ai * HALF + m * 16;
#pragma unroll
                    for (int bj = 0; bj < 2; ++bj) { const int col = cb + bj * HALF; f32x4 v0 = acc[ai][bj][m][0], v1 = acc[ai][bj][m][1];
                        if (seg == 0) {
#pragma unroll
                            for (int e = 0; e < 4; ++e) { v0[e] = fgelu_tanh(v0[e]); v1[e] = fgelu_tanh(v1[e]); }
                        } else {
#pragma unroll
                            for (int e = 0; e < 4; ++e) { v0[e] = fsigmoid(v0[e]); v1[e] = fsigmoid(v1[e]); }
                        }
                        *(u32x4*)(dst + (size_t)R * 1024 + col) = pack8(v0, v1); } }
        }
    }
};

enum { E_AMIX = 0, E_MIX = 1, E_X1 = 2, E_UP = 3, E_X2 = 4, E_PE = 5, E_Y = 6 };
template <int MODE> struct Epi2 {
    static constexpr bool PERM = true, AFTER_DRAIN = false;
    const bf16_t* g1; const bf16_t* g2; bf16_t* o1; float* of; const float* xp; const float* xs; float* ss_out; const float* ss_in; PG8_LAS float* P;
    __device__ __forceinline__ void operator()(const f32x4 (&acc)[2][2][4][2], const Unit& u, int wr, int wc, int fr, int fq) const {
        const int colw = u.pn * BM + wc * 32 + fq * 8; const int row0 = u.pm * BM + wr * 64 + fr;
        float ss[2][4][2];
#pragma unroll
        for (int ai = 0; ai < 2; ++ai)
#pragma unroll
            for (int m = 0; m < 4; ++m) { const int R = row0 + ai * HALF + m * 16;
                float rs = 1.0f;
                if (MODE == E_UP || MODE == E_Y) { const f32x4 q = *(const f32x4*)(ss_in + (size_t)R * 4); rs = __builtin_amdgcn_rsqf(((q[0] + q[1]) + (q[2] + q[3])) * (1.0f / 1024.0f) + RMS_EPS); }
#pragma unroll
                for (int bj = 0; bj < 2; ++bj) { const int col = colw + bj * HALF; const size_t idx = (size_t)R * 1024 + col;
                    const f32x4 a0 = acc[ai][bj][m][0], a1 = acc[ai][bj][m][1];
                    if (MODE == E_AMIX) { f32x4 s0, s1; unpack8(*(const u32x4*)(g1 + idx), s0, s1); *(u32x4*)(o1 + idx) = pack8(s0 * a0, s1 * a1); }
                    else if (MODE == E_MIX) { f32x4 s0, s1, p0, p1; unpack8(*(const u32x4*)(g1 + idx), s0, s1); unpack8(*(const u32x4*)(g2 + idx), p0, p1); *(u32x4*)(o1 + idx) = pack8(p0 + s0 * a0, p1 + s1 * a1); }
                    else if (MODE == E_X1) { const float* xr = (R < MP) ? xp + idx : xs + (idx - (size_t)MP * 1024);
                        const f32x4 v0 = *(const f32x4*)xr + a0, v1 = *(const f32x4*)(xr + 4) + a1;
                        *(u32x4*)(o1 + idx) = pack8(v0, v1); ss[ai][m][bj] = sq8(v0, v1); }
                    else if (MODE == E_UP) { f32x4 v0 = a0 * rs, v1 = a1 * rs;
#pragma unroll
                        for (int e = 0; e < 4; ++e) { const float p = fmaxf(v0[e], 0.f), q = fmaxf(v1[e], 0.f); v0[e] = p * p; v1[e] = q * q; }
                        *(u32x4*)(o1 + (size_t)R * 4096 + col) = pack8(v0, v1); }
                    else if (MODE == E_X2) { f32x4 p0, p1; unpack8(*(const u32x4*)(g1 + idx), p0, p1); const f32x4 v0 = p0 + a0, v1 = p1 + a1;
                        *(u32x4*)(o1 + idx) = pack8(v0, v1); ss[ai][m][bj] = sq8(v0, v1); }
                    else if (MODE == E_PE) { *(u32x4*)(o1 + idx) = pack8(a0, a1); }
                    else { f32x4 p0, p1, v0, v1; unpack8(*(const u32x4*)(g1 + idx), p0, p1); unpack8(*(const u32x4*)(g2 + idx), v0, v1);
#pragma unroll
                        for (int e = 0; e < 4; ++e) { v0[e] += fsigmoid(a0[e] * rs) * p0[e]; v1[e] += fsigmoid(a1[e] * rs) * p1[e]; }
                        *(f32x4*)(of + idx) = v0; *(f32x4*)(of + idx + 4) = v1; } }
                if (MODE != E_UP && MODE != E_PE) asm volatile("" ::: "memory"); }
        if (MODE == E_X1 || MODE == E_X2) {
            rowss_exchange(ss, P, wr, wc, fr, fq);
            if (wc == 0 && fq == 0) {
#pragma unroll
                for (int ai = 0; ai < 2; ++ai)
#pragma unroll
                    for (int m = 0; m < 4; ++m) ss_out[(size_t)(row0 + ai * HALF + m * 16) * 4 + u.pn] = ss[ai][m][0] + ss[ai][m][1]; }
        }
    }
};
template <class Epi, class Sched, bool ALIGN_EPI = false, bool SP2 = false>
__device__ __forceinline__ void gemm_phase(PG8_LAS unsigned char* lds, const Gemm g, const Sched& S, const Epi& E, const int wave0) {
    int tid_ = (wave0 << 6) | (int)__builtin_amdgcn_mbcnt_hi(~0u, __builtin_amdgcn_mbcnt_lo(~0u, 0u)); asm volatile("" : "+v"(tid_));
    const int tid = tid_, wid = __builtin_amdgcn_readfirstlane(tid >> 6), lane = tid & 63, wr = wid >> 2, wc = wid & 3, fr = lane & 15, fq = lane >> 4;
    const int K = g.K, nt = K / BK;
    unsigned voffA[2], voffB[2];
#pragma unroll
    for (int i = 0; i < 2; ++i) { int R, C; stage_rc(tid * 16 + i * 8192, R, C); const int Rb = Epi::PERM ? ((R & ~31) + perm32(R & 31)) : R;
        voffA[i] = (unsigned)(R * K + C) * 2u; voffB[i] = (unsigned)(Rb * K + C) * 2u; }
    const size_t kstep = (size_t)(BK * 2);
    const size_t hstep = (size_t)HALF * K * 2;
    const size_t tstep = 2 * hstep;
    const unsigned ldsw = (unsigned)wid * 1024u;
    const int aoff = lds_byte(wr * 64 + fr, fq * 8), boff = lds_byte(wc * 32 + fr, fq * 8);
#define PG8_SA(b, h) (((b) * 2 + (h)) * HTB)
#define PG8_SB(b, h) ((4 + (b) * 2 + (h)) * HTB)
#define PG8_STAGE(bufoff, gbase, voff) do { _Pragma("unroll") for (int _i = 0; _i < 2; ++_i) \
        __builtin_amdgcn_global_load_lds((const unsigned*)((const char*)(gbase) + (voff)[_i]), (PG8_LAS unsigned*)(lds + (bufoff) + ldsw + _i * 8192), 16, 0, 0); } while (0)
#define PG8_LDA(dst, b, h) do { _Pragma("unroll") for (int m = 0; m < 4; ++m) _Pragma("unroll") for (int k = 0; k < 2; ++k) dst[m][k] = *(const PG8_LAS bf16x8*)(lds + PG8_SA(b, h) + aoff + m * 2048 + k * 1024); } while (0)
#define PG8_LDB(dst, b, h) do { _Pragma("unroll") for (int n = 0; n < 2; ++n) _Pragma("unroll") for (int k = 0; k < 2; ++k) dst[n][k] = *(const PG8_LAS bf16x8*)(lds + PG8_SB(b, h) + boff + n * 2048 + k * 1024); } while (0)
#define PG8_MMA(ai, bj, At, Bt) do { __builtin_amdgcn_s_setprio(1); _Pragma("unroll") for (int m = 0; m < 4; ++m) _Pragma("unroll") for (int n = 0; n < 2; ++n) _Pragma("unroll") for (int k = 0; k < 2; ++k) \
        acc[ai][bj][m][n] = __builtin_amdgcn_mfma_f32_16x16x32_bf16(Bt[n][k], At[m][k], acc[ai][bj][m][n], 0, 0, 0); __builtin_amdgcn_s_setprio(0); } while (0)
#define PG8_WAIT_V(n) asm volatile("s_waitcnt vmcnt(" #n ")" ::: "memory")
#define PG8_WAIT_L(n) asm volatile("s_waitcnt lgkmcnt(" #n ")" ::: "memory")
#define PG8_BAR __builtin_amdgcn_s_barrier()
#define PG8_SCHED __builtin_amdgcn_sched_barrier(0)
    Unit cur, nxt; int ui = 0;
    if (!S.next(0, cur)) return;
    f32x4 acc[2][2][4][2];
#pragma unroll
    for (int a = 0; a < 2; ++a)
#pragma unroll
        for (int b = 0; b < 2; ++b)
#pragma unroll
            for (int m = 0; m < 4; ++m)
#pragma unroll
                for (int n = 0; n < 2; ++n) acc[a][b][m][n] = (f32x4){0.f, 0.f, 0.f, 0.f};
    bf16x8 At[4][2], B0[2][2], B1[2][2];
    const char* cA = (const char*)g.A + (size_t)cur.pm * tstep; const char* cB = (const char*)g.Bt + (size_t)cur.pn * tstep;
    S.a_ready(cur);
    if constexpr (SP2) {
        PG8_STAGE(PG8_SB(0, 0), cB, voffB); PG8_STAGE(PG8_SB(0, 1), cB + hstep, voffB); PG8_STAGE(PG8_SA(0, 0), cA, voffA); PG8_STAGE(PG8_SA(0, 1), cA + hstep, voffA);
        if (wr == 1) PG8_BAR;
        PG8_WAIT_V(2); PG8_BAR;
        PG8_STAGE(PG8_SB(1, 0), cB + kstep, voffB); PG8_STAGE(PG8_SA(1, 0), cA + kstep, voffA); PG8_STAGE(PG8_SB(1, 1), cB + hstep + kstep, voffB);
        PG8_WAIT_V(6); PG8_BAR;
    } else {
        PG8_STAGE(PG8_SB(0, 0), cB, voffB); PG8_STAGE(PG8_SA(0, 0), cA, voffA); PG8_STAGE(PG8_SB(0, 1), cB + hstep, voffB); PG8_STAGE(PG8_SA(0, 1), cA + hstep, voffA);
        if (wr == 1) PG8_BAR;
        PG8_WAIT_V(4); PG8_BAR;
        PG8_STAGE(PG8_SB(1, 0), cB + kstep, voffB); PG8_STAGE(PG8_SA(1, 0), cA + kstep, voffA); PG8_STAGE(PG8_SB(1, 1), cB + hstep + kstep, voffB);
        PG8_WAIT_V(6); PG8_BAR;
    }
    for (;;) {
        const bool has_next = S.next(ui + 1, nxt);
        const char* nA = has_next ? (const char*)g.A + (size_t)nxt.pm * tstep : cA; const char* nB = has_next ? (const char*)g.Bt + (size_t)nxt.pn * tstep : cB;
        for (int t = 0; t < nt; t += 2) {
            const bool last = (t == nt - 2);
            const char* a1 = cA + (size_t)(t + 1) * kstep;
            const char* a2 = last ? nA : cA + (size_t)(t + 2) * kstep; const char* b2 = last ? nB : cB + (size_t)(t + 2) * kstep;
            const char* a3 = a2 + kstep; const char* b3 = b2 + kstep;
            if (last && has_next) S.a_ready(nxt);
            if constexpr (SP2) {
            PG8_LDB(B0, 0, 0); PG8_LDB(B1, 0, 1); PG8_SCHED; PG8_LDA(At, 0, 0); PG8_STAGE(PG8_SA(1, 1), a1 + hstep, voffA);
            PG8_WAIT_V(8); PG8_WAIT_L(0); PG8_BAR; PG8_MMA(0, 0, At, B0); PG8_MMA(0, 1, At, B1); PG8_BAR; PG8_SCHED;
            PG8_LDA(At, 0, 1); PG8_STAGE(PG8_SB(0, 0), b2, voffB); PG8_STAGE(PG8_SB(0, 1), b2 + hstep, voffB); PG8_STAGE(PG8_SA(0, 0), a2, voffA);
            PG8_WAIT_V(8); PG8_WAIT_L(0); PG8_BAR; PG8_MMA(1, 0, At, B0); PG8_MMA(1, 1, At, B1); PG8_BAR; PG8_SCHED;
            PG8_LDB(B0, 1, 0); PG8_LDB(B1, 1, 1); PG8_SCHED; PG8_LDA(At, 1, 0); PG8_STAGE(PG8_SA(0, 1), a2 + hstep, voffA);
            PG8_WAIT_V(8); PG8_WAIT_L(0); PG8_BAR; PG8_MMA(0, 0, At, B0); PG8_MMA(0, 1, At, B1); PG8_BAR; PG8_SCHED;
            PG8_LDA(At, 1, 1); PG8_STAGE(PG8_SB(1, 0), b3, voffB); PG8_STAGE(PG8_SB(1, 1), b3 + hstep, voffB); PG8_STAGE(PG8_SA(1, 0), a3, voffA);
            PG8_WAIT_V(8); PG8_WAIT_L(0); PG8_BAR; PG8_MMA(1, 0, At, B0); PG8_MMA(1, 1, At, B1); PG8_BAR; PG8_SCHED;
            } else {
            PG8_LDB(B0, 0, 0); PG8_SCHED; PG8_LDA(At, 0, 0); PG8_STAGE(PG8_SA(1, 1), a1 + hstep, voffA);
            PG8_WAIT_L(8); PG8_BAR; PG8_WAIT_L(0); PG8_MMA(0, 0, At, B0); PG8_BAR; PG8_SCHED;
            PG8_LDB(B1, 0, 1); PG8_STAGE(PG8_SB(0, 0), b2, voffB);
            PG8_BAR; PG8_WAIT_L(0); PG8_MMA(0, 1, At, B1); PG8_BAR;
            PG8_LDA(At, 0, 1); PG8_STAGE(PG8_SA(0, 0), a2, voffA);
            PG8_BAR; PG8_WAIT_L(0); PG8_MMA(1, 0, At, B0); PG8_BAR; PG8_SCHED;
            PG8_STAGE(PG8_SB(0, 1), b2 + hstep, voffB);
            PG8_WAIT_V(6); PG8_BAR; PG8_MMA(1, 1, At, B1); PG8_BAR;
            PG8_LDB(B0, 1, 0); PG8_SCHED; PG8_LDA(At, 1, 0); PG8_STAGE(PG8_SA(0, 1), a2 + hstep, voffA);
            PG8_WAIT_L(8); PG8_BAR; PG8_WAIT_L(0); PG8_MMA(0, 0, At, B0); PG8_BAR; PG8_SCHED;
            PG8_LDB(B1, 1, 1); PG8_STAGE(PG8_SB(1, 0), b3, voffB);
            PG8_BAR; PG8_WAIT_L(0); PG8_MMA(0, 1, At, B1); PG8_BAR;
            PG8_LDA(At, 1, 1); PG8_STAGE(PG8_SA(1, 0), a3, voffA);
            PG8_BAR; PG8_WAIT_L(0); PG8_MMA(1, 0, At, B0); PG8_BAR; PG8_SCHED;
            PG8_STAGE(PG8_SB(1, 1), b3 + hstep, voffB);
            PG8_WAIT_V(6); PG8_BAR; PG8_MMA(1, 1, At, B1); PG8_BAR;
            }
        }
        if constexpr (ALIGN_EPI) { if (wr == 0) PG8_BAR; }
        if constexpr (!Epi::AFTER_DRAIN) { E(acc, cur, wr, wc, fr, fq); S.done(cur); }
        if (!has_next) break;
#pragma unroll
        for (int a = 0; a < 2; ++a)
#pragma unroll
            for (int b = 0; b < 2; ++b)
#pragma unroll
                for (int m = 0; m < 4; ++m)
#pragma unroll
                    for (int n = 0; n < 2; ++n) acc[a][b][m][n] = (f32x4){0.f, 0.f, 0.f, 0.f};
        cur = nxt; cA = nA; cB = nB; ++ui;
        if constexpr (ALIGN_EPI) { if (wr == 1) PG8_BAR; }
    }
    PG8_WAIT_V(0);
    if constexpr (!ALIGN_EPI) { if (wr == 0) PG8_BAR; }
    PG8_BAR;
    if constexpr (Epi::AFTER_DRAIN) { E.fused(acc, cur, wr, wc, fr, fq, lds, wid, lane); S.done(cur); }
#undef PG8_SA
#undef PG8_SB
#undef PG8_STAGE
#undef PG8_LDA
#undef PG8_LDB
#undef PG8_MMA
#undef PG8_WAIT_V
#undef PG8_WAIT_L
#undef PG8_BAR
#undef PG8_SCHED
}
}
#define XB_TMO      128
#define XB_XCNT(j)  (256  + 64 * (j))
#define XB_XSUB(j)  (1280 + 64 * (j))
#define XB_XGEN(j)  (2304 + 64 * (j))
#define XB_TOP      3328
#define XB_TOPGEN   3392
#define XCD_BAR_WORDS 3456
#define XB_SPIN_CAP (1u << 18)

__device__ __forceinline__ unsigned xb_ld(unsigned* p)              { return __hip_atomic_load(p, __ATOMIC_RELAXED, __HIP_MEMORY_SCOPE_AGENT); }
__device__ __forceinline__ unsigned xb_add(unsigned* p, unsigned v) { return __hip_atomic_fetch_add(p, v, __ATOMIC_RELAXED, __HIP_MEMORY_SCOPE_AGENT); }
__device__ __forceinline__ unsigned xb_xcc_id() { return (unsigned)__builtin_amdgcn_s_getreg((3 << 11) | 20) & 0xFu; }
#define XB_SPIN(cond, bar) do { unsigned _sp = 0; while (cond) { __builtin_amdgcn_s_sleep(1); \
    if ((++_sp & 255u) == 0u) { if (xb_ld(&(bar)[XB_TMO])) break; if (_sp > XB_SPIN_CAP) { atomicAdd(&(bar)[XB_TMO], 1u); break; } } } } while (0)

struct XcdBarrier {
    unsigned* bar; unsigned x;
    volatile LAS unsigned* st;
};

__device__ __forceinline__ XcdBarrier xcd_barrier_post(unsigned* bar, volatile LAS unsigned* st) {
    XcdBarrier b; b.bar = bar; b.x = xb_xcc_id(); b.st = st;
    if (threadIdx.x == 0) (void)xb_add(&bar[XB_XCNT(b.x)], 1u);
    return b;
}
__device__ __forceinline__ void xcd_barrier_complete(unsigned* bar, unsigned x, unsigned& nloc, unsigned& nx) {
    const unsigned G = gridDim.x * gridDim.y * gridDim.z;
    unsigned sum, cnt, mine, sp = 0u;
    for (;;) {
        sum = 0u; cnt = 0u; mine = 0u;
#pragma unroll
        for (unsigned j = 0; j < 16; ++j) { const unsigned c = xb_ld(&bar[XB_XCNT(j)]); sum += c; cnt += (c > 0u) ? 1u : 0u; mine = (j == x) ? c : mine; }
        if (sum == G) break;
        __builtin_amdgcn_s_sleep(1);
        if ((++sp & 255u) == 0u) { if (xb_ld(&bar[XB_TMO])) break; if (sp > XB_SPIN_CAP) { atomicAdd(&bar[XB_TMO], 1u); break; } }
    }
    nloc = mine > 0u ? mine : 1u; nx = cnt > 0u ? cnt : 1u;
}

__device__ __forceinline__ void xcd_barrier(const XcdBarrier& b) {
    asm volatile("s_waitcnt vmcnt(0)" ::: "memory");
    __syncthreads();
    if (threadIdx.x == 0) {
        unsigned* bar = b.bar;
        __builtin_amdgcn_s_waitcnt(0);
        unsigned nloc = b.st[0], nx = b.st[1];
        if (nloc == 0u) { xcd_barrier_complete(bar, b.x, nloc, nx); b.st[0] = nloc; b.st[1] = nx; }
        const unsigned old = xb_add(&bar[XB_XSUB(b.x)], 1u);
        const unsigned gen = old / nloc;
        if (old + 1u == (gen + 1u) * nloc) {
            __builtin_amdgcn_fence(__ATOMIC_RELEASE, "agent");
            asm volatile("s_waitcnt vmcnt(0)" ::: "memory");
            const unsigned og = xb_add(&bar[XB_TOP], 1u);
            const unsigned tg = og / nx;
            if (og + 1u == (tg + 1u) * nx) xb_add(&bar[XB_TOPGEN], 1u);
            else XB_SPIN(xb_ld(&bar[XB_TOPGEN]) == tg, bar);
            __builtin_amdgcn_fence(__ATOMIC_ACQUIRE, "agent");
            xb_add(&bar[XB_XGEN(b.x)], 1u);
            asm volatile("s_waitcnt vmcnt(0)" ::: "memory");
        } else {
            XB_SPIN(xb_ld(&bar[XB_XGEN(b.x)]) == gen, bar);
            __builtin_amdgcn_fence(__ATOMIC_ACQUIRE, "agent");
            asm volatile("s_waitcnt vmcnt(0)" ::: "memory");
        }
    }
    __syncthreads();
}
__device__ __forceinline__ float wave_sum(float v) {
#pragma unroll
    for (int o = 1; o < 64; o <<= 1) v += __shfl_xor(v, o);
    return v;
}
__device__ __forceinline__ float wave_max(float v) {
#pragma unroll
    for (int o = 1; o < 64; o <<= 1) v = fmaxf(v, __shfl_xor(v, o));
    return v;
}
__device__ __forceinline__ void p0_transpose_item(const float* W, int K, int N, bf16* WT, const float* ks, LAS float* scr, int item, int lane) {
    const int nblk = N / 32, kb = item / nblk, nb = item % nblk, k0 = 64 * kb, n0 = 32 * nb;
#pragma unroll 8
    for (int i = 0; i < 32; ++i) { const int kk = 2 * i + (lane >> 5); float w = W[(size_t)(k0 + kk) * N + n0 + (lane & 31)]; if (ks) w *= ks[k0 + kk]; scr[kk * 33 + (lane & 31)] = w; }
    LDS_WAIT(); asm volatile("" ::: "memory");
    const int c = lane & 7;
#pragma unroll
    for (int j = 0; j < 4; ++j) { const int n = (lane >> 3) + 8 * j; const LAS float* s = scr + (8 * c) * 33 + n;
        v4u o; o.x = pk2(s[0 * 33], s[1 * 33]); o.y = pk2(s[2 * 33], s[3 * 33]); o.z = pk2(s[4 * 33], s[5 * 33]); o.w = pk2(s[6 * 33], s[7 * 33]);
        *(GAS v4u*)(WT + (size_t)(n0 + n) * K + k0 + 8 * c) = o; }
    LDS_WAIT(); asm volatile("" ::: "memory");
}

struct Ptrs {
    const float* in[30]; float* out; unsigned char* ws;
};
#define WSP(T, off) ((T*)(P.ws + (off)))

__device__ __forceinline__ void p0_prologue(const Ptrs& P, LAS unsigned char* lds, int tid, int lane, int wave, int vcu, int G) {
    LAS float* scr = (LAS float*)(lds + RING_OFF + wave * 16384);
    const int gw = vcu * NWAVES + wave, NGW = G * NWAVES;
    constexpr int I0 = (DM / 64) * (NIN / 32), I1 = (MW / 64) * (DM / 32), I2 = (DM / 64) * (DM / 32), I3 = I2, I4 = (DM / 64) * (FF / 32), I5 = (FF / 64) * (DM / 32), I6 = I2, I7 = (PLE / 64) * (DM / 32);
    constexpr int NITEMS = I0 + I1 + I2 + I3 + I4 + I5 + I6 + I7;
    for (int it = gw; it < NITEMS; it += NGW) {
        int r = it;
        if (r < I0) { p0_transpose_item(P.in[11], DM, NIN, WSP(bf16, WS_WIN), nullptr, scr, r, lane); continue; } r -= I0;
        if (r < I1) { p0_transpose_item(P.in[14], MW, DM, WSP(bf16, WS_WOA), nullptr, scr, r, lane); continue; } r -= I1;
        if (r < I2) { p0_transpose_item(P.in[22], DM, DM, WSP(bf16, WS_WOB), nullptr, scr, r, lane); continue; } r -= I2;
        if (r < I3) { p0_transpose_item(P.in[23], DM, DM, WSP(bf16, WS_WO), nullptr, scr, r, lane); continue; } r -= I3;
        if (r < I4) { p0_transpose_item(P.in[25], DM, FF, WSP(bf16, WS_WUP), P.in[24], scr, r, lane); continue; } r -= I4;
        if (r < I5) { p0_transpose_item(P.in[26], FF, DM, WSP(bf16, WS_WDN), nullptr, scr, r, lane); continue; } r -= I5;
        if (r < I6) { p0_transpose_item(P.in[28], DM, DM, WSP(bf16, WS_WPG), P.in[27], scr, r, lane); continue; } r -= I6;
        p0_transpose_item(P.in[29], PLE, DM, WSP(bf16, WS_WPE), nullptr, scr, r, lane);
    }
    { const GAS f32x4* gm = (const GAS f32x4*)P.in[10] + lane; f32x4 g[4];
#pragma unroll
      for (int j = 0; j < 4; ++j) g[j] = gm[64 * j];
      bf16* HB = WSP(bf16, WS_HB);
      for (int m = gw; m < M; m += NGW) {
        const float* xrow = (m < MP) ? P.in[0] + (size_t)m * DM : P.in[1] + (size_t)(m - MP) * DM;
        const GAS f32x4* xr = (const GAS f32x4*)xrow + lane; f32x4 v[4]; float s = 0.f;
#pragma unroll
        for (int j = 0; j < 4; ++j) { v[j] = xr[64 * j]; s += (v[j].x * v[j].x + v[j].y * v[j].y) + (v[j].z * v[j].z + v[j].w * v[j].w); }
        const float rs = 1.0f / sqrtf(wave_sum(s) * (1.f / DM) + 1e-6f);
        GAS v2u* o8 = (GAS v2u*)(HB + (size_t)m * DM) + lane;
#pragma unroll
        for (int j = 0; j < 4; ++j) { v2u w; w.x = pk2(v[j].x * rs * g[j].x, v[j].y * rs * g[j].y); w.y = pk2(v[j].z * rs * g[j].z, v[j].w * rs * g[j].w); o8[64 * j] = w; }
      }
      bf16* PB = WSP(bf16, WS_PB);
      for (int m = gw; m < M; m += NGW) {
        const float* prow = (m < MP) ? P.in[2] + (size_t)m * PLE : P.in[3] + (size_t)(m - MP) * PLE;
        const f32x4 v = ((const GAS f32x4*)prow)[lane]; v2u w; w.x = pk2(v.x, v.y); w.y = pk2(v.z, v.w); ((GAS v2u*)(PB + (size_t)m * PLE))[lane] = w;
      }
    }
    const int gt = vcu * (NWAVES * 64) + tid, NT = G * NWAVES * 64;
    { bf16* WRG = WSP(bf16, WS_WRG);
      for (int e = gt; e < 2 * 65536; e += NT) { const int mat = e >> 16, n = (e >> 12) & 15, o = (e >> 6) & 63, i = e & 63;
          WRG[e] = (bf16)f2bf(P.in[mat ? 19 : 17][(n * 64 + i) * 64 + o]); }
      float* TAB = WSP(float, WS_TAB);
      for (int e = gt; e < 12 * 132; e += NT) { const int hh = e / 132, j = e % 132; float v = 0.f;
          if (j <= 128) { const int g = hh >> 2, dist = j << (2 * g); int bk;
              if (dist < 16) bk = dist; else { const double lg = log((double)dist / 16.0) / log(128.0) * 16.0; bk = 16 + (int)lg; if (bk > 31) bk = 31; }
              v = P.in[9][bk * 12 + hh] * 1.4426950408889634f; }
          TAB[e] = v; }
      for (int e = gt; e < 1024; e += NT) { const double x = (double)P.in[21][e]; const double ls = (x >= 0.0) ? -log1p(exp(-x)) : x - log1p(exp(x)); TAB[2048 + e] = (float)(8.0 * ls); }
    }
}

__device__ __forceinline__ unsigned offb(unsigned row, unsigned ch) { return 256u * row + 16u * (ch ^ (((row & 3u) << 2) | ((row >> 2) & 3u))); }
__device__ __forceinline__ s16x4 vtr(LAS const unsigned char* p) { typedef short v4i16_t __attribute__((ext_vector_type(4))); return __builtin_bit_cast(s16x4, __builtin_amdgcn_ds_read_tr16_b64_v4i16((LAS v4i16_t*)p)); }

__device__ __forceinline__ void attn_unit(const Ptrs& P, LAS unsigned char* lds, int uid, int tid, int lane, int w) {
    const int blk = uid & 63, h4 = (uid >> 6) & 3, b = (uid >> 8) & 7, g = uid >> 11;
    const int gsh = 2 * g, hh = 4 * g + h4;
    const bool first = (blk & ((64 >> gsh) - 1)) == 0;
    const size_t qrow0 = ((size_t)(b * 12 + hh) << 13) + (size_t)blk * 128;
    const bf16* Qb = WSP(bf16, WS_Q); const bf16* Kb = WSP(bf16, WS_K); const bf16* Vb = WSP(bf16, WS_V);
    LAS unsigned char* Kimg = lds; LAS unsigned char* Vimg = lds + 65536;
    const LAS float* bias = (const LAS float*)(lds + XCH_OFF) + hh * 132;
    const int qi = lane & 15, g4 = lane >> 4;
    {
        const int lr = lane >> 4, sl = lane & 15;
#pragma unroll
        for (int i = 0; i < 8; ++i) { const int p = w * 8 + i, row = 4 * p + lr; const int ch = sl ^ ((lr << 2) | (p & 3));
            const size_t srow = (first && row < 128) ? qrow0 + row : qrow0 - 128 + row;
            __builtin_amdgcn_global_load_lds((const unsigned*)((const char*)Kb + srow * 256 + ch * 16), (LAS unsigned*)(Kimg + p * 1024), 16, 0, 0);
            __builtin_amdgcn_global_load_lds((const unsigned*)((const char*)Vb + srow * 256 + ch * 16), (LAS unsigned*)(Vimg + p * 1024), 16, 0, 0); }
    }
    bf16x8 Qf[4];
    { const bf16* qp = Qb + (qrow0 + 16 * w + qi) * 128 + 8 * g4;
#pragma unroll
      for (int s = 0; s < 4; ++s) Qf[s] = *(const bf16x8*)(qp + 32 * s); }
    VM_WAIT(); __syncthreads();
    f32x4 S[9];
    { const unsigned fl = ((lane & 3) << 2) | ((lane >> 2) & 3);
      const LAS unsigned char* kp = Kimg + 256 * (16 * w + qi);
#pragma unroll
      for (int jb = 0; jb < 9; ++jb) { S[jb] = (f32x4){0.f, 0.f, 0.f, 0.f};
#pragma unroll
          for (int s = 0; s < 4; ++s) { const bf16x8 a = *(const LAS bf16x8*)(kp + jb * 4096 + 16 * ((4 * s + g4) ^ fl));
              S[jb] = __builtin_amdgcn_mfma_f32_16x16x32_bf16(a, Qf[s], S[jb], 0, 0, 0); } } }
    float mx = -1e30f;
#pragma unroll
    for (int jb = 0; jb < 9; ++jb)
#pragma unroll
        for (int i = 0; i < 4; ++i) { const int ki = 4 * g4 + i, rel = 16 * jb + ki - qi;
            int slot = 128 - rel; slot = slot < 0 ? 0 : (slot > 128 ? 128 : slot);
            bool ok = true; if (jb == 0) ok = rel >= 0; if (jb == 8) ok = rel <= 128;
            if (first) ok = ok && (16 * w + 16 * jb + ki >= 128);
            const float v = ok ? S[jb][i] + bias[slot] : -1e30f; S[jb][i] = v; mx = fmaxf(mx, v); }
    mx = fmaxf(mx, __shfl_xor(mx, 16)); mx = fmaxf(mx, __shfl_xor(mx, 32));
    float tot = 0.f;
#pragma unroll
    for (int jb = 0; jb < 9; ++jb)
#pragma unroll
        for (int i = 0; i < 4; ++i) { const float p = fexp2(S[jb][i] - mx); S[jb][i] = p; tot += p; }
    tot += __shfl_xor(tot, 16); tot += __shfl_xor(tot, 32);
    bf16x8 Pf[5];
#pragma unroll
    for (int ks = 0; ks < 5; ++ks) { v4u pk; pk.x = pk2(S[2 * ks][0], S[2 * ks][1]); pk.y = pk2(S[2 * ks][2], S[2 * ks][3]);
        if (ks < 4) { pk.z = pk2(S[2 * ks + 1][0], S[2 * ks + 1][1]); pk.w = pk2(S[2 * ks + 1][2], S[2 * ks + 1][3]); } else { pk.z = 0u; pk.w = 0u; }
        Pf[ks] = __builtin_bit_cast(bf16x8, pk); }
    f32x4 O[8];
#pragma unroll
    for (int c = 0; c < 8; ++c) O[c] = (f32x4){0.f, 0.f, 0.f, 0.f};
    { const int q = (lane & 15) >> 2, p = lane & 3; const unsigned fl = ((unsigned)q << 2) | (unsigned)g4;
      const LAS unsigned char* vp = Vimg + 256 * (16 * w + 4 * g4 + q) + 8 * (p & 1);
#pragma unroll
      for (int ks = 0; ks < 5; ++ks)
#pragma unroll
          for (int c = 0; c < 8; ++c) { const unsigned co = 16u * (((unsigned)(2 * c + (p >> 1))) ^ fl);
              const s16x4 lo = vtr(vp + 256 * (32 * ks) + co);
              const s16x4 hi = vtr(vp + 256 * (32 * ks + (ks < 4 ? 16 : 0)) + co);
              const bf16x8 a = (bf16x8){lo[0], lo[1], lo[2], lo[3], hi[0], hi[1], hi[2], hi[3]};
              O[c] = __builtin_amdgcn_mfma_f32_16x16x32_bf16(a, Pf[ks], O[c], 0, 0, 0); } }
    const float inv = frcp(tot);
    const int mq = (blk & ((64 >> gsh) - 1)) * 128 + 16 * w + qi, rr = blk >> (6 - gsh);
    const size_t R = (size_t)b * SEQ + ((size_t)mq << gsh) + rr;
    bf16* og = WSP(bf16, WS_OG) + ((size_t)g * MP + R) * MW + h4 * 128 + 4 * g4;
#pragma unroll
    for (int c = 0; c < 8; ++c) { v2u o; o.x = pk2(O[c][0] * inv, O[c][1] * inv); o.y = pk2(O[c][2] * inv, O[c][3] * inv); *(GAS v2u*)(og + 16 * c) = o; }
    if (g4 == 0) WSP(float, WS_LSE)[((size_t)g * MP + R) * 4 + h4] = mx + __log2f(tot);
    __syncthreads();
}

__device__ __forceinline__ void sattn_unit(const Ptrs& P, LAS unsigned char* lds, int su, int tid, int lane, int w) {
    const int b = su >> 2, t = su & 3; const int h = lane >> 4, sub = lane & 15;
    LAS float* LG = (LAS float*)lds;
    LAS float* PART = (LAS float*)(lds + 8192);
    const LAS float* bias = (const LAS float*)(lds + XCH_OFF);
    const float* QS = WSP(float, WS_QS) + (size_t)su * AW;
    const float* caches[3] = {P.in[4], P.in[5], P.in[6]};
#pragma unroll
    for (int g = 0; g < 3; ++g) {
        const int gsh = 2 * g, nbuf = 128 << gsh; const float* cache = caches[g]; const float* knew = P.out + pg8::kvs_off(g);
        const f32x4 q0 = *(const f32x4*)(QS + (4 * g + h) * 128 + 8 * sub), q1 = *(const f32x4*)(QS + (4 * g + h) * 128 + 8 * sub + 4);
        for (int j = w; j < 129; j += 8) { const int ridx = nbuf + t - (j << gsh);
            const float* rp = (ridx >= nbuf) ? knew + (size_t)(b * 4 + (ridx - nbuf)) * 1024 : cache + ((size_t)b * nbuf + ridx) * 1024;
            const f32x4 k0 = *(const f32x4*)(rp + h * 128 + 8 * sub), k1 = *(const f32x4*)(rp + h * 128 + 8 * sub + 4);
            float d = (q0[0] * k0[0] + q0[1] * k0[1]) + (q0[2] * k0[2] + q0[3] * k0[3]) + (q1[0] * k1[0] + q1[1] * k1[1]) + (q1[2] * k1[2] + q1[3] * k1[3]);
            d += __shfl_xor(d, 1); d += __shfl_xor(d, 2); d += __shfl_xor(d, 4); d += __shfl_xor(d, 8);
            if (sub == 0) LG[h * 392 + g * 129 + j] = d + bias[(4 * g + h) * 132 + j]; }
    }
    LDS_WAIT(); __syncthreads();
    float mxh = 0.f, invh = 0.f;
#pragma unroll
    for (int hd = 0; hd < 4; ++hd) { float m = -1e30f;
        for (int i = lane; i < 387; i += 64) m = fmaxf(m, LG[hd * 392 + i]);
        m = wave_max(m); float s = 0.f;
        for (int i = lane; i < 387; i += 64) s += fexp2(LG[hd * 392 + i] - m);
        s = wave_sum(s); if (hd == h) { mxh = m; invh = 1.0f / s; } }
    float acc[8];
#pragma unroll
    for (int i = 0; i < 8; ++i) acc[i] = 0.f;
#pragma unroll
    for (int g = 0; g < 3; ++g) {
        const int gsh = 2 * g, nbuf = 128 << gsh; const float* cache = caches[g]; const float* knew = P.out + pg8::kvs_off(g);
        for (int j = w; j < 129; j += 8) { const int ridx = nbuf + t - (j << gsh);
            const float* rp = (ridx >= nbuf) ? knew + (size_t)(b * 4 + (ridx - nbuf)) * 1024 : cache + ((size_t)b * nbuf + ridx) * 1024;
            const f32x4 v0 = *(const f32x4*)(rp + 512 + h * 128 + 8 * sub), v1 = *(const f32x4*)(rp + 512 + h * 128 + 8 * sub + 4);
            const float p = fexp2(LG[h * 392 + g * 129 + j] - mxh) * invh;
#pragma unroll
            for (int i = 0; i < 4; ++i) { acc[i] += p * v0[i]; acc[4 + i] += p * v1[i]; } }
    }
#pragma unroll
    for (int i = 0; i < 8; ++i) PART[w * 512 + lane * 8 + i] = acc[i];
    LDS_WAIT(); __syncthreads();
    { float s = 0.f;
#pragma unroll
      for (int k = 0; k < 8; ++k) s += PART[k * 512 + tid];
      WSP(bf16, WS_ATT)[(size_t)(MP + su) * MW + tid] = (bf16)f2bf(s); }
    __syncthreads();
}

__device__ __forceinline__ int crow(int r, int hi) { return (r & 3) + 8 * (r >> 2) + 4 * hi; }
template <bool OUT> __device__ __forceinline__ void lru_unit(const Ptrs& P, LAS unsigned char* lds, int b, int n, int rg, int tid, int lane, int w) {
    LAS unsigned char* AIMG = lds;
    LAS float* XC32 = (LAS float*)(lds + 16384);
    LAS float* HST = (LAS float*)(lds + 49152);
    LAS float* SUM = (LAS float*)(lds + 81920);
    LAS float* WC = (LAS float*)(lds + 84992);
    const int ch0 = 64 * n, tb = w >> 1, cb = w & 1, cl = lane & 31, hi = lane >> 5, mych = ch0 + 32 * cb + cl;
    if (tid < 320) { const int k = tid >> 6, i = tid & 63; WC[tid] = (k < 4) ? P.in[15][k * 1024 + ch0 + i] : P.in[16][ch0 + i]; }
    const bf16* WRG = WSP(bf16, WS_WRG);
    bf16x8 Bfa[4], Bfi[4];
#pragma unroll
    for (int s = 0; s < 4; ++s) { Bfa[s] = *(const bf16x8*)(WRG + ((size_t)(n * 64 + 32 * cb + cl) * 64 + 16 * s + 8 * hi));
                                  Bfi[s] = *(const bf16x8*)(WRG + 65536 + ((size_t)(n * 64 + 32 * cb + cl) * 64 + 16 * s + 8 * hi)); }
    const float ba = P.in[18][mych], bi = P.in[20][mych], c8l = WSP(float, WS_TAB)[2048 + mych] * 1.4426950408889634f;
    float hstate = (OUT && rg == 1) ? WSP(float, WS_TAB)[4096 + b * 1024 + mych] : 0.f;
    const int tl = tid >> 2, cg = tid & 3;
    const bf16* XB = WSP(bf16, WS_XB); const bf16* GY = WSP(bf16, WS_GY); bf16* HRG = WSP(bf16, WS_HRG);
    v4u xv[4][2];
    const int tbase = rg * 4096;
    { const int t0 = tbase;
#pragma unroll
      for (int k = 0; k < 4; ++k) { const int t = t0 + tl - 3 + k;
          if (t >= 0) { const v4u* p = (const v4u*)(XB + ((size_t)b * SEQ + t) * DM + ch0 + 16 * cg); xv[k][0] = p[0]; xv[k][1] = p[1]; }
          else { xv[k][0] = (v4u){0u, 0u, 0u, 0u}; xv[k][1] = (v4u){0u, 0u, 0u, 0u}; } } }
    LDS_WAIT(); __syncthreads();
    for (int ci = 0; ci < 32; ++ci) {
        const int t0 = tbase + ci * 128; const size_t R0 = (size_t)b * SEQ + t0;
        {
            float xc[16];
#pragma unroll
            for (int q = 0; q < 4; ++q) { const f32x4 bc = *(const LAS f32x4*)(WC + 256 + 16 * cg + 4 * q); xc[4 * q] = bc[0]; xc[4 * q + 1] = bc[1]; xc[4 * q + 2] = bc[2]; xc[4 * q + 3] = bc[3]; }
#pragma unroll
            for (int k = 0; k < 4; ++k)
#pragma unroll
                for (int q = 0; q < 4; ++q) { const f32x4 wv = *(const LAS f32x4*)(WC + 64 * k + 16 * cg + 4 * q);
                    const unsigned u0 = xv[k][q >> 1][(q & 1) * 2], u1 = xv[k][q >> 1][(q & 1) * 2 + 1];
                    xc[4 * q] += wv[0] * bflo(u0); xc[4 * q + 1] += wv[1] * bfhi(u0); xc[4 * q + 2] += wv[2] * bflo(u1); xc[4 * q + 3] += wv[3] * bfhi(u1); }
#pragma unroll
            for (int q = 0; q < 4; ++q) *(LAS f32x4*)(XC32 + tl * 64 + 16 * cg + 4 * q) = (f32x4){xc[4 * q], xc[4 * q + 1], xc[4 * q + 2], xc[4 * q + 3]};
#pragma unroll
            for (int e = 0; e < 2; ++e) { v4u o; o.x = pk2(xc[8 * e], xc[8 * e + 1]); o.y = pk2(xc[8 * e + 2], xc[8 * e + 3]); o.z = pk2(xc[8 * e + 4], xc[8 * e + 5]); o.w = pk2(xc[8 * e + 6], xc[8 * e + 7]);
                *(LAS v4u*)(AIMG + tl * 128 + 16 * ((2 * cg + e) ^ ((tl >> 1) & 7))) = o; }
        }
        v4u gy0, gy1;
        if (OUT) { const v4u* p = (const v4u*)(GY + (R0 + tl) * DM + ch0 + 16 * cg); gy0 = p[0]; gy1 = p[1]; }
        if (ci + 1 < 32) {
#pragma unroll
            for (int k = 0; k < 4; ++k) { const v4u* p = (const v4u*)(XB + (R0 + 128 + tl - 3 + k) * DM + ch0 + 16 * cg); xv[k][0] = p[0]; xv[k][1] = p[1]; } }
        LDS_WAIT(); __syncthreads();
        f32x16 za, zi;
#pragma unroll
        for (int i = 0; i < 16; ++i) { za[i] = 0.f; zi[i] = 0.f; }
        { const int row = 32 * tb + cl;
#pragma unroll
          for (int s = 0; s < 4; ++s) { const bf16x8 a = *(const LAS bf16x8*)(AIMG + row * 128 + 16 * ((2 * s + hi) ^ ((row >> 1) & 7)));
              za = __builtin_amdgcn_mfma_f32_32x32x16_bf16(a, Bfa[s], za, 0, 0, 0); zi = __builtin_amdgcn_mfma_f32_32x32x16_bf16(a, Bfi[s], zi, 0, 0, 0); } }
        float av[16], bv[16];
#pragma unroll
        for (int i = 0; i < 16; ++i) { const float xcv = XC32[(32 * tb + crow(i, hi)) * 64 + 32 * cb + cl];
            const float r = sigm(za[i] + ba), ig = sigm(zi[i] + bi); const float a = fexp2(c8l * r); av[i] = a; bv[i] = sqrtf(fmaxf(1.0f - a * a, 0.f)) * (ig * xcv); }
        float As[4], Bs[4], pAs[4], pBs[4], preA[4], preB[4];
#pragma unroll
        for (int sg = 0; sg < 4; ++sg) { float A = 1.f, B = 0.f;
#pragma unroll
            for (int e = 0; e < 4; ++e) { B = av[4 * sg + e] * B + bv[4 * sg + e]; A = av[4 * sg + e] * A; }
            As[sg] = A; Bs[sg] = B; pAs[sg] = __shfl_xor(A, 32); pBs[sg] = __shfl_xor(B, 32); }
        float PA = 1.f, PB = 0.f;
#pragma unroll
        for (int sg = 0; sg < 4; ++sg) {
            const float fA = hi ? pAs[sg] : As[sg], fB = hi ? pBs[sg] : Bs[sg], sA = hi ? As[sg] : pAs[sg], sB = hi ? Bs[sg] : pBs[sg];
            const float PB1 = fA * PB + fB, PA1 = fA * PA;
            preA[sg] = hi ? PA1 : PA; preB[sg] = hi ? PB1 : PB;
            PB = sA * PB1 + sB; PA = sA * PA1; }
        if (hi == 0) { SUM[(tb * 64 + 32 * cb + cl) * 2] = PA; SUM[(tb * 64 + 32 * cb + cl) * 2 + 1] = PB; }
        LDS_WAIT(); __syncthreads();
        float hin = hstate, hnew = hstate;
#pragma unroll
        for (int t = 0; t < 4; ++t) { const float A = SUM[(t * 64 + 32 * cb + cl) * 2], B = SUM[(t * 64 + 32 * cb + cl) * 2 + 1];
            hnew = A * hnew + B; if (t < tb) hin = hnew; }
        hstate = hnew;
        if (OUT) {
#pragma unroll
            for (int sg = 0; sg < 4; ++sg) { float hc = preA[sg] * hin + preB[sg];
#pragma unroll
                for (int e = 0; e < 4; ++e) { hc = av[4 * sg + e] * hc + bv[4 * sg + e]; HST[(32 * tb + 8 * sg + 4 * hi + e) * 64 + 32 * cb + cl] = hc; } }
            LDS_WAIT(); __syncthreads();
            f32x4 hv[4];
#pragma unroll
            for (int q = 0; q < 4; ++q) hv[q] = *(const LAS f32x4*)(HST + tl * 64 + 16 * cg + 4 * q);
            v4u o0, o1;
            o0.x = pk2(hv[0][0] * bflo(gy0.x), hv[0][1] * bfhi(gy0.x)); o0.y = pk2(hv[0][2] * bflo(gy0.y), hv[0][3] * bfhi(gy0.y));
            o0.z = pk2(hv[1][0] * bflo(gy0.z), hv[1][1] * bfhi(gy0.z)); o0.w = pk2(hv[1][2] * bflo(gy0.w), hv[1][3] * bfhi(gy0.w));
            o1.x = pk2(hv[2][0] * bflo(gy1.x), hv[2][1] * bfhi(gy1.x)); o1.y = pk2(hv[2][2] * bflo(gy1.y), hv[2][3] * bfhi(gy1.y));
            o1.z = pk2(hv[3][0] * bflo(gy1.z), hv[3][1] * bfhi(gy1.z)); o1.w = pk2(hv[3][2] * bflo(gy1.w), hv[3][3] * bfhi(gy1.w));
            v4u* op = (v4u*)(HRG + (R0 + tl) * DM + ch0 + 16 * cg); op[0] = o0; op[1] = o1;
        }
    }
    if (tb == 0 && hi == 0) {
        if (!OUT) WSP(float, WS_TAB)[4096 + b * 1024 + mych] = hstate;
        else if (rg == 1) P.out[pg8::O_LRUP + (size_t)b * 1024 + mych] = hstate;
    }
    __syncthreads();
}

__device__ __forceinline__ void lru_sample(const Ptrs& P, int gt) {
    const int b = gt >> 10, ch = gt & 1023, n = ch >> 6, o = ch & 63;
    const float* XBS = WSP(float, WS_XBS); const float* sc = P.in[7] + (size_t)b * 3 * 1024; const float* wcv = P.in[15]; const float* bcv = P.in[16];
    float za[4] = {0.f, 0.f, 0.f, 0.f}, zi[4] = {0.f, 0.f, 0.f, 0.f}, xo[4] = {0.f, 0.f, 0.f, 0.f};
    for (int i = 0; i < 64; ++i) { const int c = 64 * n + i;
        float xcat[7];
#pragma unroll
        for (int k = 0; k < 3; ++k) xcat[k] = sc[k * 1024 + c];
#pragma unroll
        for (int k = 0; k < 4; ++k) xcat[3 + k] = XBS[(size_t)(4 * b + k) * 1024 + c];
        const float w0 = wcv[c], w1 = wcv[1024 + c], w2 = wcv[2048 + c], w3 = wcv[3072 + c], bc = bcv[c];
        const float wa = P.in[17][(n * 64 + i) * 64 + o], wi = P.in[19][(n * 64 + i) * 64 + o];
#pragma unroll
        for (int t = 0; t < 4; ++t) { const float xc = bc + w0 * xcat[t] + w1 * xcat[t + 1] + w2 * xcat[t + 2] + w3 * xcat[t + 3];
            za[t] += xc * wa; zi[t] += xc * wi; xo[t] = (i == o) ? xc : xo[t]; } }
    const float ba = P.in[18][ch], bi = P.in[20][ch], c8l = WSP(float, WS_TAB)[2048 + ch] * 1.4426950408889634f;
    float h = P.in[8][(size_t)b * 1024 + ch];
    const bf16* GY = WSP(bf16, WS_GY); bf16* HRG = WSP(bf16, WS_HRG);
#pragma unroll
    for (int t = 0; t < 4; ++t) { const float r = sigm(za[t] + ba), ig = sigm(zi[t] + bi), a = fexp2(c8l * r);
        h = a * h + sqrtf(fmaxf(1.0f - a * a, 0.f)) * (ig * xo[t]);
        const size_t idx = (size_t)(MP + 4 * b + t) * DM + ch;
        HRG[idx] = (bf16)f2bf(h * __uint_as_float((unsigned)GY[idx] << 16)); }
    P.out[pg8::O_LRUS + (size_t)b * 1024 + ch] = h;
}

__device__ __forceinline__ void combine_items(const Ptrs& P, int gt, int NT) {
    const bf16* OG = WSP(bf16, WS_OG); const float* LSE = WSP(float, WS_LSE); bf16* ATT = WSP(bf16, WS_ATT);
    for (int it = gt; it < MP * 64; it += NT) { const int R = it >> 6, ck = it & 63, h4 = ck >> 4;
        const float l0 = LSE[((size_t)0 * MP + R) * 4 + h4], l1 = LSE[((size_t)1 * MP + R) * 4 + h4], l2 = LSE[((size_t)2 * MP + R) * 4 + h4];
        const float mx = fmaxf(l0, fmaxf(l1, l2)); float w0 = fexp2(l0 - mx), w1 = fexp2(l1 - mx), w2 = fexp2(l2 - mx); const float inv = 1.0f / (w0 + w1 + w2); w0 *= inv; w1 *= inv; w2 *= inv;
        const v4u a = *(const v4u*)(OG + ((size_t)0 * MP + R) * MW + ck * 8), bq = *(const v4u*)(OG + ((size_t)1 * MP + R) * MW + ck * 8), c = *(const v4u*)(OG + ((size_t)2 * MP + R) * MW + ck * 8);
        v4u o;
        o.x = pk2(w0 * bflo(a.x) + w1 * bflo(bq.x) + w2 * bflo(c.x), w0 * bfhi(a.x) + w1 * bfhi(bq.x) + w2 * bfhi(c.x));
        o.y = pk2(w0 * bflo(a.y) + w1 * bflo(bq.y) + w2 * bflo(c.y), w0 * bfhi(a.y) + w1 * bfhi(bq.y) + w2 * bfhi(c.y));
        o.z = pk2(w0 * bflo(a.z) + w1 * bflo(bq.z) + w2 * bflo(c.z), w0 * bfhi(a.z) + w1 * bfhi(bq.z) + w2 * bfhi(c.z));
        o.w = pk2(w0 * bflo(a.w) + w1 * bflo(bq.w) + w2 * bflo(c.w), w0 * bfhi(a.w) + w1 * bfhi(bq.w) + w2 * bfhi(c.w));
        *(v4u*)(ATT + (size_t)R * MW + ck * 8) = o; }
}
struct Args { const float* in[30]; float* out; unsigned char* ws; int ph_lo, ph_hi, li, sub; };
__global__ void __launch_bounds__(NWAVES * 64, 2) fwd_kernel(Args args) {
    extern __shared__ __attribute__((aligned(16))) unsigned char lds_raw[];
    LAS unsigned char* lds = (LAS unsigned char*)lds_raw;
    volatile LAS unsigned* MISC = (volatile LAS unsigned*)(lds + MISC_OFF);
    const int tid0 = threadIdx.x; const int wave0 = __builtin_amdgcn_readfirstlane(tid0 >> 6);
    const int G = gridDim.x, bx = blockIdx.x; const int vcu = (G % 8 == 0) ? (bx % 8) * (G / 8) + bx / 8 : bx;
    typedef __attribute__((address_space(4))) const Args* KArgs;
    KArgs ap0 = (KArgs)__builtin_amdgcn_kernarg_segment_ptr();
    gu32* ctl = (gu32*)(args.ws + WS_CTL);
    for (int u = tid0; u < 32; u += NWAVES * 64) MISC[u] = 0u;
    __syncthreads();
    XcdBarrier bar; bar.bar = (unsigned*)(ctl + CW_BAR) + args.li * XCD_BAR_WORDS; bar.x = 0; bar.st = nullptr;
    if (N_LAUNCHES != PER_PHASE) bar = xcd_barrier_post((unsigned*)(ctl + CW_BAR) + args.li * XCD_BAR_WORDS, MISC + 8);
#define GRID_BAR() do { if (N_LAUNCHES != PER_PHASE) xcd_barrier(bar); } while (0)
    const int lo = args.ph_lo, hi = args.ph_hi, sub = args.sub;
#ifndef PH_MASK
#define PH_MASK 0x1ff
#endif
#define IN(k) (((PH_MASK >> (k)) & 1) && lo <= (k) && (k) < hi)
#define BOTH(k) (IN(k) && IN((k) + 1))
    LAS float* XCH = (LAS float*)(lds + XCH_OFF);
    const int NT = G * NWAVES * 64;

#define LOAD_P() KArgs ap = ap0; asm volatile("" : "+s"(ap)); Ptrs P; _Pragma("unroll") for (int i_ = 0; i_ < 30; ++i_) P.in[i_] = ap->in[i_]; P.out = ap->out; P.ws = ap->ws
#define OPAQUE_TID() LOAD_P(); int tid = (wave0 << 6) | (int)__builtin_amdgcn_mbcnt_hi(~0u, __builtin_amdgcn_mbcnt_lo(~0u, 0u)); asm volatile("" : "+v"(tid)); const int lane = tid & 63, wave = wave0; const int gt = vcu * (NWAVES * 64) + tid
    if (IN(0)) { OPAQUE_TID(); p0_prologue(P, lds, tid, lane, wave, vcu, G); if (BOTH(0)) GRID_BAR(); }

    if (IN(1)) {
        LOAD_P();
        pg8::Gemm g{WSP(pg8::bf16_t, WS_HB), WSP(pg8::bf16_t, WS_WIN), M, NIN, DM}; pg8::StaticOrder S; S.init(M, NIN, G, bx);
        pg8::Epi1 E{P.ws, P.out, P.in[12], P.in[13], XCH};
        pg8::gemm_phase<pg8::Epi1, pg8::StaticOrder, true, true>(lds + RING_OFF, g, S, E, wave0);
        if (BOTH(1)) GRID_BAR();
    }

    if (IN(2)) {
        OPAQUE_TID();
        { const float* TAB = WSP(float, WS_TAB); for (int e = tid; e < 12 * 132; e += NWAVES * 64) XCH[e] = TAB[e]; }
        LDS_WAIT(); __syncthreads();
        if ((sub & 1) && vcu < 128) lru_unit<false>(P, lds, vcu >> 4, vcu & 15, 0, tid, lane, wave);
        if (sub & 2) for (int su = vcu; su < MS; su += G) sattn_unit(P, lds, su, tid, lane, wave);
        if (sub & 4) { const int per = (6144 + G - 1) / G; const int u0 = vcu * per, u1 = (u0 + per < 6144) ? u0 + per : 6144;
          for (int u = u0; u < u1; ++u) attn_unit(P, lds, u, tid, lane, wave); }
        if (BOTH(2)) GRID_BAR();
    }

    if (IN(3)) {
        OPAQUE_TID();
        if (sub & 1) for (int u = vcu; u < 256; u += G) lru_unit<true>(P, lds, u >> 5, (u >> 1) & 15, u & 1, tid, lane, wave);
        if (sub & 2) for (int t = gt; t < DBATCH * 1024; t += NT) lru_sample(P, t);
        if (sub & 4) combine_items(P, gt, NT);
        if (BOTH(3)) GRID_BAR();
    }

    if (IN(4)) {
        LOAD_P();
        { pg8::Gemm g{WSP(pg8::bf16_t, WS_ATT), WSP(pg8::bf16_t, WS_WOA), M, DM, MW}; pg8::StaticOrder S; S.init(M, DM, G, bx);
          pg8::Epi2<pg8::E_AMIX> E{WSP(pg8::bf16_t, WS_SGA), nullptr, WSP(pg8::bf16_t, WS_AMIX), nullptr, nullptr, nullptr, nullptr, nullptr, XCH};
          pg8::gemm_phase<pg8::Epi2<pg8::E_AMIX>, pg8::StaticOrder, true, true>(lds + RING_OFF, g, S, E, wave0); }
        VM_WAIT(); __syncthreads();
        { pg8::Gemm g{WSP(pg8::bf16_t, WS_HRG), WSP(pg8::bf16_t, WS_WOB), M, DM, DM}; pg8::StaticOrder S; S.init(M, DM, G, bx);
          pg8::Epi2<pg8::E_MIX> E{WSP(pg8::bf16_t, WS_SGB), WSP(pg8::bf16_t, WS_AMIX), WSP(pg8::bf16_t, WS_MIX), nullptr, nullptr, nullptr, nullptr, nullptr, XCH};
          pg8::gemm_phase<pg8::Epi2<pg8::E_MIX>, pg8::StaticOrder, true, true>(lds + RING_OFF, g, S, E, wave0); }
        if (BOTH(4)) GRID_BAR();
    }

    if (IN(5)) {
        LOAD_P();
        pg8::Gemm g{WSP(pg8::bf16_t, WS_MIX), WSP(pg8::bf16_t, WS_WO), M, DM, DM}; pg8::StaticOrder S; S.init(M, DM, G, bx);
        pg8::Epi2<pg8::E_X1> E{nullptr, nullptr, WSP(pg8::bf16_t, WS_X1B), nullptr, P.in[0], P.in[1], WSP(float, WS_SS1), nullptr, XCH};
        pg8::gemm_phase<pg8::Epi2<pg8::E_X1>, pg8::StaticOrder, true, true>(lds + RING_OFF, g, S, E, wave0);
        if (BOTH(5)) GRID_BAR();
    }

    if (IN(6)) {
        LOAD_P();
        pg8::Gemm g{WSP(pg8::bf16_t, WS_X1B), WSP(pg8::bf16_t, WS_WUP), M, FF, DM}; pg8::StaticOrder S; S.init(M, FF, G, bx);
        pg8::Epi2<pg8::E_UP> E{nullptr, nullptr, WSP(pg8::bf16_t, WS_U), nullptr, nullptr, nullptr, nullptr, WSP(float, WS_SS1), XCH};
        pg8::gemm_phase<pg8::Epi2<pg8::E_UP>, pg8::StaticOrder, true, true>(lds + RING_OFF, g, S, E, wave0);
        if (BOTH(6)) GRID_BAR();
    }

    if (IN(7)) {
        LOAD_P();
        pg8::Gemm g{WSP(pg8::bf16_t, WS_U), WSP(pg8::bf16_t, WS_WDN), M, DM, FF}; pg8::StaticOrder S; S.init(M, DM, G, bx);
        pg8::Epi2<pg8::E_X2> E{WSP(pg8::bf16_t, WS_X1B), nullptr, WSP(pg8::bf16_t, WS_X2B), nullptr, nullptr, nullptr, WSP(float, WS_SS2), nullptr, XCH};
        pg8::gemm_phase<pg8::Epi2<pg8::E_X2>, pg8::StaticOrder, true, true>(lds + RING_OFF, g, S, E, wave0);
        if (BOTH(7)) GRID_BAR();
    }

    if (IN(8)) {
        LOAD_P();
        { pg8::Gemm g{WSP(pg8::bf16_t, WS_PB), WSP(pg8::bf16_t, WS_WPE), M, DM, PLE}; pg8::StaticOrder S; S.init(M, DM, G, bx);
          pg8::Epi2<pg8::E_PE> E{nullptr, nullptr, WSP(pg8::bf16_t, WS_PEP), nullptr, nullptr, nullptr, nullptr, nullptr, XCH};
          pg8::gemm_phase<pg8::Epi2<pg8::E_PE>, pg8::StaticOrder, true, true>(lds + RING_OFF, g, S, E, wave0); }
        VM_WAIT(); __syncthreads();
        { pg8::Gemm g{WSP(pg8::bf16_t, WS_X2B), WSP(pg8::bf16_t, WS_WPG), M, DM, DM}; pg8::StaticOrder S; S.init(M, DM, G, bx);
          pg8::Epi2<pg8::E_Y> E{WSP(pg8::bf16_t, WS_PEP), WSP(pg8::bf16_t, WS_X2B), nullptr, P.out, nullptr, nullptr, nullptr, WSP(float, WS_SS2), XCH};
          pg8::gemm_phase<pg8::Epi2<pg8::E_Y>, pg8::StaticOrder, true, true>(lds + RING_OFF, g, S, E, wave0); }
    }
#undef IN
#undef BOTH
#undef GRID_BAR
}

extern "C" void kernel_launch(void* const* d_in, const int* in_sizes, int n_in, void* d_out, int out_size, void* d_ws, size_t ws_size, hipStream_t stream) {
    static int grid = 0;
    if (grid == 0) {
        if (n_in != 30 || in_sizes[0] != MP * DM || out_size != (int)pg8::O_END || ws_size < WS_END) {
            fprintf(stderr, "kernel_launch: unexpected shapes (n_in %d, in0 %d, out %d, ws %zu, need %zu); nothing launched\n", n_in, n_in > 0 ? in_sizes[0] : -1, out_size, ws_size, (size_t)WS_END); grid = -1; return; }
        int dev = 0, cus = 0, per_cu = 0;
        if (hipGetDevice(&dev) != hipSuccess || hipDeviceGetAttribute(&cus, hipDeviceAttributeMultiprocessorCount, dev) != hipSuccess) { grid = -1; return; }
        if (hipFuncSetAttribute((const void*)fwd_kernel, hipFuncAttributeMaxDynamicSharedMemorySize, LDS_BYTES) != hipSuccess) { fprintf(stderr, "kernel_launch: hipFuncSetAttribute failed\n"); grid = -1; return; }
        if (hipOccupancyMaxActiveBlocksPerMultiprocessor(&per_cu, (const void*)fwd_kernel, NWAVES * 64, LDS_BYTES) != hipSuccess || per_cu < 1)
            fprintf(stderr, "kernel_launch: note: occupancy query reports %d workgroups per CU\n", per_cu);
        (void)hipGetLastError();
        grid = cus;
    }
    if (grid < 0) return;
    if (hipMemsetAsync((char*)d_ws + WS_CTL, 0, CTL_ZERO_BYTES, stream) != hipSuccess) { fprintf(stderr, "kernel_launch: hipMemsetAsync failed\n"); return; }
    Args a{};
    for (int i = 0; i < 30; ++i) a.in[i] = (const float*)d_in[i];
    a.out = (float*)d_out; a.ws = (unsigned char*)d_ws;
#if defined(PROBE_DUP)
    const int cut[4] = {0, PROBE_DUP + 1, PROBE_DUP + 1, PER_PHASE};
    for (int li = 0; li < 3; ++li) {
        a.ph_lo = (li == 1) ? PROBE_DUP : cut[li]; a.ph_hi = (li == 1) ? PROBE_DUP + 1 : cut[li + 1]; a.li = li; a.sub = (li == 1) ? PROBE_SUB : 7;
        if (a.ph_lo >= a.ph_hi) continue;
        hipLaunchKernelGGL(fwd_kernel, dim3(grid), dim3(NWAVES * 64), LDS_BYTES, stream, a);
    }
#else
    for (int li = 0; li < N_LAUNCHES; ++li) {
        a.ph_lo = (N_LAUNCHES == PER_PHASE) ? li : 0; a.ph_hi = (N_LAUNCHES == PER_PHASE) ? li + 1 : PER_PHASE; a.li = (N_LAUNCHES == PER_PHASE) ? 0 : li; a.sub = 7;
        hipLaunchKernelGGL(fwd_kernel, dim3(grid), dim3(NWAVES * 64), LDS_BYTES, stream, a);
        const hipError_t le = hipPeekAtLastError();
        if (le != hipSuccess) { fprintf(stderr, "kernel_launch: launch %d failed: %s\n", li, hipGetErrorName(le)); break; }
    }
#endif
}
```

```cpp
#include <hip/hip_runtime.h>
#include <cstdio>
#include <cstdint>
#include <cmath>
#define MK_N_LAUNCHES 1

constexpr int NWAVES = 8;
#ifndef MK_N_LAUNCHES
#define MK_N_LAUNCHES 1
#endif
constexpr int N_LAUNCHES = MK_N_LAUNCHES;
constexpr int PER_PHASE = 9;

constexpr int DM = 1024, NBATCH = 8, SEQ = 8192, DBATCH = 128, DSEQ = 4;
constexpr int MP = NBATCH * SEQ, MS = DBATCH * DSEQ, M = MP + MS;
constexpr int NIN = 8704, FF = 4096, PLE = 256, AW = 1536, MW = 512;
static_assert(M % 256 == 0 && NIN % 256 == 0, "tile shapes");

constexpr size_t MiB = 1u << 20;
constexpr size_t al(size_t x) { return (x + MiB - 1) / MiB * MiB; }
constexpr size_t WS_CTL = 0, CTL_ZERO_BYTES = 1 * MiB;
constexpr size_t WS_WIN = 1 * MiB;
constexpr size_t WS_WOA = WS_WIN + al((size_t)NIN * DM * 2);
constexpr size_t WS_WOB = WS_WOA + al((size_t)DM * MW * 2);
constexpr size_t WS_WO = WS_WOB + al((size_t)DM * DM * 2);
constexpr size_t WS_WUP = WS_WO + al((size_t)DM * DM * 2);
constexpr size_t WS_WDN = WS_WUP + al((size_t)FF * DM * 2);
constexpr size_t WS_WPG = WS_WDN + al((size_t)FF * DM * 2);
constexpr size_t WS_WPE = WS_WPG + al((size_t)DM * DM * 2);
constexpr size_t WS_WRG = WS_WPE + al((size_t)DM * PLE * 2);
constexpr size_t WS_TAB = WS_WRG + MiB;
constexpr size_t WS_HB = WS_TAB + MiB;
constexpr size_t ACT = al((size_t)M * DM * 2);
constexpr size_t WS_Q = WS_HB + ACT;
constexpr size_t QKV = (size_t)MP * AW * 2;
constexpr size_t WS_K = WS_Q + QKV, WS_V = WS_K + QKV;
constexpr size_t WS_XB = WS_V + QKV, WS_GY = WS_XB + ACT, WS_SGA = WS_GY + ACT, WS_SGB = WS_SGA + ACT;
constexpr size_t WS_QS = WS_SGB + ACT;
constexpr size_t WS_XBS = WS_QS + al((size_t)MS * AW * 4);
constexpr size_t WS_OG = WS_XBS + al((size_t)MS * DM * 4);
constexpr size_t WS_LSE = WS_OG + al((size_t)3 * MP * MW * 2);
constexpr size_t WS_ATT = WS_LSE + al((size_t)3 * MP * 4 * 4);
constexpr size_t WS_HRG = WS_ATT + al((size_t)M * MW * 2);
constexpr size_t WS_AMIX = WS_HRG + ACT, WS_MIX = WS_AMIX + ACT, WS_X1B = WS_MIX + ACT, WS_X2B = WS_X1B + ACT;
constexpr size_t WS_U = WS_X2B + ACT;
constexpr size_t WS_PB = WS_U + al((size_t)M * FF * 2);
constexpr size_t WS_PEP = WS_PB + al((size_t)M * PLE * 2);
constexpr size_t WS_SS1 = WS_PEP + ACT;
constexpr size_t WS_SS2 = WS_SS1 + al((size_t)M * 4 * 4);
constexpr size_t WS_DUMP = WS_SS2 + al((size_t)M * 4 * 4);
constexpr size_t WS_END = WS_DUMP + 32 * MiB;
constexpr int CW_Q = 16384;
constexpr int CW_BAR = 4096;

constexpr int RING_OFF = 0, RING_BYTES = 131072;
constexpr int XCH_OFF = 131072;
constexpr int MISC_OFF = 139264;
constexpr int LDS_BYTES = 147456;

#define GAS __attribute__((address_space(1)))
#define LAS __attribute__((address_space(3)))
typedef unsigned short bf16;
typedef unsigned v4u __attribute__((ext_vector_type(4)));
typedef unsigned v2u __attribute__((ext_vector_type(2)));
typedef float f32x4 __attribute__((ext_vector_type(4)));
typedef float f32x16 __attribute__((ext_vector_type(16)));
typedef short bf16x8 __attribute__((ext_vector_type(8)));
typedef short s16x4 __attribute__((ext_vector_type(4)));
typedef GAS unsigned gu32;
#define RLX_AGENT __ATOMIC_RELAXED, __HIP_MEMORY_SCOPE_AGENT
#define LDS_WAIT() asm volatile("s_waitcnt lgkmcnt(0)" ::: "memory")
#define VM_WAIT() asm volatile("s_waitcnt vmcnt(0)" ::: "memory")
__device__ __forceinline__ unsigned f2bf(float f) { unsigned u = __builtin_bit_cast(unsigned, f); return (u + 0x7fffu + ((u >> 16) & 1u)) >> 16; }
typedef float f32x2_t __attribute__((ext_vector_type(2))); typedef __bf16 bf16x2_t __attribute__((ext_vector_type(2)));
__device__ __forceinline__ unsigned pk2(float lo, float hi) { f32x2_t v = {lo, hi}; bf16x2_t b = __builtin_convertvector(v, bf16x2_t); return __builtin_bit_cast(unsigned, b); }
__device__ __forceinline__ float bflo(unsigned w) { return __uint_as_float(w << 16); }
__device__ __forceinline__ float bfhi(unsigned w) { return __uint_as_float(w & 0xffff0000u); }
__device__ __forceinline__ float fexp2(float x) { return __builtin_amdgcn_exp2f(x); }
__device__ __forceinline__ float frcp(float x) { return __builtin_amdgcn_rcpf(x); }
__device__ __forceinline__ float sigm(float x) { return frcp(1.0f + fexp2(-1.4426950408889634f * x)); }
namespace pg8 {
#define PG8_LAS __attribute__((address_space(3)))
typedef unsigned short bf16_t;
typedef short bf16x8 __attribute__((ext_vector_type(8)));
typedef float f32x4 __attribute__((ext_vector_type(4)));
typedef unsigned u32x4 __attribute__((ext_vector_type(4)));
constexpr int BM = 256, BK = 64, HALF = 128, HTB = HALF * BK * 2  , STAGE_BYTES = 8 * HTB, NXCD = 8, WGM = 4;

__host__ __device__ __forceinline__ int lds_byte(int r, int c) { const int st = (r >> 4) * 2 + (c >> 5), rr = r & 15, cc = c & 31, ob = rr * 64 + cc * 2; return st * 1024 + (ob ^ (((ob >> 9) & 1) << 5)); }
__host__ __device__ __forceinline__ void stage_rc(int b, int& R, int& C) { const int st = b / 1024, sb = b % 1024, swz = sb ^ (((sb >> 9) & 1) << 5); R = (st >> 1) * 16 + swz / 64; C = (st & 1) * 32 + (swz % 64) / 2; }
__host__ __device__ __forceinline__ int perm32(int rho) { const int n = rho >> 4, i = rho & 15; return 8 * (i >> 2) + 4 * n + (i & 3); }

struct Unit { int pm, pn; };
struct Gemm { const bf16_t* A; const bf16_t* Bt; int M, N, K; };

struct StaticOrder {
    int nM, nN, nwg, G, c;
    __host__ __device__ void init(int M, int N, int G_, int c_) { nM = M / BM; nN = N / BM; nwg = nM * nN; G = G_; c = c_; }
    __host__ __device__ bool next(int i, Unit& u) const {
        const long L = (long)i * G + c; if (L >= nwg) return false;
        int wgid = (int)L; { const int q = nwg / NXCD, r = nwg % NXCD, xcd = wgid % NXCD, off = wgid / NXCD; wgid = (xcd < r ? xcd * (q + 1) : r * (q + 1) + (xcd - r) * q) + off; }
        const int nig = WGM * nN, gid = wgid / nig, fm = gid * WGM, gsz = (nM - fm) < WGM ? (nM - fm) : WGM;
        u.pm = fm + ((wgid % nig) % gsz); u.pn = (wgid % nig) / gsz; return true;
    }
    __device__ __forceinline__ void a_ready(const Unit&) const {}
    __device__ __forceinline__ void done(const Unit&) const {}
};
__device__ __forceinline__ unsigned cvt_pk_bf16(float lo, float hi) { unsigned r; asm volatile("v_cvt_pk_bf16_f32 %0, %1, %2" : "=v"(r) : "v"(lo), "v"(hi)); return r; }
typedef float f32x2 __attribute__((ext_vector_type(2)));
typedef unsigned u32x2 __attribute__((ext_vector_type(2)));
constexpr float RMS_EPS = 1e-6f;
constexpr float QSCALE = 0.08838834764831845f * 1.4426950408889634f;
constexpr size_t O_YP = 0, O_YS = 67108864, O_KV1P = 67633152, O_KV2P = 68681728, O_KV3P = 72876032, O_CONVP = 89653248, O_LRUP = 89677824,
                 O_KV1S = 89686016, O_KV2S = 90210304, O_KV3S = 90734592, O_CONVS = 91258880, O_LRUS = 91652096, O_END = 91783168;
__device__ __forceinline__ size_t kvp_off(int g) { return g == 0 ? O_KV1P : (g == 1 ? O_KV2P : O_KV3P); }
__device__ __forceinline__ size_t kvs_off(int g) { return g == 0 ? O_KV1S : (g == 1 ? O_KV2S : O_KV3S); }

__device__ __forceinline__ float fsigmoid(float x) { return __builtin_amdgcn_rcpf(1.0f + __builtin_amdgcn_exp2f(-1.4426950408889634f * x)); }
__device__ __forceinline__ float fgelu_tanh(float x) { const float u = x + 0.044715f * x * x * x; return x * __builtin_amdgcn_rcpf(1.0f + __builtin_amdgcn_exp2f(-2.3022082232f * u)); }
__device__ __forceinline__ float bf_lo(unsigned w) { return __uint_as_float(w << 16); }
__device__ __forceinline__ float bf_hi(unsigned w) { return __uint_as_float(w & 0xffff0000u); }
__device__ __forceinline__ u32x4 pack8(const f32x4& a, const f32x4& b) { u32x4 w; w.x = cvt_pk_bf16(a[0], a[1]); w.y = cvt_pk_bf16(a[2], a[3]); w.z = cvt_pk_bf16(b[0], b[1]); w.w = cvt_pk_bf16(b[2], b[3]); return w; }
__device__ __forceinline__ void unpack8(const u32x4& w, f32x4& a, f32x4& b) { a = (f32x4){bf_lo(w.x), bf_hi(w.x), bf_lo(w.y), bf_hi(w.y)}; b = (f32x4){bf_lo(w.z), bf_hi(w.z), bf_lo(w.w), bf_hi(w.w)}; }
__device__ __forceinline__ float sq8(const f32x4& a, const f32x4& b) { return (a[0] * a[0] + a[1] * a[1]) + (a[2] * a[2] + a[3] * a[3]) + (b[0] * b[0] + b[1] * b[1]) + (b[2] * b[2] + b[3] * b[3]); }

__device__ __forceinline__ void rowss_exchange(float (&ss)[2][4][2], PG8_LAS float* P, int wr, int wc, int fr, int fq) {
#pragma unroll
    for (int ai = 0; ai < 2; ++ai)
#pragma unroll
        for (int m = 0; m < 4; ++m)
#pragma unroll
            for (int bj = 0; bj < 2; ++bj) { float s = ss[ai][m][bj]; s += __shfl_xor(s, 16); s += __shfl_xor(s, 32);
                if (fq == 0) P[(ai * HALF + wr * 64 + m * 16 + fr) * 8 + bj * 4 + wc] = s; }
    asm volatile("s_waitcnt lgkmcnt(0)" ::: "memory"); __builtin_amdgcn_s_barrier(); asm volatile("" ::: "memory");
#pragma unroll
    for (int ai = 0; ai < 2; ++ai)
#pragma unroll
        for (int m = 0; m < 4; ++m) { const PG8_LAS f32x4* p = (const PG8_LAS f32x4*)(P + (ai * HALF + wr * 64 + m * 16 + fr) * 8);
            const f32x4 a = p[0], b = p[1]; ss[ai][m][0] = (a[0] + a[1]) + (a[2] + a[3]); ss[ai][m][1] = (b[0] + b[1]) + (b[2] + b[3]); }
}

struct Epi1 {
    static constexpr bool PERM = true, AFTER_DRAIN = false; static constexpr int NST = 16;
    unsigned char* ws; float* out; const float *gq, *gk; PG8_LAS float* P; int probe;
    __device__ __forceinline__ void operator()(const f32x4 (&acc)[2][2][4][2], const Unit& u, int wr, int wc, int fr, int fq) const {
        if (probe & 16) return;
        const int pn = u.pn; const bool sample = u.pm >= 256;
        asm volatile("" : "+v"(fr), "+v"(fq));
        const int colw = wc * 32 + fq * 8;
        const int row0 = u.pm * BM + wr * 64 + fr;
        if (pn < 12) {
            const bool isq = pn < 6; const int hbase = 2 * (isq ? pn : pn - 6);
            float ss[2][4][2];
#pragma unroll
            for (int ai = 0; ai < 2; ++ai)
#pragma unroll
                for (int m = 0; m < 4; ++m)
#pragma unroll
                    for (int bj = 0; bj < 2; ++bj) ss[ai][m][bj] = sq8(acc[ai][bj][m][0], acc[ai][bj][m][1]);
            rowss_exchange(ss, P, wr, wc, fr, fq);
            const f32x4 gq0 = *(const f32x4*)(gq + colw), gq1 = *(const f32x4*)(gq + colw + 4), gk0 = *(const f32x4*)(gk + colw), gk1 = *(const f32x4*)(gk + colw + 4);
            f32x4 g0, g1;
#pragma unroll
            for (int e = 0; e < 4; ++e) { g0[e] = isq ? gq0[e] * QSCALE : gk0[e]; g1[e] = isq ? gq1[e] * QSCALE : gk1[e]; }
            bf16_t* const QK = (bf16_t*)(ws + (isq ? WS_Q : WS_K)); float* const QS = (float*)(ws + WS_QS);
#pragma unroll
            for (int ai = 0; ai < 2; ++ai)
#pragma unroll
                for (int m = 0; m < 4; ++m) { const int R = row0 + ai * HALF + m * 16;
#pragma unroll
                    for (int bj = 0; bj < 2; ++bj) { const int hh = hbase + bj, grp = hh >> 2, gsh = 2 * grp;
                        const float rs = __builtin_amdgcn_rsqf(ss[ai][m][bj] * (1.0f / 128.0f) + RMS_EPS);
                        const f32x4 v0 = acc[ai][bj][m][0] * rs * g0, v1 = acc[ai][bj][m][1] * rs * g1;
                        if (!sample) { const int b = R >> 13, t = R & 8191; const int rr = t & ((1 << gsh) - 1), mm = t >> gsh;
                            const size_t rowp = ((size_t)(b * 12 + hh) << 13) + (size_t)(rr << (13 - gsh)) + mm;
                            { const u32x4 w_ = pack8(v0, v1); if (!(probe & 8) || w_.x == 0x7fc17fc1u) *(u32x4*)(QK + rowp * 128 + colw) = w_; }
                            if (!isq) { const int W = 128 << gsh, trel = t - (8192 - W);
                                if (trel >= 0) { float* o = out + kvp_off(grp) + ((((size_t)b * W + trel) * 2 + 0) * 4 + (hh & 3)) * 128 + colw; *(f32x4*)o = v0; *(f32x4*)(o + 4) = v1; } }
                        } else { const int s = R - MP;
                            float* o = isq ? QS + (size_t)s * 1536 + hh * 128 + colw : out + kvs_off(grp) + (((size_t)s * 2 + 0) * 4 + (hh & 3)) * 128 + colw;
                            *(f32x4*)o = v0; *(f32x4*)(o + 4) = v1; } } }
        } else if (pn < 18) {
            const int hbase = 2 * (pn - 12); bf16_t* const V = (bf16_t*)(ws + WS_V);
#pragma unroll
            for (int ai = 0; ai < 2; ++ai)
#pragma unroll
                for (int m = 0; m < 4; ++m) { const int R = row0 + ai * HALF + m * 16;
#pragma unroll
                    for (int bj = 0; bj < 2; ++bj) { const int hh = hbase + bj, grp = hh >> 2, gsh = 2 * grp;
                        const f32x4 v0 = acc[ai][bj][m][0], v1 = acc[ai][bj][m][1];
                        if (!sample) { const int b = R >> 13, t = R & 8191; const int rr = t & ((1 << gsh) - 1), mm = t >> gsh;
                            const size_t rowp = ((size_t)(b * 12 + hh) << 13) + (size_t)(rr << (13 - gsh)) + mm;
                            { const u32x4 w_ = pack8(v0, v1); if (!(probe & 8) || w_.x == 0x7fc17fc1u) *(u32x4*)(V + rowp * 128 + colw) = w_; }
                            const int W = 128 << gsh, trel = t - (8192 - W);
                            if (trel >= 0) { float* o = out + kvp_off(grp) + ((((size_t)b * W + trel) * 2 + 1) * 4 + (hh & 3)) * 128 + colw; *(f32x4*)o = v0; *(f32x4*)(o + 4) = v1; }
                        } else { const int s = R - MP;
                            float* o = out + kvs_off(grp) + (((size_t)s * 2 + 1) * 4 + (hh & 3)) * 128 + colw; *(f32x4*)o = v0; *(f32x4*)(o + 4) = v1; } } }
        } else if (pn < 22) {
            const int cb = (pn - 18) * BM + colw; bf16_t* const XB = (bf16_t*)(ws + WS_XB); float* const XBS = (float*)(ws + WS_XBS);
#pragma unroll
            for (int ai = 0; ai < 2; ++ai)
#pragma unroll
                for (int m = 0; m < 4; ++m) { const int R = row0 + ai * HALF + m * 16;
#pragma unroll
                    for (int bj = 0; bj < 2; ++bj) { const int col = cb + bj * HALF; const f32x4 v0 = acc[ai][bj][m][0], v1 = acc[ai][bj][m][1];
                        if (!sample) { const int b = R >> 13, t = R & 8191;
                            { const u32x4 w_ = pack8(v0, v1); if (!(probe & 8) || w_.x == 0x7fc17fc1u) *(u32x4*)(XB + (size_t)R * 1024 + col) = w_; }
                            if (t >= 8189) { float* o = out + O_CONVP + ((size_t)b * 3 + (t - 8189)) * 1024 + col; *(f32x4*)o = v0; *(f32x4*)(o + 4) = v1; }
                        } else { const int s = R - MP, b = s >> 2, t = s & 3;
                            float* o = XBS + (size_t)s * 1024 + col; *(f32x4*)o = v0; *(f32x4*)(o + 4) = v1;
                            if (t >= 1) { float* o2 = out + O_CONVS + ((size_t)b * 3 + (t - 1)) * 1024 + col; *(f32x4*)o2 = v0; *(f32x4*)(o2 + 4) = v1; } } } }
        } else {
            const int seg = (pn - 22) >> 2; const int cb = ((pn - 22) & 3) * BM + colw; bf16_t* const dst = (bf16_t*)(ws + (seg == 0 ? WS_GY : (seg == 1 ? WS_SGA : WS_SGB)));
#pragma unroll
            for (int ai = 0; ai < 2; ++ai)
#pragma unroll
                for (int m = 0; m < 4; ++m) { const int R = row0 + ai * HALF + m * 16;
#pragma unroll
                    for (int bj = 0; bj < 2; ++bj) { const int col = cb + bj * HALF; f32x4 v0 = acc[ai][bj][m][0], v1 = acc[ai][bj][m][1];
                        if (seg == 0) {
#pragma unroll
                            for (int e = 0; e < 4; ++e) { v0[e] = fgelu_tanh(v0[e]); v1[e] = fgelu_tanh(v1[e]); }
                        } else {
#pragma unroll
                            for (int e = 0; e < 4; ++e) { v0[e] = fsigmoid(v0[e]); v1[e] = fsigmoid(v1[e]); }
                        }
                        { const u32x4 w_ = pack8(v0, v1); if (!(probe & 8) || w_.x == 0x7fc17fc1u) *(u32x4*)(dst + (size_t)R * 1024 + col) = w_; } } }
        }
    }
};

enum { E_AMIX = 0, E_MIX = 1, E_X1 = 2, E_UP = 3, E_X2 = 4, E_PE = 5, E_Y = 6 };
template <int MODE> struct Epi2 {
    static constexpr bool PERM = true, AFTER_DRAIN = false; static constexpr int NST = (MODE == E_Y) ? 32 : 16;
    const bf16_t* g1; const bf16_t* g2; bf16_t* o1; float* of; const float* xp; const float* xs; float* ss_out; const float* ss_in; PG8_LAS float* P; int probe;
    static constexpr int NG = (MODE == E_MIX || MODE == E_X1 || MODE == E_Y) ? 2 : 1, GA = 2 / NG;
    __device__ __forceinline__ void operator()(const f32x4 (&acc)[2][2][4][2], const Unit& u, int wr, int wc, int fr, int fq) const {
        if (probe & 16) return;
        asm volatile("" : "+v"(fr), "+v"(fq));
        const int colw = u.pn * BM + wc * 32 + fq * 8; const int row0 = u.pm * BM + wr * 64 + fr;
        float ss[2][4][2];
#pragma unroll
        for (int gi = 0; gi < NG; ++gi) {
            u32x4 L1[GA][4][2], L2[GA][4][2]; f32x4 X0[GA][4][2], X1v[GA][4][2], SQ[GA][4];
#pragma unroll
            for (int a = 0; a < GA; ++a)
#pragma unroll
                for (int m = 0; m < 4; ++m) { const int ai = gi * GA + a; const int R = row0 + ai * HALF + m * 16;
                    if (MODE == E_UP || MODE == E_Y) SQ[a][m] = *(const f32x4*)(ss_in + (size_t)R * 4);
#pragma unroll
                    for (int bj = 0; bj < 2; ++bj) { const size_t idx = (size_t)R * 1024 + colw + bj * HALF;
                        if (MODE == E_AMIX || MODE == E_MIX || MODE == E_X2 || MODE == E_Y) L1[a][m][bj] = *(const u32x4*)(g1 + idx);
                        if (MODE == E_MIX || MODE == E_Y) L2[a][m][bj] = *(const u32x4*)(g2 + idx);
                        if (MODE == E_X1) { const float* xr = (R < MP) ? xp + idx : xs + (idx - (size_t)MP * 1024); X0[a][m][bj] = *(const f32x4*)xr; X1v[a][m][bj] = *(const f32x4*)(xr + 4); } } }
#pragma unroll
            for (int a = 0; a < GA; ++a)
#pragma unroll
                for (int m = 0; m < 4; ++m) { const int ai = gi * GA + a; const int R = row0 + ai * HALF + m * 16;
                    float rs = 1.0f;
                    if (MODE == E_UP || MODE == E_Y) { const f32x4 q = SQ[a][m]; rs = __builtin_amdgcn_rsqf(((q[0] + q[1]) + (q[2] + q[3])) * (1.0f / 1024.0f) + RMS_EPS); }
#pragma unroll
                    for (int bj = 0; bj < 2; ++bj) { const int col = colw + bj * HALF; const size_t idx = (size_t)R * 1024 + col;
                        const f32x4 a0 = acc[ai][bj][m][0], a1 = acc[ai][bj][m][1];
                        if (MODE == E_AMIX) { f32x4 s0, s1; unpack8(L1[a][m][bj], s0, s1); *(u32x4*)(o1 + idx) = pack8(s0 * a0, s1 * a1); }
                        else if (MODE == E_MIX) { f32x4 s0, s1, p0, p1; unpack8(L1[a][m][bj], s0, s1); unpack8(L2[a][m][bj], p0, p1); *(u32x4*)(o1 + idx) = pack8(p0 + s0 * a0, p1 + s1 * a1); }
                        else if (MODE == E_X1) { const f32x4 v0 = X0[a][m][bj] + a0, v1 = X1v[a][m][bj] + a1;
                            *(u32x4*)(o1 + idx) = pack8(v0, v1); ss[ai][m][bj] = sq8(v0, v1); }
                        else if (MODE == E_UP) { f32x4 v0 = a0 * rs, v1 = a1 * rs;
#pragma unroll
                            for (int e = 0; e < 4; ++e) { const float p = fmaxf(v0[e], 0.f), q = fmaxf(v1[e], 0.f); v0[e] = p * p; v1[e] = q * q; }
                            const u32x4 w_ = pack8(v0, v1); if (!(probe & 8) || w_.x == 0x7fc17fc1u) *(u32x4*)(o1 + (size_t)R * 4096 + col) = w_; }
                        else if (MODE == E_X2) { f32x4 p0, p1; unpack8(L1[a][m][bj], p0, p1); const f32x4 v0 = p0 + a0, v1 = p1 + a1;
                            *(u32x4*)(o1 + idx) = pack8(v0, v1); ss[ai][m][bj] = sq8(v0, v1); }
                        else if (MODE == E_PE) { *(u32x4*)(o1 + idx) = pack8(a0, a1); }
                        else { f32x4 p0, p1, v0, v1; unpack8(L1[a][m][bj], p0, p1); unpack8(L2[a][m][bj], v0, v1);
#pragma unroll
                            for (int e = 0; e < 4; ++e) { v0[e] += fsigmoid(a0[e] * rs) * p0[e]; v1[e] += fsigmoid(a1[e] * rs) * p1[e]; }
                            *(f32x4*)(of + idx) = v0; *(f32x4*)(of + idx + 4) = v1; } } }
            if (NG > 1) asm volatile("" ::: "memory");
        }
        if (MODE == E_X1 || MODE == E_X2) {
            rowss_exchange(ss, P, wr, wc, fr, fq);
            if (wc == 0 && fq == 0) {
#pragma unroll
                for (int ai = 0; ai < 2; ++ai)
#pragma unroll
                    for (int m = 0; m < 4; ++m) ss_out[(size_t)(row0 + ai * HALF + m * 16) * 4 + u.pn] = ss[ai][m][0] + ss[ai][m][1]; }
        }
    }
};
template <class Epi, class Sched, bool ALIGN_EPI = false, bool SP2 = false>
__device__ __forceinline__ void gemm_phase(PG8_LAS unsigned char* lds, const Gemm g, const Sched& S, const Epi& E, const int wave0, const unsigned stag_ticks = 0u) {
    int tid_; asm volatile("v_mbcnt_lo_u32_b32 %0, -1, 0\n\tv_mbcnt_hi_u32_b32 %0, -1, %0" : "=v"(tid_)); tid_ |= wave0 << 6;
    const int tid = tid_, wid = __builtin_amdgcn_readfirstlane(tid >> 6), lane = tid & 63, wr = wid >> 2, wc = wid & 3, fr = lane & 15, fq = lane >> 4;
    const int K = g.K, nt = K / BK;
    unsigned voffA[2], voffB[2];
#pragma unroll
    for (int i = 0; i < 2; ++i) { int R, C; stage_rc(tid * 16 + i * 8192, R, C); const int Rb = Epi::PERM ? ((R & ~31) + perm32(R & 31)) : R;
        voffA[i] = (unsigned)(R * K + C) * 2u; voffB[i] = (unsigned)(Rb * K + C) * 2u; }
    const size_t kstep = (size_t)(BK * 2);
    const size_t hstep = (size_t)HALF * K * 2;
    const size_t tstep = 2 * hstep;
    const unsigned ldsw = (unsigned)wid * 1024u;
    const int aoff = lds_byte(wr * 64 + fr, fq * 8), boff = lds_byte(wc * 32 + fr, fq * 8);
#define PG8_SA(b, h) (((b) * 2 + (h)) * HTB)
#define PG8_SB(b, h) ((4 + (b) * 2 + (h)) * HTB)
#define PG8_STAGE(bufoff, gbase, voff) do { _Pragma("unroll") for (int _i = 0; _i < 2; ++_i) \
        __builtin_amdgcn_global_load_lds((const unsigned*)((const char*)(gbase) + (voff)[_i]), (PG8_LAS unsigned*)(lds + (bufoff) + ldsw + _i * 8192), 16, 0, 0); } while (0)
#define PG8_LDA(dst, b, h) do { _Pragma("unroll") for (int m = 0; m < 4; ++m) _Pragma("unroll") for (int k = 0; k < 2; ++k) dst[m][k] = *(const PG8_LAS bf16x8*)(lds + PG8_SA(b, h) + aoff + m * 2048 + k * 1024); } while (0)
#define PG8_LDB(dst, b, h) do { _Pragma("unroll") for (int n = 0; n < 2; ++n) _Pragma("unroll") for (int k = 0; k < 2; ++k) dst[n][k] = *(const PG8_LAS bf16x8*)(lds + PG8_SB(b, h) + boff + n * 2048 + k * 1024); } while (0)
#define PG8_MMA(ai, bj, At, Bt) do { __builtin_amdgcn_s_setprio(1); _Pragma("unroll") for (int m = 0; m < 4; ++m) _Pragma("unroll") for (int n = 0; n < 2; ++n) _Pragma("unroll") for (int k = 0; k < 2; ++k) \
        acc[ai][bj][m][n] = __builtin_amdgcn_mfma_f32_16x16x32_bf16(Bt[n][k], At[m][k], acc[ai][bj][m][n], 0, 0, 0); __builtin_amdgcn_s_setprio(0); } while (0)
#define PG8_WAIT_V(n) asm volatile("s_waitcnt vmcnt(" #n ")" ::: "memory")
#define PG8_WAIT_L(n) asm volatile("s_waitcnt lgkmcnt(" #n ")" ::: "memory")
#define PG8_WAIT_V_EPI(flag, n) asm volatile("s_cmp_eq_u32 %0, 0\n\ts_cbranch_scc1 1f\n\ts_waitcnt vmcnt(" #n ")\n\ts_branch 2f\n1:\n\ts_waitcnt vmcnt(8)\n2:" :: "s"(flag) : "memory", "scc")
#define PG8_BAR __builtin_amdgcn_s_barrier()
#define PG8_SCHED __builtin_amdgcn_sched_barrier(0)
    Unit cur, nxt; int ui = 0;
    if (!S.next(0, cur)) return;
    if (stag_ticks) {
        const unsigned long long t0_ = __builtin_amdgcn_s_memrealtime();
        while (__builtin_amdgcn_s_memrealtime() - t0_ < (unsigned long long)stag_ticks) __builtin_amdgcn_s_sleep(16);
    }
    f32x4 acc[2][2][4][2];
#pragma unroll
    for (int a = 0; a < 2; ++a)
#pragma unroll
        for (int b = 0; b < 2; ++b)
#pragma unroll
            for (int m = 0; m < 4; ++m)
#pragma unroll
                for (int n = 0; n < 2; ++n) acc[a][b][m][n] = (f32x4){0.f, 0.f, 0.f, 0.f};
    bf16x8 At[4][2], B0[2][2], B1[2][2];
    const char* cA = (const char*)g.A + (size_t)cur.pm * tstep; const char* cB = (const char*)g.Bt + (size_t)cur.pn * tstep;
    S.a_ready(cur);
    if constexpr (SP2) {
        PG8_STAGE(PG8_SB(0, 0), cB, voffB); PG8_STAGE(PG8_SB(0, 1), cB + hstep, voffB); PG8_STAGE(PG8_SA(0, 0), cA, voffA); PG8_STAGE(PG8_SA(0, 1), cA + hstep, voffA);
        if (wr == 1) PG8_BAR;
        PG8_WAIT_V(2); PG8_BAR;
        PG8_STAGE(PG8_SB(1, 0), cB + kstep, voffB); PG8_STAGE(PG8_SA(1, 0), cA + kstep, voffA); PG8_STAGE(PG8_SB(1, 1), cB + hstep + kstep, voffB);
        PG8_WAIT_V(6); PG8_BAR;
    } else {
        PG8_STAGE(PG8_SB(0, 0), cB, voffB); PG8_STAGE(PG8_SA(0, 0), cA, voffA); PG8_STAGE(PG8_SB(0, 1), cB + hstep, voffB); PG8_STAGE(PG8_SA(0, 1), cA + hstep, voffA);
        if (wr == 1) PG8_BAR;
        PG8_WAIT_V(4); PG8_BAR;
        PG8_STAGE(PG8_SB(1, 0), cB + kstep, voffB); PG8_STAGE(PG8_SA(1, 0), cA + kstep, voffA); PG8_STAGE(PG8_SB(1, 1), cB + hstep + kstep, voffB);
        PG8_WAIT_V(6); PG8_BAR;
    }
    for (;;) {
        const bool has_next = S.next(ui + 1, nxt);
        const char* nA = has_next ? (const char*)g.A + (size_t)nxt.pm * tstep : cA; const char* nB = has_next ? (const char*)g.Bt + (size_t)nxt.pn * tstep : cB;
        for (int t = 0; t < nt; t += 2) {
            const bool last = (t == nt - 2);
            const char* a1 = cA + (size_t)(t + 1) * kstep;
            const char* a2 = last ? nA : cA + (size_t)(t + 2) * kstep; const char* b2 = last ? nB : cB + (size_t)(t + 2) * kstep;
            const char* a3 = a2 + kstep; const char* b3 = b2 + kstep;
            if (last && has_next) S.a_ready(nxt);
            if constexpr (SP2) {
            const int after_epi = __builtin_amdgcn_readfirstlane(((t == 0) && (ui > 0)) ? 1 : 0);
            PG8_LDB(B0, 0, 0); PG8_LDB(B1, 0, 1); PG8_SCHED; PG8_LDA(At, 0, 0); PG8_STAGE(PG8_SA(1, 1), a1 + hstep, voffA);
            if constexpr (Epi::NST >= 32) PG8_WAIT_V_EPI(after_epi, 40); else PG8_WAIT_V_EPI(after_epi, 24);
            PG8_WAIT_L(0); PG8_BAR; PG8_MMA(0, 0, At, B0); PG8_MMA(0, 1, At, B1); PG8_BAR; PG8_SCHED;
            PG8_LDA(At, 0, 1); PG8_STAGE(PG8_SB(0, 0), b2, voffB); PG8_STAGE(PG8_SB(0, 1), b2 + hstep, voffB); PG8_STAGE(PG8_SA(0, 0), a2, voffA);
            if constexpr (Epi::NST >= 32) PG8_WAIT_V_EPI(after_epi, 40); else PG8_WAIT_V_EPI(after_epi, 24);
            PG8_WAIT_L(0); PG8_BAR; PG8_MMA(1, 0, At, B0); PG8_MMA(1, 1, At, B1); PG8_BAR; PG8_SCHED;
            PG8_LDB(B0, 1, 0); PG8_LDB(B1, 1, 1); PG8_SCHED; PG8_LDA(At, 1, 0); PG8_STAGE(PG8_SA(0, 1), a2 + hstep, voffA);
            PG8_WAIT_V(8); PG8_WAIT_L(0); PG8_BAR; PG8_MMA(0, 0, At, B0); PG8_MMA(0, 1, At, B1); PG8_BAR; PG8_SCHED;
            PG8_LDA(At, 1, 1); PG8_STAGE(PG8_SB(1, 0), b3, voffB); PG8_STAGE(PG8_SB(1, 1), b3 + hstep, voffB); PG8_STAGE(PG8_SA(1, 0), a3, voffA);
            PG8_WAIT_V(8); PG8_WAIT_L(0); PG8_BAR; PG8_MMA(1, 0, At, B0); PG8_MMA(1, 1, At, B1); PG8_BAR; PG8_SCHED;
            } else {
            PG8_LDB(B0, 0, 0); PG8_SCHED; PG8_LDA(At, 0, 0); PG8_STAGE(PG8_SA(1, 1), a1 + hstep, voffA);
            PG8_WAIT_L(8); PG8_BAR; PG8_WAIT_L(0); PG8_MMA(0, 0, At, B0); PG8_BAR; PG8_SCHED;
            PG8_LDB(B1, 0, 1); PG8_STAGE(PG8_SB(0, 0), b2, voffB);
            PG8_BAR; PG8_WAIT_L(0); PG8_MMA(0, 1, At, B1); PG8_BAR;
            PG8_LDA(At, 0, 1); PG8_STAGE(PG8_SA(0, 0), a2, voffA);
            PG8_BAR; PG8_WAIT_L(0); PG8_MMA(1, 0, At, B0); PG8_BAR; PG8_SCHED;
            PG8_STAGE(PG8_SB(0, 1), b2 + hstep, voffB);
            PG8_WAIT_V(6); PG8_BAR; PG8_MMA(1, 1, At, B1); PG8_BAR;
            PG8_LDB(B0, 1, 0); PG8_SCHED; PG8_LDA(At, 1, 0); PG8_STAGE(PG8_SA(0, 1), a2 + hstep, voffA);
            PG8_WAIT_L(8); PG8_BAR; PG8_WAIT_L(0); PG8_MMA(0, 0, At, B0); PG8_BAR; PG8_SCHED;
            PG8_LDB(B1, 1, 1); PG8_STAGE(PG8_SB(1, 0), b3, voffB);
            PG8_BAR; PG8_WAIT_L(0); PG8_MMA(0, 1, At, B1); PG8_BAR;
            PG8_LDA(At, 1, 1); PG8_STAGE(PG8_SA(1, 0), a3, voffA);
            PG8_BAR; PG8_WAIT_L(0); PG8_MMA(1, 0, At, B0); PG8_BAR; PG8_SCHED;
            PG8_STAGE(PG8_SB(1, 1), b3 + hstep, voffB);
            PG8_WAIT_V(6); PG8_BAR; PG8_MMA(1, 1, At, B1); PG8_BAR;
            }
        }
        if constexpr (ALIGN_EPI) { if (wr == 0) PG8_BAR; }
        if constexpr (!Epi::AFTER_DRAIN) { E(acc, cur, wr, wc, fr, fq); S.done(cur); }
        if (!has_next) break;
#pragma unroll
        for (int a = 0; a < 2; ++a)
#pragma unroll
            for (int b = 0; b < 2; ++b)
#pragma unroll
                for (int m = 0; m < 4; ++m)
#pragma unroll
                    for (int n = 0; n < 2; ++n) acc[a][b][m][n] = (f32x4){0.f, 0.f, 0.f, 0.f};
        cur = nxt; cA = nA; cB = nB; ++ui;
        if constexpr (ALIGN_EPI) { if (wr == 1) PG8_BAR; }
    }
    PG8_WAIT_V(0);
    if constexpr (!ALIGN_EPI) { if (wr == 0) PG8_BAR; }
    PG8_BAR;
    if constexpr (Epi::AFTER_DRAIN) { E.fused(acc, cur, wr, wc, fr, fq, lds, wid, lane); S.done(cur); }
#undef PG8_SA
#undef PG8_SB
#undef PG8_STAGE
#undef PG8_LDA
#undef PG8_LDB
#undef PG8_MMA
#undef PG8_WAIT_V
#undef PG8_WAIT_L
#undef PG8_WAIT_V_EPI
#undef PG8_BAR
#undef PG8_SCHED
}
}
#define XB_TMO      128
#define XB_XCNT(j)  (256  + 64 * (j))
#define XB_XSUB(j)  (1280 + 64 * (j))
#define XB_XGEN(j)  (2304 + 64 * (j))
#define XB_TOP      3328
#define XB_TOPGEN   3392
#define XCD_BAR_WORDS 3456
#define XB_SPIN_CAP (1u << 18)

__device__ __forceinline__ unsigned xb_ld(unsigned* p)              { return __hip_atomic_load(p, __ATOMIC_RELAXED, __HIP_MEMORY_SCOPE_AGENT); }
__device__ __forceinline__ unsigned xb_add(unsigned* p, unsigned v) { return __hip_atomic_fetch_add(p, v, __ATOMIC_RELAXED, __HIP_MEMORY_SCOPE_AGENT); }
__device__ __forceinline__ unsigned xb_xcc_id() { return (unsigned)__builtin_amdgcn_s_getreg((3 << 11) | 20) & 0xFu; }
#define XB_SPIN(cond, bar) do { unsigned _sp = 0; while (cond) { __builtin_amdgcn_s_sleep(1); \
    if ((++_sp & 255u) == 0u) { if (xb_ld(&(bar)[XB_TMO])) break; if (_sp > XB_SPIN_CAP) { atomicAdd(&(bar)[XB_TMO], 1u); break; } } } } while (0)

struct XcdBarrier {
    unsigned* bar; unsigned x;
    volatile LAS unsigned* st;
};

__device__ __forceinline__ XcdBarrier xcd_barrier_post(unsigned* bar, volatile LAS unsigned* st) {
    XcdBarrier b; b.bar = bar; b.x = xb_xcc_id(); b.st = st;
    if (threadIdx.x == 0) (void)xb_add(&bar[XB_XCNT(b.x)], 1u);
    return b;
}
__device__ __forceinline__ void xcd_barrier_complete(unsigned* bar, unsigned x, unsigned& nloc, unsigned& nx) {
    const unsigned G = gridDim.x * gridDim.y * gridDim.z;
    unsigned sum, cnt, mine, sp = 0u;
    for (;;) {
        sum = 0u; cnt = 0u; mine = 0u;
#pragma unroll
        for (unsigned j = 0; j < 16; ++j) { const unsigned c = xb_ld(&bar[XB_XCNT(j)]); sum += c; cnt += (c > 0u) ? 1u : 0u; mine = (j == x) ? c : mine; }
        if (sum == G) break;
        __builtin_amdgcn_s_sleep(1);
        if ((++sp & 255u) == 0u) { if (xb_ld(&bar[XB_TMO])) break; if (sp > XB_SPIN_CAP) { atomicAdd(&bar[XB_TMO], 1u); break; } }
    }
    nloc = mine > 0u ? mine : 1u; nx = cnt > 0u ? cnt : 1u;
}

__device__ __forceinline__ void xcd_barrier(const XcdBarrier& b) {
    asm volatile("s_waitcnt vmcnt(0)" ::: "memory");
    __syncthreads();
    if (threadIdx.x == 0) {
        unsigned* bar = b.bar;
        __builtin_amdgcn_s_waitcnt(0);
        unsigned nloc = b.st[0], nx = b.st[1];
        if (nloc == 0u) { xcd_barrier_complete(bar, b.x, nloc, nx); b.st[0] = nloc; b.st[1] = nx; }
        const unsigned old = xb_add(&bar[XB_XSUB(b.x)], 1u);
        const unsigned gen = old / nloc;
        if (old + 1u == (gen + 1u) * nloc) {
            __builtin_amdgcn_fence(__ATOMIC_RELEASE, "agent");
            asm volatile("s_waitcnt vmcnt(0)" ::: "memory");
            const unsigned og = xb_add(&bar[XB_TOP], 1u);
            const unsigned tg = og / nx;
            if (og + 1u == (tg + 1u) * nx) xb_add(&bar[XB_TOPGEN], 1u);
            else XB_SPIN(xb_ld(&bar[XB_TOPGEN]) == tg, bar);
            __builtin_amdgcn_fence(__ATOMIC_ACQUIRE, "agent");
            xb_add(&bar[XB_XGEN(b.x)], 1u);
            asm volatile("s_waitcnt vmcnt(0)" ::: "memory");
        } else {
            XB_SPIN(xb_ld(&bar[XB_XGEN(b.x)]) == gen, bar);
            __builtin_amdgcn_fence(__ATOMIC_ACQUIRE, "agent");
            asm volatile("s_waitcnt vmcnt(0)" ::: "memory");
        }
    }
    __syncthreads();
}
__device__ __forceinline__ float wave_sum(float v) {
#pragma unroll
    for (int o = 1; o < 64; o <<= 1) v += __shfl_xor(v, o);
    return v;
}
__device__ __forceinline__ float wave_max(float v) {
#pragma unroll
    for (int o = 1; o < 64; o <<= 1) v = fmaxf(v, __shfl_xor(v, o));
    return v;
}
__device__ __forceinline__ void p0_transpose_item(const float* W, int K, int N, bf16* WT, const float* ks, LAS float* scr, int item, int lane) {
    const int nblk = N / 32, kb = item / nblk, nb = item % nblk, k0 = 64 * kb, n0 = 32 * nb;
#pragma unroll 8
    for (int i = 0; i < 32; ++i) { const int kk = 2 * i + (lane >> 5); float w = W[(size_t)(k0 + kk) * N + n0 + (lane & 31)]; if (ks) w *= ks[k0 + kk]; scr[kk * 33 + (lane & 31)] = w; }
    LDS_WAIT(); asm volatile("" ::: "memory");
    const int c = lane & 7;
#pragma unroll
    for (int j = 0; j < 4; ++j) { const int n = (lane >> 3) + 8 * j; const LAS float* s = scr + (8 * c) * 33 + n;
        v4u o; o.x = pk2(s[0 * 33], s[1 * 33]); o.y = pk2(s[2 * 33], s[3 * 33]); o.z = pk2(s[4 * 33], s[5 * 33]); o.w = pk2(s[6 * 33], s[7 * 33]);
        *(GAS v4u*)(WT + (size_t)(n0 + n) * K + k0 + 8 * c) = o; }
    LDS_WAIT(); asm volatile("" ::: "memory");
}

struct Ptrs {
    const float* in[30]; float* out; unsigned char* ws;
};
#define WSP(T, off) ((T*)(P.ws + (off)))

__device__ __forceinline__ void p0_prologue(const Ptrs& P, LAS unsigned char* lds, int tid, int lane, int wave, int vcu, int G) {
    LAS float* scr = (LAS float*)(lds + RING_OFF + wave * 16384);
    const int gw = vcu * NWAVES + wave, NGW = G * NWAVES;
    constexpr int I0 = (DM / 64) * (NIN / 32), I1 = (MW / 64) * (DM / 32), I2 = (DM / 64) * (DM / 32), I3 = I2, I4 = (DM / 64) * (FF / 32), I5 = (FF / 64) * (DM / 32), I6 = I2, I7 = (PLE / 64) * (DM / 32);
    constexpr int NITEMS = I0 + I1 + I2 + I3 + I4 + I5 + I6 + I7;
    for (int it = gw; it < NITEMS; it += NGW) {
        int r = it;
        if (r < I0) { p0_transpose_item(P.in[11], DM, NIN, WSP(bf16, WS_WIN), nullptr, scr, r, lane); continue; } r -= I0;
        if (r < I1) { p0_transpose_item(P.in[14], MW, DM, WSP(bf16, WS_WOA), nullptr, scr, r, lane); continue; } r -= I1;
        if (r < I2) { p0_transpose_item(P.in[22], DM, DM, WSP(bf16, WS_WOB), nullptr, scr, r, lane); continue; } r -= I2;
        if (r < I3) { p0_transpose_item(P.in[23], DM, DM, WSP(bf16, WS_WO), nullptr, scr, r, lane); continue; } r -= I3;
        if (r < I4) { p0_transpose_item(P.in[25], DM, FF, WSP(bf16, WS_WUP), P.in[24], scr, r, lane); continue; } r -= I4;
        if (r < I5) { p0_transpose_item(P.in[26], FF, DM, WSP(bf16, WS_WDN), nullptr, scr, r, lane); continue; } r -= I5;
        if (r < I6) { p0_transpose_item(P.in[28], DM, DM, WSP(bf16, WS_WPG), P.in[27], scr, r, lane); continue; } r -= I6;
        p0_transpose_item(P.in[29], PLE, DM, WSP(bf16, WS_WPE), nullptr, scr, r, lane);
    }
    { const GAS f32x4* gm = (const GAS f32x4*)P.in[10] + lane; f32x4 g[4];
#pragma unroll
      for (int j = 0; j < 4; ++j) g[j] = gm[64 * j];
      bf16* HB = WSP(bf16, WS_HB);
      for (int m0 = gw; m0 < M; m0 += 4 * NGW) {
        f32x4 v[4][4]; float s[4];
#pragma unroll
        for (int r = 0; r < 4; ++r) { const int m = (m0 + r * NGW < M) ? m0 + r * NGW : m0; const float* xrow = (m < MP) ? P.in[0] + (size_t)m * DM : P.in[1] + (size_t)(m - MP) * DM;
            const GAS f32x4* xr = (const GAS f32x4*)xrow + lane;
#pragma unroll
            for (int j = 0; j < 4; ++j) v[r][j] = xr[64 * j]; }
#pragma unroll
        for (int r = 0; r < 4; ++r) { float t = 0.f;
#pragma unroll
            for (int j = 0; j < 4; ++j) t += (v[r][j].x * v[r][j].x + v[r][j].y * v[r][j].y) + (v[r][j].z * v[r][j].z + v[r][j].w * v[r][j].w);
            s[r] = t; }
#pragma unroll
        for (int o = 1; o < 64; o <<= 1) {
#pragma unroll
            for (int r = 0; r < 4; ++r) s[r] += __shfl_xor(s[r], o); }
#pragma unroll
        for (int r = 0; r < 4; ++r) { const int m = m0 + r * NGW; if (m < M) { const float rs = 1.0f / sqrtf(s[r] * (1.f / DM) + 1e-6f);
            GAS v2u* o8 = (GAS v2u*)(HB + (size_t)m * DM) + lane;
#pragma unroll
            for (int j = 0; j < 4; ++j) { v2u w; w.x = pk2(v[r][j].x * rs * g[j].x, v[r][j].y * rs * g[j].y); w.y = pk2(v[r][j].z * rs * g[j].z, v[r][j].w * rs * g[j].w); o8[64 * j] = w; } } }
      }
      bf16* PB = WSP(bf16, WS_PB);
      for (int m0 = gw; m0 < M; m0 += 8 * NGW) {
        f32x4 pv[8];
#pragma unroll
        for (int r = 0; r < 8; ++r) { const int m = (m0 + r * NGW < M) ? m0 + r * NGW : m0; const float* prow = (m < MP) ? P.in[2] + (size_t)m * PLE : P.in[3] + (size_t)(m - MP) * PLE; pv[r] = ((const GAS f32x4*)prow)[lane]; }
#pragma unroll
        for (int r = 0; r < 8; ++r) { const int m = m0 + r * NGW; if (m < M) { v2u w; w.x = pk2(pv[r].x, pv[r].y); w.y = pk2(pv[r].z, pv[r].w); ((GAS v2u*)(PB + (size_t)m * PLE))[lane] = w; } }
      }
    }
    const int gt = vcu * (NWAVES * 64) + tid, NT = G * NWAVES * 64;
    { bf16* WRG = WSP(bf16, WS_WRG);
      for (int e = gt; e < 2 * 65536; e += NT) { const int mat = e >> 16, n = (e >> 12) & 15, o = (e >> 6) & 63, i = e & 63;
          WRG[e] = (bf16)f2bf(P.in[mat ? 19 : 17][(n * 64 + i) * 64 + o] * -1.4426950408889634f); }
      float* TAB = WSP(float, WS_TAB);
      for (int e = gt; e < 12 * 132; e += NT) { const int hh = e / 132, j = e % 132; float v = 0.f;
          if (j <= 128) { const int g = hh >> 2, dist = j << (2 * g); int bk;
              if (dist < 16) bk = dist; else { const double lg = log((double)dist / 16.0) / log(128.0) * 16.0; bk = 16 + (int)lg; if (bk > 31) bk = 31; }
              v = P.in[9][bk * 12 + hh] * 1.4426950408889634f; }
          TAB[e] = v; }
      for (int e = gt; e < 1024; e += NT) { const double x = (double)P.in[21][e]; const double ls = (x >= 0.0) ? -log1p(exp(-x)) : x - log1p(exp(x)); TAB[2048 + e] = (float)(8.0 * ls); }
    }
}

__device__ __forceinline__ unsigned offb(unsigned row, unsigned ch) { return 256u * row + 16u * (ch ^ (((row & 3u) << 2) | ((row >> 2) & 3u))); }
__device__ __forceinline__ s16x4 vtr(LAS const unsigned char* p) { typedef short v4i16_t __attribute__((ext_vector_type(4))); return __builtin_bit_cast(s16x4, __builtin_amdgcn_ds_read_tr16_b64_v4i16((LAS v4i16_t*)p)); }

__device__ __forceinline__ void attn_unit(const Ptrs& P, LAS unsigned char* lds, int uid, bool have_prev, int tid, int lane, int w, int probe) {
    const int blk = uid & 63, h4 = (uid >> 6) & 3, b = (uid >> 8) & 7, g = uid >> 11;
    const int gsh = 2 * g, hh = 4 * g + h4;
    const int nb = blk & ((64 >> gsh) - 1); const bool first = nb == 0;
    const int par = nb & 1; const unsigned xr = par ? 0u : 32768u;
    const size_t qrow0 = ((size_t)(b * 12 + hh) << 13) + (size_t)blk * 128;
    const bf16* Qb = WSP(bf16, WS_Q); const bf16* Kb = WSP(bf16, WS_K); const bf16* Vb = WSP(bf16, WS_V);
    LAS unsigned char* Kimg = lds; LAS unsigned char* Vimg = lds + 65536;
    const LAS float* bias = (const LAS float*)(lds + XCH_OFF) + hh * 132;
    const int qi = lane & 15, g4 = lane >> 4;
    {
        const int lr = lane >> 4, sl = lane & 15;
#pragma unroll
        for (int i = 0; i < 4; ++i) { const int pl = w * 4 + i, p = 32 * par + pl; const int ch = sl ^ ((lr << 2) | (p & 3));
            const size_t srow = qrow0 + 4 * pl + lr;
            __builtin_amdgcn_global_load_lds((const unsigned*)((const char*)Kb + srow * 256 + ch * 16), (LAS unsigned*)(Kimg + p * 1024), 16, 0, 0);
            __builtin_amdgcn_global_load_lds((const unsigned*)((const char*)Vb + srow * 256 + ch * 16), (LAS unsigned*)(Vimg + p * 1024), 16, 0, 0); }
        if (!first && !have_prev) {
#pragma unroll
            for (int i = 0; i < 4; ++i) { const int pl = w * 4 + i, p = 32 * (par ^ 1) + pl; const int ch = sl ^ ((lr << 2) | (p & 3));
                const size_t srow = qrow0 - 128 + 4 * pl + lr;
                __builtin_amdgcn_global_load_lds((const unsigned*)((const char*)Kb + srow * 256 + ch * 16), (LAS unsigned*)(Kimg + p * 1024), 16, 0, 0);
                __builtin_amdgcn_global_load_lds((const unsigned*)((const char*)Vb + srow * 256 + ch * 16), (LAS unsigned*)(Vimg + p * 1024), 16, 0, 0); } }
        if (first) {
#pragma unroll
            for (int i = 0; i < 4; ++i) *(LAS v4u*)(Vimg + 32768 * (par ^ 1) + (i * 512 + tid) * 16) = (v4u){0u, 0u, 0u, 0u}; }
    }
    bf16x8 Qf[4];
    { const bf16* qp = Qb + (qrow0 + 16 * w + qi) * 128 + 8 * g4;
#pragma unroll
      for (int s = 0; s < 4; ++s) Qf[s] = *(const bf16x8*)(qp + 32 * s); }
    VM_WAIT(); LDS_WAIT(); __syncthreads();
    f32x4 S[9];
    { const unsigned fl = ((lane & 3) << 2) | ((lane >> 2) & 3);
      const unsigned kb = 256u * (unsigned)(16 * w + qi);
#pragma unroll
      for (int jb = 0; jb < 9; ++jb) { S[jb] = (f32x4){0.f, 0.f, 0.f, 0.f};
#pragma unroll
          for (int s = 0; s < 4; ++s) { const bf16x8 a = *(const LAS bf16x8*)(Kimg + (((kb + jb * 4096u) ^ xr) + 16u * ((unsigned)(4 * s + g4) ^ fl)));
              S[jb] = __builtin_amdgcn_mfma_f32_16x16x32_bf16(a, Qf[s], S[jb], 0, 0, 0); } } }
    if (probe & 16) { float t_ = 0.f;
#pragma unroll
        for (int jb = 0; jb < 9; ++jb) t_ += S[jb][0] + S[jb][1] + S[jb][2] + S[jb][3];
        if (t_ == 1.2345e-30f) WSP(float, WS_LSE)[tid] = t_; __syncthreads(); return; }
    float mx = -1e30f;
#pragma unroll
    for (int jb = 0; jb < 9; ++jb)
#pragma unroll
        for (int i = 0; i < 4; ++i) { const int ki = 4 * g4 + i, rel = 16 * jb + ki - qi;
            int slot = 128 - rel; slot = slot < 0 ? 0 : (slot > 128 ? 128 : slot);
            bool ok = true; if (jb == 0) ok = rel >= 0; if (jb == 8) ok = rel <= 128;
            if (first) ok = ok && (16 * w + 16 * jb + ki >= 128);
            const float v = ok ? S[jb][i] + bias[slot] : -1e30f; S[jb][i] = v; mx = fmaxf(mx, v); }
    mx = fmaxf(mx, __shfl_xor(mx, 16)); mx = fmaxf(mx, __shfl_xor(mx, 32));
    float tot = 0.f;
#pragma unroll
    for (int jb = 0; jb < 9; ++jb)
#pragma unroll
        for (int i = 0; i < 4; ++i) { const float p = fexp2(S[jb][i] - mx); S[jb][i] = p; tot += p; }
    tot += __shfl_xor(tot, 16); tot += __shfl_xor(tot, 32);
    bf16x8 Pf[5];
#pragma unroll
    for (int ks = 0; ks < 5; ++ks) { v4u pk; pk.x = pk2(S[2 * ks][0], S[2 * ks][1]); pk.y = pk2(S[2 * ks][2], S[2 * ks][3]);
        if (ks < 4) { pk.z = pk2(S[2 * ks + 1][0], S[2 * ks + 1][1]); pk.w = pk2(S[2 * ks + 1][2], S[2 * ks + 1][3]); } else { pk.z = 0u; pk.w = 0u; }
        Pf[ks] = __builtin_bit_cast(bf16x8, pk); }
    f32x4 O[8];
#pragma unroll
    for (int c = 0; c < 8; ++c) O[c] = (f32x4){0.f, 0.f, 0.f, 0.f};
    { const int q = (lane & 15) >> 2, p = lane & 3; const unsigned fl = ((unsigned)q << 2) | (unsigned)g4;
      const unsigned vb = 256u * (unsigned)(16 * w + 4 * g4 + q);
#pragma unroll
      for (int ks = 0; ks < 5; ++ks)
#pragma unroll
          for (int c = 0; c < 8; ++c) { const unsigned co = 16u * (((unsigned)(2 * c + (p >> 1))) ^ fl) + 8u * (unsigned)(p & 1);
              const s16x4 lo = vtr(Vimg + (((vb + 256u * (32 * ks)) ^ xr) + co));
              const s16x4 hi = vtr(Vimg + (((vb + 256u * (32 * ks + (ks < 4 ? 16 : 0))) ^ xr) + co));
              const bf16x8 a = (bf16x8){lo[0], lo[1], lo[2], lo[3], hi[0], hi[1], hi[2], hi[3]};
              O[c] = __builtin_amdgcn_mfma_f32_16x16x32_bf16(a, Pf[ks], O[c], 0, 0, 0); } }
    const float inv = frcp(tot);
    const int mq = nb * 128 + 16 * w + qi, rr = blk >> (6 - gsh);
    const size_t R = (size_t)b * SEQ + ((size_t)mq << gsh) + rr;
    bf16* og = WSP(bf16, WS_OG) + ((size_t)g * MP + R) * MW + h4 * 128 + 4 * g4;
#pragma unroll
    for (int c = 0; c < 8; ++c) { v2u o; o.x = pk2(O[c][0] * inv, O[c][1] * inv); o.y = pk2(O[c][2] * inv, O[c][3] * inv); if (!(probe & 8) || o.x == 0x7fc17fc1u) *(GAS v2u*)(og + 16 * c) = o; }
    if (g4 == 0) WSP(float, WS_LSE)[((size_t)g * MP + R) * 4 + h4] = mx + __log2f(tot);
    __syncthreads();
}

__device__ __forceinline__ void glds16(const void* gsrc, unsigned lds_dst) { unsigned keep;
    asm volatile("s_mov_b32 %0, m0\n\ts_mov_b32 m0, %2\n\ts_nop 0\n\tglobal_load_lds_dwordx4 %1, off\n\ts_mov_b32 m0, %0" : "=&s"(keep) : "v"(gsrc), "s"(lds_dst) : "memory"); }
__device__ __forceinline__ void attn_dma_half(const bf16* src, LAS unsigned char* img, size_t row0, int half, int lane, int w) {
    const int lr = lane >> 4, sl = lane & 15; const unsigned img0 = (unsigned)(uintptr_t)img;
#pragma unroll
    for (int i = 0; i < 4; ++i) { const int pl = w * 4 + i, p = 32 * half + pl; const int ch = sl ^ ((lr << 2) | (p & 3));
        glds16((const char*)src + (row0 + 4 * pl + lr) * 256 + ch * 16, (unsigned)__builtin_amdgcn_readfirstlane((int)(img0 + p * 1024))); }
}
__device__ __forceinline__ void attn_qload(bf16x8 (&Qf)[4], const bf16* qp) {
    asm volatile("global_load_dwordx4 %0, %4, off\n\tglobal_load_dwordx4 %1, %4, off offset:64\n\tglobal_load_dwordx4 %2, %4, off offset:128\n\tglobal_load_dwordx4 %3, %4, off offset:192"
                 : "=&v"(Qf[0]), "=&v"(Qf[1]), "=&v"(Qf[2]), "=&v"(Qf[3]) : "v"(qp) : "memory"); }
#define ATT_WAIT(n) asm volatile("s_waitcnt vmcnt(" #n ")" ::: "memory")
#define ATT_WAITQ(n) asm volatile("s_waitcnt vmcnt(" #n ")" : "+v"(Qf[0]), "+v"(Qf[1]), "+v"(Qf[2]), "+v"(Qf[3]) :: "memory")
#define ATT_BAR() do { asm volatile("s_waitcnt lgkmcnt(0)" ::: "memory"); __builtin_amdgcn_s_barrier(); asm volatile("" ::: "memory"); } while (0)
__device__ __forceinline__ void attn_run(const Ptrs& P, LAS unsigned char* lds, int u0, int n, int tid, int lane, int w) {
    const bf16* Qb = WSP(bf16, WS_Q); const bf16* Kb = WSP(bf16, WS_K); const bf16* Vb = WSP(bf16, WS_V);
    LAS unsigned char* Kimg = lds; LAS unsigned char* Vimg = lds + 65536;
    const int qi = lane & 15, g4 = lane >> 4;
    const int blk0 = u0 & 63, h4 = (u0 >> 6) & 3, b = (u0 >> 8) & 7, g = u0 >> 11; const int gsh = 2 * g, hh = 4 * g + h4;
    const int nb0 = blk0 & ((64 >> gsh) - 1); const bool first0 = nb0 == 0;
    const size_t q00 = ((size_t)(b * 12 + hh) << 13) + (size_t)blk0 * 128;
    float bm[9][4];
    { const LAS float* bias = (const LAS float*)(lds + XCH_OFF) + hh * 132;
#pragma unroll
      for (int jb = 0; jb < 9; ++jb)
#pragma unroll
          for (int i = 0; i < 4; ++i) { const int ki = 4 * g4 + i, rel = 16 * jb + ki - qi; int slot = 128 - rel; slot = slot < 0 ? 0 : (slot > 128 ? 128 : slot);
              bool ok = true; if (jb == 0) ok = rel >= 0; if (jb == 8) ok = rel <= 128;
              bm[jb][i] = ok ? bias[slot] : -1e30f; } }
    bf16x8 Qf[4];
    { const int par = nb0 & 1;
      attn_dma_half(Kb, Kimg, q00, par, lane, w); attn_dma_half(Vb, Vimg, q00, par, lane, w);
      if (!first0) { attn_dma_half(Kb, Kimg, q00 - 128, par ^ 1, lane, w); attn_dma_half(Vb, Vimg, q00 - 128, par ^ 1, lane, w); }
      else {
#pragma unroll
          for (int i = 0; i < 4; ++i) *(LAS v4u*)(Vimg + 32768 * (par ^ 1) + (i * 512 + tid) * 16) = (v4u){0u, 0u, 0u, 0u}; }
      attn_qload(Qf, Qb + (q00 + 16 * w + qi) * 128 + 8 * g4);
      ATT_WAIT(0); }
#pragma unroll 1
    for (int it = 0; it < n; ++it) {
        const bool has_next = it + 1 < n; const bool first = first0 && it == 0;
        const int nb = nb0 + it, par = nb & 1; const unsigned xr = par ? 0u : 32768u; const size_t qrow0 = q00 + (size_t)it * 128;
        ATT_WAITQ(9);
        ATT_BAR();
        if (it > 0) attn_dma_half(Vb, Vimg, qrow0, par, lane, w);
        f32x4 S[9];
        { const unsigned fl = ((lane & 3) << 2) | ((lane >> 2) & 3);
          const unsigned kb = 256u * (unsigned)(16 * w + qi);
          unsigned ko[4];
#pragma unroll
          for (int s = 0; s < 4; ++s) ko[s] = 16u * ((unsigned)(4 * s + g4) ^ fl);
          bf16x8 kf[2][4];
#pragma unroll
          for (int s = 0; s < 4; ++s) kf[0][s] = *(const LAS bf16x8*)(Kimg + ((kb ^ xr) + ko[s]));
#pragma unroll
          for (int jb = 0; jb < 9; ++jb) {
              if (jb < 8) {
#pragma unroll
                  for (int s = 0; s < 4; ++s) kf[(jb + 1) & 1][s] = *(const LAS bf16x8*)(Kimg + (((kb + (jb + 1) * 4096u) ^ xr) + ko[s])); }
              S[jb] = (f32x4){0.f, 0.f, 0.f, 0.f};
#pragma unroll
              for (int s = 0; s < 4; ++s) S[jb] = __builtin_amdgcn_mfma_f32_16x16x32_bf16(kf[jb & 1][s], Qf[s], S[jb], 0, 0, 0); } }
        if (first) {
#pragma unroll
            for (int jb = 0; jb < 8; ++jb) if (w + jb < 8) S[jb] = (f32x4){-1e30f, -1e30f, -1e30f, -1e30f}; }
        float mx = -1e30f;
#pragma unroll
        for (int jb = 0; jb < 9; ++jb)
#pragma unroll
            for (int i = 0; i < 4; ++i) { const float v = S[jb][i] + bm[jb][i]; S[jb][i] = v; mx = fmaxf(mx, v); }
        mx = fmaxf(mx, __shfl_xor(mx, 16)); mx = fmaxf(mx, __shfl_xor(mx, 32));
        float tot = 0.f;
#pragma unroll
        for (int jb = 0; jb < 9; ++jb)
#pragma unroll
            for (int i = 0; i < 4; ++i) { const float p = fexp2(S[jb][i] - mx); S[jb][i] = p; tot += p; }
        tot += __shfl_xor(tot, 16); tot += __shfl_xor(tot, 32);
        bf16x8 Pf[5];
#pragma unroll
        for (int ks = 0; ks < 5; ++ks) { v4u pk; pk.x = pk2(S[2 * ks][0], S[2 * ks][1]); pk.y = pk2(S[2 * ks][2], S[2 * ks][3]);
            if (ks < 4) { pk.z = pk2(S[2 * ks + 1][0], S[2 * ks + 1][1]); pk.w = pk2(S[2 * ks + 1][2], S[2 * ks + 1][3]); } else { pk.z = 0u; pk.w = 0u; }
            Pf[ks] = __builtin_bit_cast(bf16x8, pk); }
        ATT_WAIT(0);
        ATT_BAR();
        if (has_next) attn_dma_half(Kb, Kimg, qrow0 + 128, par ^ 1, lane, w);
        attn_qload(Qf, Qb + (qrow0 + (has_next ? 128 : 0) + 16 * w + qi) * 128 + 8 * g4);
        f32x4 O[8];
#pragma unroll
        for (int c = 0; c < 8; ++c) O[c] = (f32x4){0.f, 0.f, 0.f, 0.f};
        { const int q = (lane & 15) >> 2, p = lane & 3; const unsigned fl = ((unsigned)q << 2) | (unsigned)g4;
          const unsigned vb = 256u * (unsigned)(16 * w + 4 * g4 + q);
          unsigned co[8];
#pragma unroll
          for (int c = 0; c < 8; ++c) co[c] = 16u * (((unsigned)(2 * c + (p >> 1))) ^ fl) + 8u * (unsigned)(p & 1);
          s16x4 lo[2][8], hi[2][8];
          { const unsigned r0 = vb ^ xr, r1 = (vb + 256u * 16u) ^ xr;
#pragma unroll
            for (int c = 0; c < 8; ++c) { lo[0][c] = vtr(Vimg + (r0 + co[c])); hi[0][c] = vtr(Vimg + (r1 + co[c])); } }
#pragma unroll
          for (int ks = 0; ks < 5; ++ks) {
              if (ks < 4) { const unsigned r0 = (vb + 256u * (32 * (ks + 1))) ^ xr, r1 = (vb + 256u * (32 * (ks + 1) + (ks + 1 < 4 ? 16 : 0))) ^ xr;
#pragma unroll
                  for (int c = 0; c < 8; ++c) { lo[(ks + 1) & 1][c] = vtr(Vimg + (r0 + co[c])); hi[(ks + 1) & 1][c] = vtr(Vimg + (r1 + co[c])); } }
#pragma unroll
              for (int c = 0; c < 8; ++c) { const s16x4 l_ = lo[ks & 1][c], h_ = hi[ks & 1][c];
                  const bf16x8 va = (bf16x8){l_[0], l_[1], l_[2], l_[3], h_[0], h_[1], h_[2], h_[3]};
                  O[c] = __builtin_amdgcn_mfma_f32_16x16x32_bf16(va, Pf[ks], O[c], 0, 0, 0); } } }
        const float inv = frcp(tot);
        const int mq = nb * 128 + 16 * w + qi, rr = blk0 >> (6 - gsh);
        const size_t R = (size_t)b * SEQ + ((size_t)mq << gsh) + rr;
        bf16* og = WSP(bf16, WS_OG) + ((size_t)g * MP + R) * MW + h4 * 128 + 4 * g4;
#pragma unroll
        for (int c = 0; c < 8; ++c) { v2u o; o.x = pk2(O[c][0] * inv, O[c][1] * inv); o.y = pk2(O[c][2] * inv, O[c][3] * inv); *(GAS v2u*)(og + 16 * c) = o; }
        WSP(float, WS_LSE)[((size_t)g * MP + R) * 4 + h4] = mx + __log2f(tot);
    }
    ATT_WAIT(0); ATT_BAR();
}

__device__ __forceinline__ const float* sattn_row(const float* cache, const float* knew, int b, int t, int gsh, int j) {
    const int nbuf = 128 << gsh, jj = j < 129 ? j : 128, ridx = nbuf + t - (jj << gsh);
    return (ridx >= nbuf) ? knew + (size_t)(b * 4 + (ridx - nbuf)) * 1024 : cache + ((size_t)b * nbuf + ridx) * 1024;
}
__device__ __forceinline__ void sattn_unit(const Ptrs& P, LAS unsigned char* lds, int su, int tid, int lane, int w) {
    constexpr int NSB = 8;
    const int b = su >> 2, t = su & 3; const int h = lane >> 4, sub = lane & 15;
    LAS float* LG = (LAS float*)lds;
    LAS float* PART = (LAS float*)(lds + 8192);
    const LAS float* bias = (const LAS float*)(lds + XCH_OFF);
    const float* QS = WSP(float, WS_QS) + (size_t)su * AW;
    const int lo = h * 128 + 8 * sub;
#pragma unroll
    for (int g = 0; g < 3; ++g) {
        const int gsh = 2 * g; const float* cache = g == 0 ? P.in[4] : (g == 1 ? P.in[5] : P.in[6]); const float* knew = P.out + pg8::kvs_off(g);
        const f32x4 q0 = *(const f32x4*)(QS + (4 * g + h) * 128 + 8 * sub), q1 = *(const f32x4*)(QS + (4 * g + h) * 128 + 8 * sub + 4);
        f32x4 n0[NSB], n1[NSB];
#pragma unroll
        for (int u = 0; u < NSB; ++u) { const float* rp = sattn_row(cache, knew, b, t, gsh, w + 8 * u) + lo; n0[u] = *(const f32x4*)rp; n1[u] = *(const f32x4*)(rp + 4); }
#pragma unroll 1
        for (int j0 = w; j0 < 129; j0 += 8 * NSB) {
            f32x4 k0[NSB], k1[NSB];
#pragma unroll
            for (int u = 0; u < NSB; ++u) { k0[u] = n0[u]; k1[u] = n1[u]; }
            if (j0 + 8 * NSB < 129) {
#pragma unroll
                for (int u = 0; u < NSB; ++u) { const float* rp = sattn_row(cache, knew, b, t, gsh, j0 + 8 * NSB + 8 * u) + lo; n0[u] = *(const f32x4*)rp; n1[u] = *(const f32x4*)(rp + 4); } }
#pragma unroll
            for (int u = 0; u < NSB; ++u) { const int j = j0 + 8 * u;
                float d = (q0[0] * k0[u][0] + q0[1] * k0[u][1]) + (q0[2] * k0[u][2] + q0[3] * k0[u][3]) + (q1[0] * k1[u][0] + q1[1] * k1[u][1]) + (q1[2] * k1[u][2] + q1[3] * k1[u][3]);
                d += __shfl_xor(d, 1); d += __shfl_xor(d, 2); d += __shfl_xor(d, 4); d += __shfl_xor(d, 8);
                if (sub == 0 && j < 129) LG[h * 392 + g * 129 + j] = d + bias[(4 * g + h) * 132 + j]; } }
    }
    LDS_WAIT(); __syncthreads();
    float mxh = 0.f, invh = 0.f;
#pragma unroll
    for (int hd = 0; hd < 4; ++hd) { float m = -1e30f;
        for (int i = lane; i < 387; i += 64) m = fmaxf(m, LG[hd * 392 + i]);
        m = wave_max(m); float s = 0.f;
        for (int i = lane; i < 387; i += 64) s += fexp2(LG[hd * 392 + i] - m);
        s = wave_sum(s); if (hd == h) { mxh = m; invh = 1.0f / s; } }
    float acc[8];
#pragma unroll
    for (int i = 0; i < 8; ++i) acc[i] = 0.f;
#pragma unroll
    for (int g = 0; g < 3; ++g) {
        const int gsh = 2 * g; const float* cache = g == 0 ? P.in[4] : (g == 1 ? P.in[5] : P.in[6]); const float* knew = P.out + pg8::kvs_off(g);
        f32x4 n0[NSB], n1[NSB];
#pragma unroll
        for (int u = 0; u < NSB; ++u) { const float* rp = sattn_row(cache, knew, b, t, gsh, w + 8 * u) + 512 + lo; n0[u] = *(const f32x4*)rp; n1[u] = *(const f32x4*)(rp + 4); }
#pragma unroll 1
        for (int j0 = w; j0 < 129; j0 += 8 * NSB) {
            f32x4 v0[NSB], v1[NSB];
#pragma unroll
            for (int u = 0; u < NSB; ++u) { v0[u] = n0[u]; v1[u] = n1[u]; }
            if (j0 + 8 * NSB < 129) {
#pragma unroll
                for (int u = 0; u < NSB; ++u) { const float* rp = sattn_row(cache, knew, b, t, gsh, j0 + 8 * NSB + 8 * u) + 512 + lo; n0[u] = *(const f32x4*)rp; n1[u] = *(const f32x4*)(rp + 4); } }
#pragma unroll
            for (int u = 0; u < NSB; ++u) { const int j = j0 + 8 * u;
                const float p = (j < 129) ? fexp2(LG[h * 392 + g * 129 + (j < 129 ? j : 128)] - mxh) * invh : 0.f;
#pragma unroll
                for (int i = 0; i < 4; ++i) { acc[i] += p * v0[u][i]; acc[4 + i] += p * v1[u][i]; } } }
    }
#pragma unroll
    for (int i = 0; i < 8; ++i) PART[w * 512 + lane * 8 + i] = acc[i];
    LDS_WAIT(); __syncthreads();
    { float s = 0.f;
#pragma unroll
      for (int k = 0; k < 8; ++k) s += PART[k * 512 + tid];
      WSP(bf16, WS_ATT)[(size_t)(MP + su) * MW + tid] = (bf16)f2bf(s); }
    __syncthreads();
}

struct CombItem { v4u a, b, c; float l0, l1, l2; };
__device__ __forceinline__ void comb_load(const Ptrs& P, int it, CombItem& x) {
    const bf16* OG = WSP(bf16, WS_OG); const float* LSE = WSP(float, WS_LSE); const int R = it >> 6, ck = it & 63, h4 = ck >> 4;
    x.l0 = LSE[((size_t)0 * MP + R) * 4 + h4]; x.l1 = LSE[((size_t)1 * MP + R) * 4 + h4]; x.l2 = LSE[((size_t)2 * MP + R) * 4 + h4];
    x.a = *(const v4u*)(OG + ((size_t)0 * MP + R) * MW + ck * 8); x.b = *(const v4u*)(OG + ((size_t)1 * MP + R) * MW + ck * 8); x.c = *(const v4u*)(OG + ((size_t)2 * MP + R) * MW + ck * 8);
}
__device__ __forceinline__ void comb_finish(const Ptrs& P, int it, const CombItem& x) {
    const float mx = fmaxf(x.l0, fmaxf(x.l1, x.l2)); float w0 = fexp2(x.l0 - mx), w1 = fexp2(x.l1 - mx), w2 = fexp2(x.l2 - mx); const float inv = frcp(w0 + w1 + w2); w0 *= inv; w1 *= inv; w2 *= inv;
    v4u o;
    o.x = pk2(w0 * bflo(x.a.x) + w1 * bflo(x.b.x) + w2 * bflo(x.c.x), w0 * bfhi(x.a.x) + w1 * bfhi(x.b.x) + w2 * bfhi(x.c.x));
    o.y = pk2(w0 * bflo(x.a.y) + w1 * bflo(x.b.y) + w2 * bflo(x.c.y), w0 * bfhi(x.a.y) + w1 * bfhi(x.b.y) + w2 * bfhi(x.c.y));
    o.z = pk2(w0 * bflo(x.a.z) + w1 * bflo(x.b.z) + w2 * bflo(x.c.z), w0 * bfhi(x.a.z) + w1 * bfhi(x.b.z) + w2 * bfhi(x.c.z));
    o.w = pk2(w0 * bflo(x.a.w) + w1 * bflo(x.b.w) + w2 * bflo(x.c.w), w0 * bfhi(x.a.w) + w1 * bfhi(x.b.w) + w2 * bfhi(x.c.w));
    *(v4u*)(WSP(bf16, WS_ATT) + (size_t)(it >> 6) * MW + (it & 63) * 8) = o;
}
__device__ __forceinline__ int crow(int r, int hi) { return (r & 3) + 8 * (r >> 2) + 4 * hi; }
constexpr int TAB_HC = 4096, TAB_SA = 12288, TAB_SB = 20480;
template <bool OUT> __device__ __forceinline__ void lru_unit(const Ptrs& P, LAS unsigned char* lds, int b, int n, int rg, int tid, int lane, int w, int comb_base = -1) {
    LAS unsigned char* AIMG = lds;
    LAS float* XC32 = (LAS float*)(lds + 16384);
    LAS float* HST = (LAS float*)(lds + 49152);
    LAS float* SUM = (LAS float*)(lds + 81920);
    LAS float* WC = (LAS float*)(lds + 84992);
    const int ch0 = 64 * n, tb = w >> 1, cb = w & 1, cl = lane & 31, hi = lane >> 5, mych = ch0 + 32 * cb + cl;
    if (tid < 320) { const int k = tid >> 6, i = tid & 63; WC[tid] = (k < 4) ? P.in[15][k * 1024 + ch0 + i] : P.in[16][ch0 + i]; }
    const bf16* WRG = WSP(bf16, WS_WRG);
    bf16x8 Bfa[4], Bfi[4];
#pragma unroll
    for (int s = 0; s < 4; ++s) { Bfa[s] = *(const bf16x8*)(WRG + ((size_t)(n * 64 + 32 * cb + cl) * 64 + 16 * s + 8 * hi));
                                  Bfi[s] = *(const bf16x8*)(WRG + 65536 + ((size_t)(n * 64 + 32 * cb + cl) * 64 + 16 * s + 8 * hi)); }
    const float ba = P.in[18][mych] * -1.4426950408889634f, bi = P.in[20][mych] * -1.4426950408889634f, c8l = WSP(float, WS_TAB)[2048 + mych] * 1.4426950408889634f;
    float hstate = 0.f, astate = 1.f;
    if (OUT && rg >= 1) { const float* T = WSP(float, WS_TAB) + b * 1024 + mych; hstate = T[TAB_HC]; if (rg == 2) hstate = T[TAB_SA] * hstate + T[TAB_SB]; }
    const int nch = (rg == 0) ? 32 : 16;
    const int tl = tid >> 2, cg = tid & 3;
    const bf16* XB = WSP(bf16, WS_XB); const bf16* GY = WSP(bf16, WS_GY); bf16* HRG = WSP(bf16, WS_HRG);
    v4u xv[4][2];
    const int tbase = (rg == 0) ? 0 : (rg == 1 ? 4096 : 6144);
    { const int t0 = tbase;
#pragma unroll
      for (int k = 0; k < 4; ++k) { const int t = t0 + tl - 3 + k;
          if (t >= 0) { const v4u* p = (const v4u*)(XB + ((size_t)b * SEQ + t) * DM + ch0 + 16 * cg); xv[k][0] = p[0]; xv[k][1] = p[1]; }
          else { xv[k][0] = (v4u){0u, 0u, 0u, 0u}; xv[k][1] = (v4u){0u, 0u, 0u, 0u}; } } }
    LDS_WAIT(); __syncthreads();
    for (int ci = 0; ci < nch; ++ci) {
        const int t0 = tbase + ci * 128; const size_t R0 = (size_t)b * SEQ + t0;
        {
            float xc[16];
#pragma unroll
            for (int q = 0; q < 4; ++q) { const f32x4 bc = *(const LAS f32x4*)(WC + 256 + 16 * cg + 4 * q); xc[4 * q] = bc[0]; xc[4 * q + 1] = bc[1]; xc[4 * q + 2] = bc[2]; xc[4 * q + 3] = bc[3]; }
#pragma unroll
            for (int k = 0; k < 4; ++k)
#pragma unroll
                for (int q = 0; q < 4; ++q) { const f32x4 wv = *(const LAS f32x4*)(WC + 64 * k + 16 * cg + 4 * q);
                    const unsigned u0 = xv[k][q >> 1][(q & 1) * 2], u1 = xv[k][q >> 1][(q & 1) * 2 + 1];
                    xc[4 * q] += wv[0] * bflo(u0); xc[4 * q + 1] += wv[1] * bfhi(u0); xc[4 * q + 2] += wv[2] * bflo(u1); xc[4 * q + 3] += wv[3] * bfhi(u1); }
#pragma unroll
            for (int q = 0; q < 4; ++q) *(LAS f32x4*)(XC32 + tl * 64 + 4 * ((4 * cg + q) ^ (tl & 15))) = (f32x4){xc[4 * q], xc[4 * q + 1], xc[4 * q + 2], xc[4 * q + 3]};
#pragma unroll
            for (int e = 0; e < 2; ++e) { v4u o; o.x = pk2(xc[8 * e], xc[8 * e + 1]); o.y = pk2(xc[8 * e + 2], xc[8 * e + 3]); o.z = pk2(xc[8 * e + 4], xc[8 * e + 5]); o.w = pk2(xc[8 * e + 6], xc[8 * e + 7]);
                *(LAS v4u*)(AIMG + tl * 128 + 16 * ((2 * cg + e) ^ ((tl >> 1) & 7))) = o; }
        }
        v4u gy0, gy1;
        if (OUT) { const v4u* p = (const v4u*)(GY + (R0 + tl) * DM + ch0 + 16 * cg); gy0 = p[0]; gy1 = p[1]; }
        CombItem cb0, cb1; const int cit = (comb_base + ci) * 1024 + tid;
        if (OUT && comb_base >= 0) { comb_load(P, cit, cb0); comb_load(P, cit + 512, cb1); }
        if (ci + 1 < nch) {
#pragma unroll
            for (int k = 0; k < 4; ++k) { const v4u* p = (const v4u*)(XB + (R0 + 128 + tl - 3 + k) * DM + ch0 + 16 * cg); xv[k][0] = p[0]; xv[k][1] = p[1]; } }
        LDS_WAIT(); __builtin_amdgcn_s_barrier(); asm volatile("" ::: "memory");
        f32x16 za, zi;
#pragma unroll
        for (int i = 0; i < 16; ++i) { za[i] = 0.f; zi[i] = 0.f; }
        { const int row = 32 * tb + cl;
#pragma unroll
          for (int s = 0; s < 4; ++s) { const bf16x8 a = *(const LAS bf16x8*)(AIMG + row * 128 + 16 * ((2 * s + hi) ^ ((row >> 1) & 7)));
              za = __builtin_amdgcn_mfma_f32_32x32x16_bf16(a, Bfa[s], za, 0, 0, 0); zi = __builtin_amdgcn_mfma_f32_32x32x16_bf16(a, Bfi[s], zi, 0, 0, 0); } }
        float av[16], bv[16];
#pragma unroll
        for (int i = 0; i < 16; ++i) { const int tk_ = 32 * tb + crow(i, hi); const float xcv = XC32[tk_ * 64 + 4 * (((32 * cb + cl) >> 2) ^ (tk_ & 15)) + (cl & 3)];
            const float r = frcp(1.0f + fexp2(za[i] + ba)), ig = frcp(1.0f + fexp2(zi[i] + bi)); const float a = fexp2(c8l * r); av[i] = a; bv[i] = __builtin_amdgcn_sqrtf(fmaf(-a, a, 1.0f)) * (ig * xcv); }
        float As[4], Bs[4], pAs[4], pBs[4], preA[4], preB[4];
#pragma unroll
        for (int sg = 0; sg < 4; ++sg) { float A = 1.f, B = 0.f;
#pragma unroll
            for (int e = 0; e < 4; ++e) { B = av[4 * sg + e] * B + bv[4 * sg + e]; A = av[4 * sg + e] * A; }
            As[sg] = A; Bs[sg] = B; pAs[sg] = __shfl_xor(A, 32); pBs[sg] = __shfl_xor(B, 32); }
        float PA = 1.f, PB = 0.f;
#pragma unroll
        for (int sg = 0; sg < 4; ++sg) {
            const float fA = hi ? pAs[sg] : As[sg], fB = hi ? pBs[sg] : Bs[sg], sA = hi ? As[sg] : pAs[sg], sB = hi ? Bs[sg] : pBs[sg];
            const float PB1 = fA * PB + fB, PA1 = fA * PA;
            preA[sg] = hi ? PA1 : PA; preB[sg] = hi ? PB1 : PB;
            PB = sA * PB1 + sB; PA = sA * PA1; }
        if (hi == 0) { SUM[(tb * 64 + 32 * cb + cl) * 2] = PA; SUM[(tb * 64 + 32 * cb + cl) * 2 + 1] = PB; }
        LDS_WAIT(); __builtin_amdgcn_s_barrier(); asm volatile("" ::: "memory");
        float hin = hstate, hnew = hstate;
#pragma unroll
        for (int t = 0; t < 4; ++t) { const float A = SUM[(t * 64 + 32 * cb + cl) * 2], B = SUM[(t * 64 + 32 * cb + cl) * 2 + 1];
            hnew = A * hnew + B; if (t < tb) hin = hnew; if (!OUT) astate *= A; }
        hstate = hnew;
        if (OUT) {
#pragma unroll
            for (int sg = 0; sg < 4; ++sg) { float hc = preA[sg] * hin + preB[sg];
#pragma unroll
                for (int e = 0; e < 4; ++e) { hc = av[4 * sg + e] * hc + bv[4 * sg + e]; const int tk_ = 32 * tb + 8 * sg + 4 * hi + e; HST[tk_ * 64 + 4 * (((32 * cb + cl) >> 2) ^ (tk_ & 15)) + (cl & 3)] = hc; } }
            LDS_WAIT(); __builtin_amdgcn_s_barrier(); asm volatile("" ::: "memory");
            f32x4 hv[4];
#pragma unroll
            for (int q = 0; q < 4; ++q) hv[q] = *(const LAS f32x4*)(HST + tl * 64 + 4 * ((4 * cg + q) ^ (tl & 15)));
            v4u o0, o1;
            o0.x = pk2(hv[0][0] * bflo(gy0.x), hv[0][1] * bfhi(gy0.x)); o0.y = pk2(hv[0][2] * bflo(gy0.y), hv[0][3] * bfhi(gy0.y));
            o0.z = pk2(hv[1][0] * bflo(gy0.z), hv[1][1] * bfhi(gy0.z)); o0.w = pk2(hv[1][2] * bflo(gy0.w), hv[1][3] * bfhi(gy0.w));
            o1.x = pk2(hv[2][0] * bflo(gy1.x), hv[2][1] * bfhi(gy1.x)); o1.y = pk2(hv[2][2] * bflo(gy1.y), hv[2][3] * bfhi(gy1.y));
            o1.z = pk2(hv[3][0] * bflo(gy1.z), hv[3][1] * bfhi(gy1.z)); o1.w = pk2(hv[3][2] * bflo(gy1.w), hv[3][3] * bfhi(gy1.w));
            v4u* op = (v4u*)(HRG + (R0 + tl) * DM + ch0 + 16 * cg); op[0] = o0; op[1] = o1;
            if (comb_base >= 0) { comb_finish(P, cit, cb0); comb_finish(P, cit + 512, cb1); }
        }
    }
    if (tb == 0 && hi == 0) {
        float* T = WSP(float, WS_TAB) + b * 1024 + mych;
        if (!OUT) { T[TAB_SA] = astate; T[TAB_SB] = hstate; }
        else if (rg == 0) T[TAB_HC] = hstate;
        else if (rg == 2) P.out[pg8::O_LRUP + (size_t)b * 1024 + mych] = hstate;
    }
    __syncthreads();
}

__device__ __forceinline__ void lru_sample(const Ptrs& P, int gt) {
    const int b = gt >> 10, ch = gt & 1023, n = ch >> 6, o = ch & 63;
    const float* XBS = WSP(float, WS_XBS); const float* sc = P.in[7] + (size_t)b * 3 * 1024; const float* wcv = P.in[15]; const float* bcv = P.in[16];
    float za[4] = {0.f, 0.f, 0.f, 0.f}, zi[4] = {0.f, 0.f, 0.f, 0.f}, xo[4] = {0.f, 0.f, 0.f, 0.f};
    for (int i = 0; i < 64; ++i) { const int c = 64 * n + i;
        float xcat[7];
#pragma unroll
        for (int k = 0; k < 3; ++k) xcat[k] = sc[k * 1024 + c];
#pragma unroll
        for (int k = 0; k < 4; ++k) xcat[3 + k] = XBS[(size_t)(4 * b + k) * 1024 + c];
        const float w0 = wcv[c], w1 = wcv[1024 + c], w2 = wcv[2048 + c], w3 = wcv[3072 + c], bc = bcv[c];
        const float wa = P.in[17][(n * 64 + i) * 64 + o], wi = P.in[19][(n * 64 + i) * 64 + o];
#pragma unroll
        for (int t = 0; t < 4; ++t) { const float xc = bc + w0 * xcat[t] + w1 * xcat[t + 1] + w2 * xcat[t + 2] + w3 * xcat[t + 3];
            za[t] += xc * wa; zi[t] += xc * wi; xo[t] = (i == o) ? xc : xo[t]; } }
    const float ba = P.in[18][ch], bi = P.in[20][ch], c8l = WSP(float, WS_TAB)[2048 + ch] * 1.4426950408889634f;
    float h = P.in[8][(size_t)b * 1024 + ch];
    const bf16* GY = WSP(bf16, WS_GY); bf16* HRG = WSP(bf16, WS_HRG);
#pragma unroll
    for (int t = 0; t < 4; ++t) { const float r = sigm(za[t] + ba), ig = sigm(zi[t] + bi), a = fexp2(c8l * r);
        h = a * h + sqrtf(fmaxf(1.0f - a * a, 0.f)) * (ig * xo[t]);
        const size_t idx = (size_t)(MP + 4 * b + t) * DM + ch;
        HRG[idx] = (bf16)f2bf(h * __uint_as_float((unsigned)GY[idx] << 16)); }
    P.out[pg8::O_LRUS + (size_t)b * 1024 + ch] = h;
}

enum { SG_AMIX = 0, SG_MIX = 1, SG_X1 = 2, SG_UP = 3, SG_X2 = 4, SG_PE = 5, SG_Y = 6 };
constexpr size_t TAB_SSS1 = 32768, TAB_SSS2 = 40960;
template <int MODE, int N, int K> __device__ __forceinline__ void sgemm_tile(const Ptrs& P, LAS unsigned char* lds, int tile, const bf16* A, const bf16* Bt, int tid, int lane, int w) {
    constexpr int NTC = N / 64, NKS = K / 128;
    const int tr = tile / NTC, tc = tile % NTC, s0 = 32 * tr, c0 = 64 * tc;
    const int r = lane & 31, h = lane >> 5;
    const bf16* ap = A + (size_t)(MP + s0 + r) * K + w * (K / 8) + 8 * h;
    const bf16* bp0 = Bt + (size_t)(c0 + r) * K + w * (K / 8) + 8 * h; const bf16* bp1 = bp0 + (size_t)32 * K;
    f32x16 acc0, acc1;
#pragma unroll
    for (int i = 0; i < 16; ++i) { acc0[i] = 0.f; acc1[i] = 0.f; }
#pragma unroll 4
    for (int ks = 0; ks < NKS; ++ks) { const bf16x8 a = *(const bf16x8*)(ap + 16 * ks), b0 = *(const bf16x8*)(bp0 + 16 * ks), b1 = *(const bf16x8*)(bp1 + 16 * ks);
        acc0 = __builtin_amdgcn_mfma_f32_32x32x16_bf16(a, b0, acc0, 0, 0, 0); acc1 = __builtin_amdgcn_mfma_f32_32x32x16_bf16(a, b1, acc1, 0, 0, 0); }
    LAS float* PART = (LAS float*)lds;
#pragma unroll
    for (int i = 0; i < 16; ++i) { const int row = crow(i, h); PART[(w * 32 + row) * 64 + r] = acc0[i]; PART[(w * 32 + row) * 64 + 32 + r] = acc1[i]; }
    LDS_WAIT(); __syncthreads();
    const int row = tid >> 4, c4 = (tid & 15) * 4;
    f32x4 v = (f32x4){0.f, 0.f, 0.f, 0.f};
#pragma unroll
    for (int k = 0; k < 8; ++k) v += *(const LAS f32x4*)(PART + (k * 32 + row) * 64 + c4);
    const int s = s0 + row, col = c0 + c4; const size_t R = (size_t)MP + s; const size_t idx = R * DM + col;
    float* TAB = WSP(float, WS_TAB);
    if (MODE == SG_AMIX) { const v2u g = *(const v2u*)(WSP(bf16, WS_SGA) + idx); v2u o; o.x = pk2(bflo(g.x) * v[0], bfhi(g.x) * v[1]); o.y = pk2(bflo(g.y) * v[2], bfhi(g.y) * v[3]); *(v2u*)(WSP(bf16, WS_AMIX) + idx) = o; }
    else if (MODE == SG_MIX) { const v2u g = *(const v2u*)(WSP(bf16, WS_SGB) + idx), m = *(const v2u*)(WSP(bf16, WS_AMIX) + idx); v2u o;
        o.x = pk2(bflo(m.x) + bflo(g.x) * v[0], bfhi(m.x) + bfhi(g.x) * v[1]); o.y = pk2(bflo(m.y) + bflo(g.y) * v[2], bfhi(m.y) + bfhi(g.y) * v[3]); *(v2u*)(WSP(bf16, WS_MIX) + idx) = o; }
    else if (MODE == SG_X1 || MODE == SG_X2) { f32x4 x;
        if (MODE == SG_X1) x = *(const f32x4*)(P.in[1] + (size_t)s * DM + col); else { const v2u m = *(const v2u*)(WSP(bf16, WS_X1B) + idx); x = (f32x4){bflo(m.x), bfhi(m.x), bflo(m.y), bfhi(m.y)}; }
        const f32x4 y = x + v; v2u o; o.x = pk2(y[0], y[1]); o.y = pk2(y[2], y[3]); *(v2u*)(WSP(bf16, MODE == SG_X1 ? WS_X1B : WS_X2B) + idx) = o;
        float ss = (y[0] * y[0] + y[1] * y[1]) + (y[2] * y[2] + y[3] * y[3]); ss += __shfl_xor(ss, 1); ss += __shfl_xor(ss, 2); ss += __shfl_xor(ss, 4); ss += __shfl_xor(ss, 8);
        if ((tid & 15) == 0) TAB[(MODE == SG_X1 ? TAB_SSS1 : TAB_SSS2) + s * 16 + tc] = ss; }
    else if (MODE == SG_PE) { v2u o; o.x = pk2(v[0], v[1]); o.y = pk2(v[2], v[3]); *(v2u*)(WSP(bf16, WS_PEP) + idx) = o; }
    else { const f32x4* q = (const f32x4*)(TAB + (MODE == SG_UP ? TAB_SSS1 : TAB_SSS2) + s * 16); const f32x4 q0 = q[0], q1 = q[1], q2 = q[2], q3 = q[3];
        const float tot = ((q0[0] + q0[1]) + (q0[2] + q0[3])) + ((q1[0] + q1[1]) + (q1[2] + q1[3])) + ((q2[0] + q2[1]) + (q2[2] + q2[3])) + ((q3[0] + q3[1]) + (q3[2] + q3[3]));
        const float rs = 1.0f / sqrtf(tot * (1.0f / 1024.0f) + 1e-6f);
        if (MODE == SG_UP) { v2u o; float u0 = fmaxf(v[0] * rs, 0.f), u1 = fmaxf(v[1] * rs, 0.f), u2 = fmaxf(v[2] * rs, 0.f), u3 = fmaxf(v[3] * rs, 0.f);
            o.x = pk2(u0 * u0, u1 * u1); o.y = pk2(u2 * u2, u3 * u3); *(v2u*)(WSP(bf16, WS_U) + R * FF + col) = o; }
        else { const v2u m = *(const v2u*)(WSP(bf16, WS_X2B) + idx), pe = *(const v2u*)(WSP(bf16, WS_PEP) + idx);
            f32x4 y; y[0] = bflo(m.x) + sigm(v[0] * rs) * bflo(pe.x); y[1] = bfhi(m.x) + sigm(v[1] * rs) * bfhi(pe.x); y[2] = bflo(m.y) + sigm(v[2] * rs) * bflo(pe.y); y[3] = bfhi(m.y) + sigm(v[3] * rs) * bfhi(pe.y);
            *(f32x4*)(P.out + idx) = y; } }
    __syncthreads();
}
#if defined(PROBE_DUP)
#define MK_PROBE_BITS(s) ((s) & 24)
#else
#define MK_PROBE_BITS(s) 0
#endif
__device__ __forceinline__ int opq_s(int v) { v = __builtin_amdgcn_readfirstlane(v); asm volatile("" : "+s"(v)); return v; }
struct Args { const float* in[30]; float* out; unsigned char* ws; int ph_lo, ph_hi, li, sub; };
__global__ void __launch_bounds__(NWAVES * 64, 2) fwd_kernel(Args args) {
    extern __shared__ __attribute__((aligned(16))) unsigned char lds_raw[];
    LAS unsigned char* lds = (LAS unsigned char*)lds_raw;
    volatile LAS unsigned* MISC = (volatile LAS unsigned*)(lds + MISC_OFF);
    const int tid0 = threadIdx.x; const int wave0 = __builtin_amdgcn_readfirstlane(tid0 >> 6);
    const int G = gridDim.x, bx = blockIdx.x; const int vcu = (G % 8 == 0) ? (bx % 8) * (G / 8) + bx / 8 : bx;
    typedef __attribute__((address_space(4))) const Args* KArgs;
    KArgs ap0 = (KArgs)__builtin_amdgcn_kernarg_segment_ptr();
    gu32* ctl = (gu32*)(args.ws + WS_CTL);
    for (int u = tid0; u < 32; u += NWAVES * 64) MISC[u] = 0u;
    __syncthreads();
    XcdBarrier bar; bar.bar = (unsigned*)(ctl + CW_BAR) + args.li * XCD_BAR_WORDS; bar.x = 0; bar.st = nullptr;
    if (N_LAUNCHES != PER_PHASE) bar = xcd_barrier_post((unsigned*)(ctl + CW_BAR) + args.li * XCD_BAR_WORDS, MISC + 8);
#define GRID_BAR() do { if (N_LAUNCHES != PER_PHASE) xcd_barrier(bar); } while (0)
    const int lo = args.ph_lo, hi = args.ph_hi, sub = args.sub;
#ifndef PH_MASK
#define PH_MASK 0x1ff
#endif
#define IN(k) (((PH_MASK >> (k)) & 1) && lo <= (k) && (k) < hi)
#define BOTH(k) (IN(k) && IN((k) + 1))
    LAS float* XCH = (LAS float*)(lds + XCH_OFF);
    const int NT = G * NWAVES * 64;

#define LOAD_P() KArgs ap = ap0; asm volatile("" : "+s"(ap)); Ptrs P; _Pragma("unroll") for (int i_ = 0; i_ < 30; ++i_) P.in[i_] = ap->in[i_]; P.out = ap->out; P.ws = ap->ws
#define OPAQUE_TID2() int tid; asm volatile("v_mbcnt_lo_u32_b32 %0, -1, 0\n\tv_mbcnt_hi_u32_b32 %0, -1, %0" : "=v"(tid)); tid |= wave0 << 6; const int lane = tid & 63, wave = wave0
#define OPAQUE_TID() LOAD_P(); int tid; asm volatile("v_mbcnt_lo_u32_b32 %0, -1, 0\n\tv_mbcnt_hi_u32_b32 %0, -1, %0" : "=v"(tid)); tid |= wave0 << 6; const int lane = tid & 63, wave = wave0; const int gt = vcu * (NWAVES * 64) + tid
    if (IN(0)) { OPAQUE_TID(); p0_prologue(P, lds, tid, lane, wave, vcu, G); if (BOTH(0)) GRID_BAR(); }

    if (IN(1)) {
        LOAD_P();
        pg8::Gemm g{WSP(pg8::bf16_t, WS_HB), WSP(pg8::bf16_t, WS_WIN), M, NIN, DM}; pg8::StaticOrder S; S.init(M, NIN, G, opq_s(blockIdx.x));
        pg8::Epi1 E{P.ws, P.out, P.in[12], P.in[13], XCH, MK_PROBE_BITS(sub)};
        pg8::gemm_phase<pg8::Epi1, pg8::StaticOrder, true, true>(lds + RING_OFF, g, S, E, wave0);
        if (BOTH(1)) GRID_BAR();
    }

    if (IN(2)) {
        OPAQUE_TID();
        { const float* TAB = WSP(float, WS_TAB); for (int e = tid; e < 12 * 132; e += NWAVES * 64) XCH[e] = TAB[e]; }
        LDS_WAIT(); __syncthreads();
#define TASK_LOOP(QI, NTASK, BODY) { gu32* qw = ctl + CW_Q + 64 * (4 * args.li + (QI)); volatile LAS unsigned* QT = MISC + 16; unsigned nxt = 0u; \
          if (tid == 0) nxt = __hip_atomic_fetch_add(qw, 1u, RLX_AGENT); \
          for (;;) { if (tid == 0) QT[0] = nxt; LDS_WAIT(); __syncthreads(); const int task = (int)__builtin_amdgcn_readfirstlane(QT[0]); __syncthreads(); if (task >= (NTASK)) break; \
              if (tid == 0) nxt = __hip_atomic_fetch_add(qw, 1u, RLX_AGENT); BODY } }
        if (sub & 1) TASK_LOOP(0, 128, lru_unit<true>(P, lds, task >> 4, task & 15, 0, tid, lane, wave);)
        if (sub & 1) TASK_LOOP(3, 128, lru_unit<false>(P, lds, task >> 4, task & 15, 1, tid, lane, wave);)
        if (sub & 2) TASK_LOOP(1, 512, sattn_unit(P, lds, task, tid, lane, wave);)
        if (sub & 4) TASK_LOOP(2, 1536, attn_run(P, lds, 4 * task, 4, tid, lane, wave);)
#undef TASK_LOOP
        if (BOTH(2)) GRID_BAR();
    }

    if (IN(3)) {
        OPAQUE_TID();
        if (sub & 1) for (int u = vcu; u < 256; u += G) lru_unit<true>(P, lds, u >> 5, (u >> 1) & 15, 1 + (u & 1), tid, lane, wave, 16 * u);
        if (sub & 2) for (int t = gt; t < DBATCH * 1024; t += NT) lru_sample(P, t);
        if (BOTH(3)) GRID_BAR();
    }

    if (IN(4)) {
        LOAD_P();
        { OPAQUE_TID2();
          for (int t = vcu; t < 256; t += G) sgemm_tile<SG_AMIX, DM, MW>(P, lds, t, WSP(bf16, WS_ATT), WSP(bf16, WS_WOA), tid, lane, wave);
          for (int t = vcu; t < 256; t += G) sgemm_tile<SG_MIX, DM, DM>(P, lds, t, WSP(bf16, WS_HRG), WSP(bf16, WS_WOB), tid, lane, wave); }
        { pg8::Gemm g{WSP(pg8::bf16_t, WS_ATT), WSP(pg8::bf16_t, WS_WOA), MP, DM, MW}; pg8::StaticOrder S; S.init(MP, DM, G, opq_s(blockIdx.x));
          pg8::Epi2<pg8::E_AMIX> E{WSP(pg8::bf16_t, WS_SGA), nullptr, WSP(pg8::bf16_t, WS_AMIX), nullptr, nullptr, nullptr, nullptr, nullptr, XCH, 0};
          pg8::gemm_phase<pg8::Epi2<pg8::E_AMIX>, pg8::StaticOrder, true, true>(lds + RING_OFF, g, S, E, wave0); }
        VM_WAIT(); __syncthreads();
        { pg8::Gemm g{WSP(pg8::bf16_t, WS_HRG), WSP(pg8::bf16_t, WS_WOB), MP, DM, DM}; pg8::StaticOrder S; S.init(MP, DM, G, opq_s(blockIdx.x));
          pg8::Epi2<pg8::E_MIX> E{WSP(pg8::bf16_t, WS_SGB), WSP(pg8::bf16_t, WS_AMIX), WSP(pg8::bf16_t, WS_MIX), nullptr, nullptr, nullptr, nullptr, nullptr, XCH, 0};
          pg8::gemm_phase<pg8::Epi2<pg8::E_MIX>, pg8::StaticOrder, true, true>(lds + RING_OFF, g, S, E, wave0); }
        if (BOTH(4)) GRID_BAR();
    }

    if (IN(5)) {
        LOAD_P();
        { OPAQUE_TID2(); for (int t = vcu; t < 256; t += G) sgemm_tile<SG_X1, DM, DM>(P, lds, t, WSP(bf16, WS_MIX), WSP(bf16, WS_WO), tid, lane, wave); }
        pg8::Gemm g{WSP(pg8::bf16_t, WS_MIX), WSP(pg8::bf16_t, WS_WO), MP, DM, DM}; pg8::StaticOrder S; S.init(MP, DM, G, opq_s(blockIdx.x));
        pg8::Epi2<pg8::E_X1> E{nullptr, nullptr, WSP(pg8::bf16_t, WS_X1B), nullptr, P.in[0], P.in[1], WSP(float, WS_SS1), nullptr, XCH, 0};
        pg8::gemm_phase<pg8::Epi2<pg8::E_X1>, pg8::StaticOrder, true, true>(lds + RING_OFF, g, S, E, wave0);
        if (BOTH(5)) GRID_BAR();
    }

    if (IN(6)) {
        LOAD_P();
        { OPAQUE_TID2(); for (int t = vcu; t < 1024; t += G) sgemm_tile<SG_UP, FF, DM>(P, lds, t, WSP(bf16, WS_X1B), WSP(bf16, WS_WUP), tid, lane, wave); }
        pg8::Gemm g{WSP(pg8::bf16_t, WS_X1B), WSP(pg8::bf16_t, WS_WUP), MP, FF, DM}; pg8::StaticOrder S; S.init(MP, FF, G, opq_s(blockIdx.x));
        pg8::Epi2<pg8::E_UP> E{nullptr, nullptr, WSP(pg8::bf16_t, WS_U), nullptr, nullptr, nullptr, nullptr, WSP(float, WS_SS1), XCH, MK_PROBE_BITS(sub)};
        pg8::gemm_phase<pg8::Epi2<pg8::E_UP>, pg8::StaticOrder, true, true>(lds + RING_OFF, g, S, E, wave0);
        if (BOTH(6)) GRID_BAR();
    }

    if (IN(7)) {
        LOAD_P();
        { OPAQUE_TID2(); for (int t = vcu; t < 256; t += G) sgemm_tile<SG_X2, DM, FF>(P, lds, t, WSP(bf16, WS_U), WSP(bf16, WS_WDN), tid, lane, wave); }
        pg8::Gemm g{WSP(pg8::bf16_t, WS_U), WSP(pg8::bf16_t, WS_WDN), MP, DM, FF}; pg8::StaticOrder S; S.init(MP, DM, G, opq_s(blockIdx.x));
        pg8::Epi2<pg8::E_X2> E{WSP(pg8::bf16_t, WS_X1B), nullptr, WSP(pg8::bf16_t, WS_X2B), nullptr, nullptr, nullptr, WSP(float, WS_SS2), nullptr, XCH, 0};
        pg8::gemm_phase<pg8::Epi2<pg8::E_X2>, pg8::StaticOrder, true, true>(lds + RING_OFF, g, S, E, wave0);
        if (BOTH(7)) GRID_BAR();
    }

    if (IN(8)) {
        LOAD_P();
        { OPAQUE_TID2();
          for (int t = vcu; t < 256; t += G) sgemm_tile<SG_PE, DM, PLE>(P, lds, t, WSP(bf16, WS_PB), WSP(bf16, WS_WPE), tid, lane, wave);
          for (int t = vcu; t < 256; t += G) sgemm_tile<SG_Y, DM, DM>(P, lds, t, WSP(bf16, WS_X2B), WSP(bf16, WS_WPG), tid, lane, wave); }
        { pg8::Gemm g{WSP(pg8::bf16_t, WS_PB), WSP(pg8::bf16_t, WS_WPE), MP, DM, PLE}; pg8::StaticOrder S; S.init(MP, DM, G, opq_s(blockIdx.x));
          pg8::Epi2<pg8::E_PE> E{nullptr, nullptr, WSP(pg8::bf16_t, WS_PEP), nullptr, nullptr, nullptr, nullptr, nullptr, XCH, 0};
          pg8::gemm_phase<pg8::Epi2<pg8::E_PE>, pg8::StaticOrder, true, true>(lds + RING_OFF, g, S, E, wave0); }
        VM_WAIT(); __syncthreads();
        { pg8::Gemm g{WSP(pg8::bf16_t, WS_X2B), WSP(pg8::bf16_t, WS_WPG), MP, DM, DM}; pg8::StaticOrder S; S.init(MP, DM, G, opq_s(blockIdx.x));
          pg8::Epi2<pg8::E_Y> E{WSP(pg8::bf16_t, WS_PEP), WSP(pg8::bf16_t, WS_X2B), nullptr, P.out, nullptr, nullptr, nullptr, WSP(float, WS_SS2), XCH, 0};
          pg8::gemm_phase<pg8::Epi2<pg8::E_Y>, pg8::StaticOrder, true, true>(lds + RING_OFF, g, S, E, wave0); }
    }
#undef IN
#undef BOTH
#undef GRID_BAR
}

extern "C" void kernel_launch(void* const* d_in, const int* in_sizes, int n_in, void* d_out, int out_size, void* d_ws, size_t ws_size, hipStream_t stream) {
    static int grid = 0;
    if (grid == 0) {
        if (n_in != 30 || in_sizes[0] != MP * DM || out_size != (int)pg8::O_END || ws_size < WS_END) {
            fprintf(stderr, "kernel_launch: unexpected shapes (n_in %d, in0 %d, out %d, ws %zu, need %zu); nothing launched\n", n_in, n_in > 0 ? in_sizes[0] : -1, out_size, ws_size, (size_t)WS_END); grid = -1; return; }
        int dev = 0, cus = 0, per_cu = 0;
        if (hipGetDevice(&dev) != hipSuccess || hipDeviceGetAttribute(&cus, hipDeviceAttributeMultiprocessorCount, dev) != hipSuccess) { grid = -1; return; }
        if (hipFuncSetAttribute((const void*)fwd_kernel, hipFuncAttributeMaxDynamicSharedMemorySize, LDS_BYTES) != hipSuccess) { fprintf(stderr, "kernel_launch: hipFuncSetAttribute failed\n"); grid = -1; return; }
        if (hipOccupancyMaxActiveBlocksPerMultiprocessor(&per_cu, (const void*)fwd_kernel, NWAVES * 64, LDS_BYTES) != hipSuccess || per_cu < 1)
            fprintf(stderr, "kernel_launch: note: occupancy query reports %d workgroups per CU\n", per_cu);
        (void)hipGetLastError();
        grid = cus;
    }
    if (grid < 0) return;
    if (hipMemsetAsync((char*)d_ws + WS_CTL, 0, CTL_ZERO_BYTES, stream) != hipSuccess) { fprintf(stderr, "kernel_launch: hipMemsetAsync failed\n"); return; }
    Args a{};
    for (int i = 0; i < 30; ++i) a.in[i] = (const float*)d_in[i];
    a.out = (float*)d_out; a.ws = (unsigned char*)d_ws;
#if defined(PROBE_DUP)
    const int cut[4] = {0, PROBE_DUP + 1, PROBE_DUP + 1, PER_PHASE};
    for (int li = 0; li < 3; ++li) {
        a.ph_lo = (li == 1) ? PROBE_DUP : cut[li]; a.ph_hi = (li == 1) ? PROBE_DUP + 1 : cut[li + 1]; a.li = li; a.sub = (li == 1) ? PROBE_SUB : 7;
        if (a.ph_lo >= a.ph_hi) continue;
        hipLaunchKernelGGL(fwd_kernel, dim3(grid), dim3(NWAVES * 64), LDS_BYTES, stream, a);
    }
#else
    for (int li = 0; li < N_LAUNCHES; ++li) {
        a.ph_lo = (N_LAUNCHES == PER_PHASE) ? li : 0; a.ph_hi = (N_LAUNCHES == PER_PHASE) ? li + 1 : PER_PHASE; a.li = (N_LAUNCHES == PER_PHASE) ? 0 : li; a.sub = 7;
        hipLaunchKernelGGL(fwd_kernel, dim3(grid), dim3(NWAVES * 64), LDS_BYTES, stream, a);
        const hipError_t le = hipPeekAtLastError();
        if (le != hipSuccess) { fprintf(stderr, "kernel_launch: launch %d failed: %s\n", li, hipGetErrorName(le)); break; }
    }
#endif
}
```

```cpp
#include <hip/hip_runtime.h>
#include <cstdio>
#include <cstdint>
#include <cmath>
#define MK_N_LAUNCHES 1

constexpr int NWAVES = 8;
#ifndef MK_N_LAUNCHES
#define MK_N_LAUNCHES 1
#endif
constexpr int N_LAUNCHES = MK_N_LAUNCHES;
constexpr int PER_PHASE = 9;

constexpr int DM = 1024, NBATCH = 8, SEQ = 8192, DBATCH = 128, DSEQ = 4;
constexpr int MP = NBATCH * SEQ, MS = DBATCH * DSEQ, M = MP + MS;
constexpr int NIN = 8704, FF = 4096, PLE = 256, AW = 1536, MW = 512;
static_assert(M % 256 == 0 && NIN % 256 == 0, "tile shapes");

constexpr size_t MiB = 1u << 20;
constexpr size_t al(size_t x) { return (x + MiB - 1) / MiB * MiB; }
constexpr size_t WS_CTL = 0, CTL_ZERO_BYTES = 1 * MiB;
constexpr size_t WS_WIN = 1 * MiB;
constexpr size_t WS_WOA = WS_WIN + al((size_t)NIN * DM * 2);
constexpr size_t WS_WOB = WS_WOA + al((size_t)DM * MW * 2);
constexpr size_t WS_WO = WS_WOB + al((size_t)DM * DM * 2);
constexpr size_t WS_WUP = WS_WO + al((size_t)DM * DM * 2);
constexpr size_t WS_WDN = WS_WUP + al((size_t)FF * DM * 2);
constexpr size_t WS_WPG = WS_WDN + al((size_t)FF * DM * 2);
constexpr size_t WS_WPE = WS_WPG + al((size_t)DM * DM * 2);
constexpr size_t WS_WRG = WS_WPE + al((size_t)DM * PLE * 2);
constexpr size_t WS_TAB = WS_WRG + MiB;
constexpr size_t WS_HB = WS_TAB + MiB;
constexpr size_t ACT = al((size_t)M * DM * 2);
constexpr size_t WS_Q = WS_HB + ACT;
constexpr size_t QKV = (size_t)MP * AW * 2;
constexpr size_t WS_K = WS_Q + QKV, WS_V = WS_K + QKV;
constexpr size_t WS_XB = WS_V + QKV, WS_GY = WS_XB + ACT, WS_SGA = WS_GY + ACT, WS_SGB = WS_SGA + ACT;
constexpr size_t WS_QS = WS_SGB + ACT;
constexpr size_t WS_XBS = WS_QS + al((size_t)MS * AW * 4);
constexpr size_t WS_OG = WS_XBS + al((size_t)MS * DM * 4);
constexpr size_t WS_LSE = WS_OG + al((size_t)3 * MP * MW * 2);
constexpr size_t WS_ATT = WS_LSE + al((size_t)3 * MP * 4 * 4);
constexpr size_t WS_HRG = WS_ATT + al((size_t)M * MW * 2);
constexpr size_t WS_AMIX = WS_HRG + ACT, WS_MIX = WS_AMIX + ACT, WS_X1B = WS_MIX + ACT, WS_X2B = WS_X1B + ACT;
constexpr size_t WS_U = WS_X2B + ACT;
constexpr size_t WS_PB = WS_U + al((size_t)M * FF * 2);
constexpr size_t WS_PEP = WS_PB + al((size_t)M * PLE * 2);
constexpr size_t WS_SS1 = WS_PEP + ACT;
constexpr size_t WS_SS2 = WS_SS1 + al((size_t)M * 4 * 4);
constexpr size_t WS_DUMP = WS_SS2 + al((size_t)M * 4 * 4);
constexpr size_t WS_END = WS_DUMP + 32 * MiB;
constexpr int CW_Q = 16384;
constexpr int CW_BAR = 4096;

constexpr int RING_OFF = 0, RING_BYTES = 131072;
constexpr int XCH_OFF = 131072;
constexpr int MISC_OFF = 139264;
constexpr int LDS_BYTES = 147456;

#define GAS __attribute__((address_space(1)))
#define LAS __attribute__((address_space(3)))
typedef unsigned short bf16;
typedef unsigned v4u __attribute__((ext_vector_type(4)));
typedef unsigned v2u __attribute__((ext_vector_type(2)));
typedef float f32x4 __attribute__((ext_vector_type(4)));
typedef float f32x16 __attribute__((ext_vector_type(16)));
typedef short bf16x8 __attribute__((ext_vector_type(8)));
typedef short s16x4 __attribute__((ext_vector_type(4)));
typedef GAS unsigned gu32;
#define RLX_AGENT __ATOMIC_RELAXED, __HIP_MEMORY_SCOPE_AGENT
#define LDS_WAIT() asm volatile("s_waitcnt lgkmcnt(0)" ::: "memory")
#define VM_WAIT() asm volatile("s_waitcnt vmcnt(0)" ::: "memory")
__device__ __forceinline__ unsigned f2bf(float f) { unsigned u = __builtin_bit_cast(unsigned, f); return (u + 0x7fffu + ((u >> 16) & 1u)) >> 16; }
typedef float f32x2_t __attribute__((ext_vector_type(2))); typedef __bf16 bf16x2_t __attribute__((ext_vector_type(2)));
__device__ __forceinline__ unsigned pk2(float lo, float hi) { f32x2_t v = {lo, hi}; bf16x2_t b = __builtin_convertvector(v, bf16x2_t); return __builtin_bit_cast(unsigned, b); }
__device__ __forceinline__ float bflo(unsigned w) { return __uint_as_float(w << 16); }
__device__ __forceinline__ float bfhi(unsigned w) { return __uint_as_float(w & 0xffff0000u); }
__device__ __forceinline__ float fexp2(float x) { return __builtin_amdgcn_exp2f(x); }
__device__ __forceinline__ float frcp(float x) { return __builtin_amdgcn_rcpf(x); }
__device__ __forceinline__ float sigm(float x) { return frcp(1.0f + fexp2(-1.4426950408889634f * x)); }
namespace pg8 {
#define PG8_LAS __attribute__((address_space(3)))
typedef unsigned short bf16_t;
typedef short bf16x8 __attribute__((ext_vector_type(8)));
typedef float f32x4 __attribute__((ext_vector_type(4)));
typedef unsigned u32x4 __attribute__((ext_vector_type(4)));
constexpr int BM = 256, BK = 64, HALF = 128, HTB = HALF * BK * 2  , STAGE_BYTES = 8 * HTB, NXCD = 8, WGM = 4;

__host__ __device__ __forceinline__ int lds_byte(int r, int c) { const int st = (r >> 4) * 2 + (c >> 5), rr = r & 15, cc = c & 31, ob = rr * 64 + cc * 2; return st * 1024 + (ob ^ (((ob >> 9) & 1) << 5)); }
__host__ __device__ __forceinline__ void stage_rc(int b, int& R, int& C) { const int st = b / 1024, sb = b % 1024, swz = sb ^ (((sb >> 9) & 1) << 5); R = (st >> 1) * 16 + swz / 64; C = (st & 1) * 32 + (swz % 64) / 2; }
__host__ __device__ __forceinline__ int perm32(int rho) { const int n = rho >> 4, i = rho & 15; return 8 * (i >> 2) + 4 * n + (i & 3); }

struct Unit { int pm, pn; };
struct Gemm { const bf16_t* A; const bf16_t* Bt; int M, N, K; };

struct StaticOrder {
    int nM, nN, nwg, G, c;
    __host__ __device__ void init(int M, int N, int G_, int c_) { nM = M / BM; nN = N / BM; nwg = nM * nN; G = G_; c = c_; }
    __host__ __device__ bool next(int i, Unit& u) const {
        const long L = (long)i * G + c; if (L >= nwg) return false;
        int wgid = (int)L; { const int q = nwg / NXCD, r = nwg % NXCD, xcd = wgid % NXCD, off = wgid / NXCD; wgid = (xcd < r ? xcd * (q + 1) : r * (q + 1) + (xcd - r) * q) + off; }
        const int nig = WGM * nN, gid = wgid / nig, fm = gid * WGM, gsz = (nM - fm) < WGM ? (nM - fm) : WGM;
        u.pm = fm + ((wgid % nig) % gsz); u.pn = (wgid % nig) / gsz; return true;
    }
    __device__ __forceinline__ void a_ready(const Unit&) const {}
    __device__ __forceinline__ void done(const Unit&) const {}
};
__device__ __forceinline__ unsigned cvt_pk_bf16(float lo, float hi) { unsigned r; asm volatile("v_cvt_pk_bf16_f32 %0, %1, %2" : "=v"(r) : "v"(lo), "v"(hi)); return r; }
typedef float f32x2 __attribute__((ext_vector_type(2)));
typedef unsigned u32x2 __attribute__((ext_vector_type(2)));
constexpr float RMS_EPS = 1e-6f;
constexpr float QSCALE = 0.08838834764831845f * 1.4426950408889634f;
constexpr size_t O_YP = 0, O_YS = 67108864, O_KV1P = 67633152, O_KV2P = 68681728, O_KV3P = 72876032, O_CONVP = 89653248, O_LRUP = 89677824,
                 O_KV1S = 89686016, O_KV2S = 90210304, O_KV3S = 90734592, O_CONVS = 91258880, O_LRUS = 91652096, O_END = 91783168;
__device__ __forceinline__ size_t kvp_off(int g) { return g == 0 ? O_KV1P : (g == 1 ? O_KV2P : O_KV3P); }
__device__ __forceinline__ size_t kvs_off(int g) { return g == 0 ? O_KV1S : (g == 1 ? O_KV2S : O_KV3S); }

__device__ __forceinline__ float fsigmoid(float x) { return __builtin_amdgcn_rcpf(1.0f + __builtin_amdgcn_exp2f(-1.4426950408889634f * x)); }
__device__ __forceinline__ float fgelu_tanh(float x) { const float u = x + 0.044715f * x * x * x; return x * __builtin_amdgcn_rcpf(1.0f + __builtin_amdgcn_exp2f(-2.3022082232f * u)); }
__device__ __forceinline__ float bf_lo(unsigned w) { return __uint_as_float(w << 16); }
__device__ __forceinline__ float bf_hi(unsigned w) { return __uint_as_float(w & 0xffff0000u); }
__device__ __forceinline__ u32x4 pack8(const f32x4& a, const f32x4& b) { u32x4 w; w.x = cvt_pk_bf16(a[0], a[1]); w.y = cvt_pk_bf16(a[2], a[3]); w.z = cvt_pk_bf16(b[0], b[1]); w.w = cvt_pk_bf16(b[2], b[3]); return w; }
__device__ __forceinline__ void unpack8(const u32x4& w, f32x4& a, f32x4& b) { a = (f32x4){bf_lo(w.x), bf_hi(w.x), bf_lo(w.y), bf_hi(w.y)}; b = (f32x4){bf_lo(w.z), bf_hi(w.z), bf_lo(w.w), bf_hi(w.w)}; }
__device__ __forceinline__ float sq8(const f32x4& a, const f32x4& b) { return (a[0] * a[0] + a[1] * a[1]) + (a[2] * a[2] + a[3] * a[3]) + (b[0] * b[0] + b[1] * b[1]) + (b[2] * b[2] + b[3] * b[3]); }

__device__ __forceinline__ void rowss_exchange(float (&ss)[2][4][2], PG8_LAS float* P, int wr, int wc, int fr, int fq) {
#pragma unroll
    for (int ai = 0; ai < 2; ++ai)
#pragma unroll
        for (int m = 0; m < 4; ++m)
#pragma unroll
            for (int bj = 0; bj < 2; ++bj) { float s = ss[ai][m][bj]; s += __shfl_xor(s, 16); s += __shfl_xor(s, 32);
                if (fq == 0) P[(ai * HALF + wr * 64 + m * 16 + fr) * 8 + bj * 4 + wc] = s; }
    asm volatile("s_waitcnt lgkmcnt(0)" ::: "memory"); __builtin_amdgcn_s_barrier(); asm volatile("" ::: "memory");
#pragma unroll
    for (int ai = 0; ai < 2; ++ai)
#pragma unroll
        for (int m = 0; m < 4; ++m) { const PG8_LAS f32x4* p = (const PG8_LAS f32x4*)(P + (ai * HALF + wr * 64 + m * 16 + fr) * 8);
            const f32x4 a = p[0], b = p[1]; ss[ai][m][0] = (a[0] + a[1]) + (a[2] + a[3]); ss[ai][m][1] = (b[0] + b[1]) + (b[2] + b[3]); }
}

struct Epi1 {
    static constexpr bool PERM = true, AFTER_DRAIN = false; static constexpr int NST = 16;
    unsigned char* ws; float* out; const float *gq, *gk; PG8_LAS float* P; int probe;
    __device__ __forceinline__ void operator()(const f32x4 (&acc)[2][2][4][2], const Unit& u, int wr, int wc, int fr, int fq) const {
        if (probe & 16) return;
        const int pn = u.pn; const bool sample = u.pm >= 256;
        asm volatile("" : "+v"(fr), "+v"(fq));
        const int colw = wc * 32 + fq * 8;
        const int row0 = u.pm * BM + wr * 64 + fr;
        if (pn < 12) {
            const bool isq = pn < 6; const int hbase = 2 * (isq ? pn : pn - 6);
            float ss[2][4][2];
#pragma unroll
            for (int ai = 0; ai < 2; ++ai)
#pragma unroll
                for (int m = 0; m < 4; ++m)
#pragma unroll
                    for (int bj = 0; bj < 2; ++bj) ss[ai][m][bj] = sq8(acc[ai][bj][m][0], acc[ai][bj][m][1]);
            rowss_exchange(ss, P, wr, wc, fr, fq);
            const f32x4 gq0 = *(const f32x4*)(gq + colw), gq1 = *(const f32x4*)(gq + colw + 4), gk0 = *(const f32x4*)(gk + colw), gk1 = *(const f32x4*)(gk + colw + 4);
            f32x4 g0, g1;
#pragma unroll
            for (int e = 0; e < 4; ++e) { g0[e] = isq ? gq0[e] * QSCALE : gk0[e]; g1[e] = isq ? gq1[e] * QSCALE : gk1[e]; }
            bf16_t* const QK = (bf16_t*)(ws + (isq ? WS_Q : WS_K)); float* const QS = (float*)(ws + WS_QS);
#pragma unroll
            for (int ai = 0; ai < 2; ++ai)
#pragma unroll
                for (int m = 0; m < 4; ++m) { const int R = row0 + ai * HALF + m * 16;
#pragma unroll
                    for (int bj = 0; bj < 2; ++bj) { const int hh = hbase + bj, grp = hh >> 2, gsh = 2 * grp;
                        const float rs = __builtin_amdgcn_rsqf(ss[ai][m][bj] * (1.0f / 128.0f) + RMS_EPS);
                        const f32x4 v0 = acc[ai][bj][m][0] * rs * g0, v1 = acc[ai][bj][m][1] * rs * g1;
                        if (!sample) { const int b = R >> 13, t = R & 8191; const int rr = t & ((1 << gsh) - 1), mm = t >> gsh;
                            const size_t rowp = ((size_t)(b * 12 + hh) << 13) + (size_t)(rr << (13 - gsh)) + mm;
                            { const u32x4 w_ = pack8(v0, v1); if (!(probe & 8) || w_.x == 0x7fc17fc1u) *(u32x4*)(QK + rowp * 128 + colw) = w_; }
                            if (!isq) { const int W = 128 << gsh, trel = t - (8192 - W);
                                if (trel >= 0) { float* o = out + kvp_off(grp) + ((((size_t)b * W + trel) * 2 + 0) * 4 + (hh & 3)) * 128 + colw; *(f32x4*)o = v0; *(f32x4*)(o + 4) = v1; } }
                        } else { const int s = R - MP;
                            float* o = isq ? QS + (size_t)s * 1536 + hh * 128 + colw : out + kvs_off(grp) + (((size_t)s * 2 + 0) * 4 + (hh & 3)) * 128 + colw;
                            *(f32x4*)o = v0; *(f32x4*)(o + 4) = v1; } } }
        } else if (pn < 18) {
            const int hbase = 2 * (pn - 12); bf16_t* const V = (bf16_t*)(ws + WS_V);
#pragma unroll
            for (int ai = 0; ai < 2; ++ai)
#pragma unroll
                for (int m = 0; m < 4; ++m) { const int R = row0 + ai * HALF + m * 16;
#pragma unroll
                    for (int bj = 0; bj < 2; ++bj) { const int hh = hbase + bj, grp = hh >> 2, gsh = 2 * grp;
                        const f32x4 v0 = acc[ai][bj][m][0], v1 = acc[ai][bj][m][1];
                        if (!sample) { const int b = R >> 13, t = R & 8191; const int rr = t & ((1 << gsh) - 1), mm = t >> gsh;
                            const size_t rowp = ((size_t)(b * 12 + hh) << 13) + (size_t)(rr << (13 - gsh)) + mm;
                            { const u32x4 w_ = pack8(v0, v1); if (!(probe & 8) || w_.x == 0x7fc17fc1u) *(u32x4*)(V + rowp * 128 + colw) = w_; }
                            const int W = 128 << gsh, trel = t - (8192 - W);
                            if (trel >= 0) { float* o = out + kvp_off(grp) + ((((size_t)b * W + trel) * 2 + 1) * 4 + (hh & 3)) * 128 + colw; *(f32x4*)o = v0; *(f32x4*)(o + 4) = v1; }
                        } else { const int s = R - MP;
                            float* o = out + kvs_off(grp) + (((size_t)s * 2 + 1) * 4 + (hh & 3)) * 128 + colw; *(f32x4*)o = v0; *(f32x4*)(o + 4) = v1; } } }
        } else if (pn < 22) {
            const int cb = (pn - 18) * BM + colw; bf16_t* const XB = (bf16_t*)(ws + WS_XB); float* const XBS = (float*)(ws + WS_XBS);
#pragma unroll
            for (int ai = 0; ai < 2; ++ai)
#pragma unroll
                for (int m = 0; m < 4; ++m) { const int R = row0 + ai * HALF + m * 16;
#pragma unroll
                    for (int bj = 0; bj < 2; ++bj) { const int col = cb + bj * HALF; const f32x4 v0 = acc[ai][bj][m][0], v1 = acc[ai][bj][m][1];
                        if (!sample) { const int b = R >> 13, t = R & 8191;
                            { const u32x4 w_ = pack8(v0, v1); if (!(probe & 8) || w_.x == 0x7fc17fc1u) *(u32x4*)(XB + (size_t)R * 1024 + col) = w_; }
                            if (t >= 8189) { float* o = out + O_CONVP + ((size_t)b * 3 + (t - 8189)) * 1024 + col; *(f32x4*)o = v0; *(f32x4*)(o + 4) = v1; }
                        } else { const int s = R - MP, b = s >> 2, t = s & 3;
                            float* o = XBS + (size_t)s * 1024 + col; *(f32x4*)o = v0; *(f32x4*)(o + 4) = v1;
                            if (t >= 1) { float* o2 = out + O_CONVS + ((size_t)b * 3 + (t - 1)) * 1024 + col; *(f32x4*)o2 = v0; *(f32x4*)(o2 + 4) = v1; } } } }
        } else {
            const int seg = (pn - 22) >> 2; const int cb = ((pn - 22) & 3) * BM + colw; bf16_t* const dst = (bf16_t*)(ws + (seg == 0 ? WS_GY : (seg == 1 ? WS_SGA : WS_SGB)));
#pragma unroll
            for (int ai = 0; ai < 2; ++ai)
#pragma unroll
                for (int m = 0; m < 4; ++m) { const int R = row0 + ai * HALF + m * 16;
#pragma unroll
                    for (int bj = 0; bj < 2; ++bj) { const int col = cb + bj * HALF; f32x4 v0 = acc[ai][bj][m][0], v1 = acc[ai][bj][m][1];
                        if (seg == 0) {
#pragma unroll
                            for (int e = 0; e < 4; ++e) { v0[e] = fgelu_tanh(v0[e]); v1[e] = fgelu_tanh(v1[e]); }
                        } else {
#pragma unroll
                            for (int e = 0; e < 4; ++e) { v0[e] = fsigmoid(v0[e]); v1[e] = fsigmoid(v1[e]); }
                        }
                        { const u32x4 w_ = pack8(v0, v1); if (!(probe & 8) || w_.x == 0x7fc17fc1u) *(u32x4*)(dst + (size_t)R * 1024 + col) = w_; } } }
        }
    }
};

enum { E_AMIX = 0, E_MIX = 1, E_X1 = 2, E_UP = 3, E_X2 = 4, E_PE = 5, E_Y = 6 };
template <int MODE> struct Epi2 {
    static constexpr bool PERM = true, AFTER_DRAIN = false; static constexpr int NST = (MODE == E_Y) ? 32 : 16;
    const bf16_t* g1; const bf16_t* g2; bf16_t* o1; float* of; const float* xp; const float* xs; float* ss_out; const float* ss_in; PG8_LAS float* P; int probe;
    static constexpr int NG = (MODE == E_MIX || MODE == E_X1 || MODE == E_Y) ? 2 : 1, GA = 2 / NG;
    __device__ __forceinline__ void operator()(const f32x4 (&acc)[2][2][4][2], const Unit& u, int wr, int wc, int fr, int fq) const {
        if (probe & 16) return;
        asm volatile("" : "+v"(fr), "+v"(fq));
        const int colw = u.pn * BM + wc * 32 + fq * 8; const int row0 = u.pm * BM + wr * 64 + fr;
        float ss[2][4][2];
#pragma unroll
        for (int gi = 0; gi < NG; ++gi) {
            u32x4 L1[GA][4][2], L2[GA][4][2]; f32x4 X0[GA][4][2], X1v[GA][4][2], SQ[GA][4];
#pragma unroll
            for (int a = 0; a < GA; ++a)
#pragma unroll
                for (int m = 0; m < 4; ++m) { const int ai = gi * GA + a; const int R = row0 + ai * HALF + m * 16;
                    if (MODE == E_UP || MODE == E_Y) SQ[a][m] = *(const f32x4*)(ss_in + (size_t)R * 4);
#pragma unroll
                    for (int bj = 0; bj < 2; ++bj) { const size_t idx = (size_t)R * 1024 + colw + bj * HALF;
                        if (MODE == E_AMIX || MODE == E_MIX || MODE == E_X2 || MODE == E_Y) L1[a][m][bj] = *(const u32x4*)(g1 + idx);
                        if (MODE == E_MIX || MODE == E_Y) L2[a][m][bj] = *(const u32x4*)(g2 + idx);
                        if (MODE == E_X1) { const float* xr = (R < MP) ? xp + idx : xs + (idx - (size_t)MP * 1024); X0[a][m][bj] = *(const f32x4*)xr; X1v[a][m][bj] = *(const f32x4*)(xr + 4); } } }
#pragma unroll
            for (int a = 0; a < GA; ++a)
#pragma unroll
                for (int m = 0; m < 4; ++m) { const int ai = gi * GA + a; const int R = row0 + ai * HALF + m * 16;
                    float rs = 1.0f;
                    if (MODE == E_UP || MODE == E_Y) { const f32x4 q = SQ[a][m]; rs = __builtin_amdgcn_rsqf(((q[0] + q[1]) + (q[2] + q[3])) * (1.0f / 1024.0f) + RMS_EPS); }
#pragma unroll
                    for (int bj = 0; bj < 2; ++bj) { const int col = colw + bj * HALF; const size_t idx = (size_t)R * 1024 + col;
                        const f32x4 a0 = acc[ai][bj][m][0], a1 = acc[ai][bj][m][1];
                        if (MODE == E_AMIX) { f32x4 s0, s1; unpack8(L1[a][m][bj], s0, s1); *(u32x4*)(o1 + idx) = pack8(s0 * a0, s1 * a1); }
                        else if (MODE == E_MIX) { f32x4 s0, s1, p0, p1; unpack8(L1[a][m][bj], s0, s1); unpack8(L2[a][m][bj], p0, p1); *(u32x4*)(o1 + idx) = pack8(p0 + s0 * a0, p1 + s1 * a1); }
                        else if (MODE == E_X1) { const f32x4 v0 = X0[a][m][bj] + a0, v1 = X1v[a][m][bj] + a1;
                            *(u32x4*)(o1 + idx) = pack8(v0, v1); ss[ai][m][bj] = sq8(v0, v1); }
                        else if (MODE == E_UP) { f32x4 v0 = a0 * rs, v1 = a1 * rs;
#pragma unroll
                            for (int e = 0; e < 4; ++e) { const float p = fmaxf(v0[e], 0.f), q = fmaxf(v1[e], 0.f); v0[e] = p * p; v1[e] = q * q; }
                            const u32x4 w_ = pack8(v0, v1); if (!(probe & 8) || w_.x == 0x7fc17fc1u) *(u32x4*)(o1 + (size_t)R * 4096 + col) = w_; }
                        else if (MODE == E_X2) { f32x4 p0, p1; unpack8(L1[a][m][bj], p0, p1); const f32x4 v0 = p0 + a0, v1 = p1 + a1;
                            *(u32x4*)(o1 + idx) = pack8(v0, v1); ss[ai][m][bj] = sq8(v0, v1); }
                        else if (MODE == E_PE) { *(u32x4*)(o1 + idx) = pack8(a0, a1); }
                        else { f32x4 p0, p1, v0, v1; unpack8(L1[a][m][bj], p0, p1); unpack8(L2[a][m][bj], v0, v1);
#pragma unroll
                            for (int e = 0; e < 4; ++e) { v0[e] += fsigmoid(a0[e] * rs) * p0[e]; v1[e] += fsigmoid(a1[e] * rs) * p1[e]; }
                            *(f32x4*)(of + idx) = v0; *(f32x4*)(of + idx + 4) = v1; } } }
            if (NG > 1) asm volatile("" ::: "memory");
        }
        if (MODE == E_X1 || MODE == E_X2) {
            rowss_exchange(ss, P, wr, wc, fr, fq);
            if (wc == 0 && fq == 0) {
#pragma unroll
                for (int ai = 0; ai < 2; ++ai)
#pragma unroll
                    for (int m = 0; m < 4; ++m) ss_out[(size_t)(row0 + ai * HALF + m * 16) * 4 + u.pn] = ss[ai][m][0] + ss[ai][m][1]; }
        }
    }
};
template <class Epi, class Sched, bool ALIGN_EPI = false, bool SP2 = false>
__device__ __forceinline__ void gemm_phase(PG8_LAS unsigned char* lds, const Gemm g, const Sched& S, const Epi& E, const int wave0, const unsigned stag_ticks = 0u) {
    int tid_; asm volatile("v_mbcnt_lo_u32_b32 %0, -1, 0\n\tv_mbcnt_hi_u32_b32 %0, -1, %0" : "=v"(tid_)); tid_ |= wave0 << 6;
    const int tid = tid_, wid = __builtin_amdgcn_readfirstlane(tid >> 6), lane = tid & 63, wr = wid >> 2, wc = wid & 3, fr = lane & 15, fq = lane >> 4;
    const int K = g.K, nt = K / BK;
    unsigned voffA[2], voffB[2];
#pragma unroll
    for (int i = 0; i < 2; ++i) { int R, C; stage_rc(tid * 16 + i * 8192, R, C); const int Rb = Epi::PERM ? ((R & ~31) + perm32(R & 31)) : R;
        voffA[i] = (unsigned)(R * K + C) * 2u; voffB[i] = (unsigned)(Rb * K + C) * 2u; }
    const size_t kstep = (size_t)(BK * 2);
    const size_t hstep = (size_t)HALF * K * 2;
    const size_t tstep = 2 * hstep;
    const unsigned ldsw = (unsigned)wid * 1024u;
    const int aoff = lds_byte(wr * 64 + fr, fq * 8), boff = lds_byte(wc * 32 + fr, fq * 8);
#define PG8_SA(b, h) (((b) * 2 + (h)) * HTB)
#define PG8_SB(b, h) ((4 + (b) * 2 + (h)) * HTB)
#define PG8_STAGE(bufoff, gbase, voff) do { _Pragma("unroll") for (int _i = 0; _i < 2; ++_i) \
        __builtin_amdgcn_global_load_lds((const unsigned*)((const char*)(gbase) + (voff)[_i]), (PG8_LAS unsigned*)(lds + (bufoff) + ldsw + _i * 8192), 16, 0, 0); } while (0)
#define PG8_LDA(dst, b, h) do { _Pragma("unroll") for (int m = 0; m < 4; ++m) _Pragma("unroll") for (int k = 0; k < 2; ++k) dst[m][k] = *(const PG8_LAS bf16x8*)(lds + PG8_SA(b, h) + aoff + m * 2048 + k * 1024); } while (0)
#define PG8_LDB(dst, b, h) do { _Pragma("unroll") for (int n = 0; n < 2; ++n) _Pragma("unroll") for (int k = 0; k < 2; ++k) dst[n][k] = *(const PG8_LAS bf16x8*)(lds + PG8_SB(b, h) + boff + n * 2048 + k * 1024); } while (0)
#define PG8_MMA(ai, bj, At, Bt) do { __builtin_amdgcn_s_setprio(1); _Pragma("unroll") for (int m = 0; m < 4; ++m) _Pragma("unroll") for (int n = 0; n < 2; ++n) _Pragma("unroll") for (int k = 0; k < 2; ++k) \
        acc[ai][bj][m][n] = __builtin_amdgcn_mfma_f32_16x16x32_bf16(Bt[n][k], At[m][k], acc[ai][bj][m][n], 0, 0, 0); __builtin_amdgcn_s_setprio(0); } while (0)
#define PG8_WAIT_V(n) asm volatile("s_waitcnt vmcnt(" #n ")" ::: "memory")
#define PG8_WAIT_L(n) asm volatile("s_waitcnt lgkmcnt(" #n ")" ::: "memory")
#define PG8_WAIT_V_EPI(flag, n) asm volatile("s_cmp_eq_u32 %0, 0\n\ts_cbranch_scc1 1f\n\ts_waitcnt vmcnt(" #n ")\n\ts_branch 2f\n1:\n\ts_waitcnt vmcnt(8)\n2:" :: "s"(flag) : "memory", "scc")
#define PG8_BAR __builtin_amdgcn_s_barrier()
#define PG8_SCHED __builtin_amdgcn_sched_barrier(0)
    Unit cur, nxt; int ui = 0;
    if (!S.next(0, cur)) return;
    if (stag_ticks) {
        const unsigned long long t0_ = __builtin_amdgcn_s_memrealtime();
        while (__builtin_amdgcn_s_memrealtime() - t0_ < (unsigned long long)stag_ticks) __builtin_amdgcn_s_sleep(16);
    }
    f32x4 acc[2][2][4][2];
#pragma unroll
    for (int a = 0; a < 2; ++a)
#pragma unroll
        for (int b = 0; b < 2; ++b)
#pragma unroll
            for (int m = 0; m < 4; ++m)
#pragma unroll
                for (int n = 0; n < 2; ++n) acc[a][b][m][n] = (f32x4){0.f, 0.f, 0.f, 0.f};
    bf16x8 At[4][2], B0[2][2], B1[2][2];
    const char* cA = (const char*)g.A + (size_t)cur.pm * tstep; const char* cB = (const char*)g.Bt + (size_t)cur.pn * tstep;
    S.a_ready(cur);
    if constexpr (SP2) {
        PG8_STAGE(PG8_SB(0, 0), cB, voffB); PG8_STAGE(PG8_SB(0, 1), cB + hstep, voffB); PG8_STAGE(PG8_SA(0, 0), cA, voffA); PG8_STAGE(PG8_SA(0, 1), cA + hstep, voffA);
        if (wr == 1) PG8_BAR;
        PG8_WAIT_V(2); PG8_BAR;
        PG8_STAGE(PG8_SB(1, 0), cB + kstep, voffB); PG8_STAGE(PG8_SA(1, 0), cA + kstep, voffA); PG8_STAGE(PG8_SB(1, 1), cB + hstep + kstep, voffB);
        PG8_WAIT_V(6); PG8_BAR;
    } else {
        PG8_STAGE(PG8_SB(0, 0), cB, voffB); PG8_STAGE(PG8_SA(0, 0), cA, voffA); PG8_STAGE(PG8_SB(0, 1), cB + hstep, voffB); PG8_STAGE(PG8_SA(0, 1), cA + hstep, voffA);
        if (wr == 1) PG8_BAR;
        PG8_WAIT_V(4); PG8_BAR;
        PG8_STAGE(PG8_SB(1, 0), cB + kstep, voffB); PG8_STAGE(PG8_SA(1, 0), cA + kstep, voffA); PG8_STAGE(PG8_SB(1, 1), cB + hstep + kstep, voffB);
        PG8_WAIT_V(6); PG8_BAR;
    }
    for (;;) {
        const bool has_next = S.next(ui + 1, nxt);
        const char* nA = has_next ? (const char*)g.A + (size_t)nxt.pm * tstep : cA; const char* nB = has_next ? (const char*)g.Bt + (size_t)nxt.pn * tstep : cB;
        for (int t = 0; t < nt; t += 2) {
            const bool last = (t == nt - 2);
            const char* a1 = cA + (size_t)(t + 1) * kstep;
            const char* a2 = last ? nA : cA + (size_t)(t + 2) * kstep; const char* b2 = last ? nB : cB + (size_t)(t + 2) * kstep;
            const char* a3 = a2 + kstep; const char* b3 = b2 + kstep;
            if (last && has_next) S.a_ready(nxt);
            if constexpr (SP2) {
            const int after_epi = __builtin_amdgcn_readfirstlane(((t == 0) && (ui > 0)) ? 1 : 0);
            PG8_LDB(B0, 0, 0); PG8_LDB(B1, 0, 1); PG8_SCHED; PG8_LDA(At, 0, 0); PG8_STAGE(PG8_SA(1, 1), a1 + hstep, voffA);
            if constexpr (Epi::NST >= 32) PG8_WAIT_V_EPI(after_epi, 40); else PG8_WAIT_V_EPI(after_epi, 24);
            PG8_WAIT_L(0); PG8_BAR; PG8_MMA(0, 0, At, B0); PG8_MMA(0, 1, At, B1); PG8_BAR; PG8_SCHED;
            PG8_LDA(At, 0, 1); PG8_STAGE(PG8_SB(0, 0), b2, voffB); PG8_STAGE(PG8_SB(0, 1), b2 + hstep, voffB); PG8_STAGE(PG8_SA(0, 0), a2, voffA);
            if constexpr (Epi::NST >= 32) PG8_WAIT_V_EPI(after_epi, 40); else PG8_WAIT_V_EPI(after_epi, 24);
            PG8_WAIT_L(0); PG8_BAR; PG8_MMA(1, 0, At, B0); PG8_MMA(1, 1, At, B1); PG8_BAR; PG8_SCHED;
            PG8_LDB(B0, 1, 0); PG8_LDB(B1, 1, 1); PG8_SCHED; PG8_LDA(At, 1, 0); PG8_STAGE(PG8_SA(0, 1), a2 + hstep, voffA);
            PG8_WAIT_V(8); PG8_WAIT_L(0); PG8_BAR; PG8_MMA(0, 0, At, B0); PG8_MMA(0, 1, At, B1); PG8_BAR; PG8_SCHED;
            PG8_LDA(At, 1, 1); PG8_STAGE(PG8_SB(1, 0), b3, voffB); PG8_STAGE(PG8_SB(1, 1), b3 + hstep, voffB); PG8_STAGE(PG8_SA(1, 0), a3, voffA);
            PG8_WAIT_V(8); PG8_WAIT_L(0); PG8_BAR; PG8_MMA(1, 0, At, B0); PG8_MMA(1, 1, At, B1); PG8_BAR; PG8_SCHED;
            } else {
            PG8_LDB(B0, 0, 0); PG8_SCHED; PG8_LDA(At, 0, 0); PG8_STAGE(PG8_SA(1, 1), a1 + hstep, voffA);
            PG8_WAIT_L(8); PG8_BAR; PG8_WAIT_L(0); PG8_MMA(0, 0, At, B0); PG8_BAR; PG8_SCHED;
            PG8_LDB(B1, 0, 1); PG8_STAGE(PG8_SB(0, 0), b2, voffB);
            PG8_BAR; PG8_WAIT_L(0); PG8_MMA(0, 1, At, B1); PG8_BAR;
            PG8_LDA(At, 0, 1); PG8_STAGE(PG8_SA(0, 0), a2, voffA);
            PG8_BAR; PG8_WAIT_L(0); PG8_MMA(1, 0, At, B0); PG8_BAR; PG8_SCHED;
            PG8_STAGE(PG8_SB(0, 1), b2 + hstep, voffB);
            PG8_WAIT_V(6); PG8_BAR; PG8_MMA(1, 1, At, B1); PG8_BAR;
            PG8_LDB(B0, 1, 0); PG8_SCHED; PG8_LDA(At, 1, 0); PG8_STAGE(PG8_SA(0, 1), a2 + hstep, voffA);
            PG8_WAIT_L(8); PG8_BAR; PG8_WAIT_L(0); PG8_MMA(0, 0, At, B0); PG8_BAR; PG8_SCHED;
            PG8_LDB(B1, 1, 1); PG8_STAGE(PG8_SB(1, 0), b3, voffB);
            PG8_BAR; PG8_WAIT_L(0); PG8_MMA(0, 1, At, B1); PG8_BAR;
            PG8_LDA(At, 1, 1); PG8_STAGE(PG8_SA(1, 0), a3, voffA);
            PG8_BAR; PG8_WAIT_L(0); PG8_MMA(1, 0, At, B0); PG8_BAR; PG8_SCHED;
            PG8_STAGE(PG8_SB(1, 1), b3 + hstep, voffB);
            PG8_WAIT_V(6); PG8_BAR; PG8_MMA(1, 1, At, B1); PG8_BAR;
            }
        }
        if constexpr (ALIGN_EPI) { if (wr == 0) PG8_BAR; }
        if constexpr (!Epi::AFTER_DRAIN) { E(acc, cur, wr, wc, fr, fq); S.done(cur); }
        if (!has_next) break;
#pragma unroll
        for (int a = 0; a < 2; ++a)
#pragma unroll
            for (int b = 0; b < 2; ++b)
#pragma unroll
                for (int m = 0; m < 4; ++m)
#pragma unroll
                    for (int n = 0; n < 2; ++n) acc[a][b][m][n] = (f32x4){0.f, 0.f, 0.f, 0.f};
        cur = nxt; cA = nA; cB = nB; ++ui;
        if constexpr (ALIGN_EPI) { if (wr == 1) PG8_BAR; }
    }
    PG8_WAIT_V(0);
    if constexpr (!ALIGN_EPI) { if (wr == 0) PG8_BAR; }
    PG8_BAR;
    if constexpr (Epi::AFTER_DRAIN) { E.fused(acc, cur, wr, wc, fr, fq, lds, wid, lane); S.done(cur); }
#undef PG8_SA
#undef PG8_SB
#undef PG8_STAGE
#undef PG8_LDA
#undef PG8_LDB
#undef PG8_MMA
#undef PG8_WAIT_V
#undef PG8_WAIT_L
#undef PG8_WAIT_V_EPI
#undef PG8_BAR
#undef PG8_SCHED
}
}
#define XB_TMO      128
#define XB_XCNT(j)  (256  + 64 * (j))
#define XB_XSUB(j)  (1280 + 64 * (j))
#define XB_XGEN(j)  (2304 + 64 * (j))
#define XB_TOP      3328
#define XB_TOPGEN   3392
#define XCD_BAR_WORDS 3456
#define XB_SPIN_CAP (1u << 18)

__device__ __forceinline__ unsigned xb_ld(unsigned* p)              { return __hip_atomic_load(p, __ATOMIC_RELAXED, __HIP_MEMORY_SCOPE_AGENT); }
__device__ __forceinline__ unsigned xb_add(unsigned* p, unsigned v) { return __hip_atomic_fetch_add(p, v, __ATOMIC_RELAXED, __HIP_MEMORY_SCOPE_AGENT); }
__device__ __forceinline__ unsigned xb_xcc_id() { return (unsigned)__builtin_amdgcn_s_getreg((3 << 11) | 20) & 0xFu; }
#define XB_SPIN(cond, bar) do { unsigned _sp = 0; while (cond) { __builtin_amdgcn_s_sleep(1); \
    if ((++_sp & 255u) == 0u) { if (xb_ld(&(bar)[XB_TMO])) break; if (_sp > XB_SPIN_CAP) { atomicAdd(&(bar)[XB_TMO], 1u); break; } } } } while (0)

struct XcdBarrier {
    unsigned* bar; unsigned x;
    volatile LAS unsigned* st;
};

__device__ __forceinline__ XcdBarrier xcd_barrier_post(unsigned* bar, volatile LAS unsigned* st) {
    XcdBarrier b; b.bar = bar; b.x = xb_xcc_id(); b.st = st;
    if (threadIdx.x == 0) (void)xb_add(&bar[XB_XCNT(b.x)], 1u);
    return b;
}
__device__ __forceinline__ void xcd_barrier_complete(unsigned* bar, unsigned x, unsigned& nloc, unsigned& nx) {
    const unsigned G = gridDim.x * gridDim.y * gridDim.z;
    unsigned sum, cnt, mine, sp = 0u;
    for (;;) {
        sum = 0u; cnt = 0u; mine = 0u;
#pragma unroll
        for (unsigned j = 0; j < 16; ++j) { const unsigned c = xb_ld(&bar[XB_XCNT(j)]); sum += c; cnt += (c > 0u) ? 1u : 0u; mine = (j == x) ? c : mine; }
        if (sum == G) break;
        __builtin_amdgcn_s_sleep(1);
        if ((++sp & 255u) == 0u) { if (xb_ld(&bar[XB_TMO])) break; if (sp > XB_SPIN_CAP) { atomicAdd(&bar[XB_TMO], 1u); break; } }
    }
    nloc = mine > 0u ? mine : 1u; nx = cnt > 0u ? cnt : 1u;
}

__device__ __forceinline__ void xcd_barrier(const XcdBarrier& b) {
    asm volatile("s_waitcnt vmcnt(0)" ::: "memory");
    __syncthreads();
    if (threadIdx.x == 0) {
        unsigned* bar = b.bar;
        __builtin_amdgcn_s_waitcnt(0);
        unsigned nloc = b.st[0], nx = b.st[1];
        if (nloc == 0u) { xcd_barrier_complete(bar, b.x, nloc, nx); b.st[0] = nloc; b.st[1] = nx; }
        const unsigned old = xb_add(&bar[XB_XSUB(b.x)], 1u);
        const unsigned gen = old / nloc;
        if (old + 1u == (gen + 1u) * nloc) {
            __builtin_amdgcn_fence(__ATOMIC_RELEASE, "agent");
            asm volatile("s_waitcnt vmcnt(0)" ::: "memory");
            const unsigned og = xb_add(&bar[XB_TOP], 1u);
            const unsigned tg = og / nx;
            if (og + 1u == (tg + 1u) * nx) xb_add(&bar[XB_TOPGEN], 1u);
            else XB_SPIN(xb_ld(&bar[XB_TOPGEN]) == tg, bar);
            __builtin_amdgcn_fence(__ATOMIC_ACQUIRE, "agent");
            xb_add(&bar[XB_XGEN(b.x)], 1u);
            asm volatile("s_waitcnt vmcnt(0)" ::: "memory");
        } else {
            XB_SPIN(xb_ld(&bar[XB_XGEN(b.x)]) == gen, bar);
            __builtin_amdgcn_fence(__ATOMIC_ACQUIRE, "agent");
            asm volatile("s_waitcnt vmcnt(0)" ::: "memory");
        }
    }
    __syncthreads();
}
__device__ __forceinline__ float wave_sum(float v) {
#pragma unroll
    for (int o = 1; o < 64; o <<= 1) v += __shfl_xor(v, o);
    return v;
}
__device__ __forceinline__ float wave_max(float v) {
#pragma unroll
    for (int o = 1; o < 64; o <<= 1) v = fmaxf(v, __shfl_xor(v, o));
    return v;
}
__device__ __forceinline__ void p0_transpose_item(const float* W, int K, int N, bf16* WT, const float* ks, LAS float* scr, int item, int lane) {
    const int nblk = N / 32, kb = item / nblk, nb = item % nblk, k0 = 64 * kb, n0 = 32 * nb;
#pragma unroll 8
    for (int i = 0; i < 32; ++i) { const int kk = 2 * i + (lane >> 5); float w = W[(size_t)(k0 + kk) * N + n0 + (lane & 31)]; if (ks) w *= ks[k0 + kk]; scr[kk * 33 + (lane & 31)] = w; }
    LDS_WAIT(); asm volatile("" ::: "memory");
    const int c = lane & 7;
#pragma unroll
    for (int j = 0; j < 4; ++j) { const int n = (lane >> 3) + 8 * j; const LAS float* s = scr + (8 * c) * 33 + n;
        v4u o; o.x = pk2(s[0 * 33], s[1 * 33]); o.y = pk2(s[2 * 33], s[3 * 33]); o.z = pk2(s[4 * 33], s[5 * 33]); o.w = pk2(s[6 * 33], s[7 * 33]);
        *(GAS v4u*)(WT + (size_t)(n0 + n) * K + k0 + 8 * c) = o; }
    LDS_WAIT(); asm volatile("" ::: "memory");
}

struct Ptrs {
    const float* in[30]; float* out; unsigned char* ws;
};
#define WSP(T, off) ((T*)(P.ws + (off)))

__device__ __forceinline__ void p0_prologue(const Ptrs& P, LAS unsigned char* lds, int tid, int lane, int wave, int vcu, int G) {
    LAS float* scr = (LAS float*)(lds + RING_OFF + wave * 16384);
    const int gw = vcu * NWAVES + wave, NGW = G * NWAVES;
    constexpr int I0 = (DM / 64) * (NIN / 32), I1 = (MW / 64) * (DM / 32), I2 = (DM / 64) * (DM / 32), I3 = I2, I4 = (DM / 64) * (FF / 32), I5 = (FF / 64) * (DM / 32), I6 = I2, I7 = (PLE / 64) * (DM / 32);
    constexpr int NITEMS = I0 + I1 + I2 + I3 + I4 + I5 + I6 + I7;
    for (int it = gw; it < NITEMS; it += NGW) {
        int r = it;
        if (r < I0) { p0_transpose_item(P.in[11], DM, NIN, WSP(bf16, WS_WIN), nullptr, scr, r, lane); continue; } r -= I0;
        if (r < I1) { p0_transpose_item(P.in[14], MW, DM, WSP(bf16, WS_WOA), nullptr, scr, r, lane); continue; } r -= I1;
        if (r < I2) { p0_transpose_item(P.in[22], DM, DM, WSP(bf16, WS_WOB), nullptr, scr, r, lane); continue; } r -= I2;
        if (r < I3) { p0_transpose_item(P.in[23], DM, DM, WSP(bf16, WS_WO), nullptr, scr, r, lane); continue; } r -= I3;
        if (r < I4) { p0_transpose_item(P.in[25], DM, FF, WSP(bf16, WS_WUP), P.in[24], scr, r, lane); continue; } r -= I4;
        if (r < I5) { p0_transpose_item(P.in[26], FF, DM, WSP(bf16, WS_WDN), nullptr, scr, r, lane); continue; } r -= I5;
        if (r < I6) { p0_transpose_item(P.in[28], DM, DM, WSP(bf16, WS_WPG), P.in[27], scr, r, lane); continue; } r -= I6;
        p0_transpose_item(P.in[29], PLE, DM, WSP(bf16, WS_WPE), nullptr, scr, r, lane);
    }
    { const GAS f32x4* gm = (const GAS f32x4*)P.in[10] + lane; f32x4 g[4];
#pragma unroll
      for (int j = 0; j < 4; ++j) g[j] = gm[64 * j];
      bf16* HB = WSP(bf16, WS_HB);
      for (int m0 = gw; m0 < M; m0 += 4 * NGW) {
        f32x4 v[4][4]; float s[4];
#pragma unroll
        for (int r = 0; r < 4; ++r) { const int m = (m0 + r * NGW < M) ? m0 + r * NGW : m0; const float* xrow = (m < MP) ? P.in[0] + (size_t)m * DM : P.in[1] + (size_t)(m - MP) * DM;
            const GAS f32x4* xr = (const GAS f32x4*)xrow + lane;
#pragma unroll
            for (int j = 0; j < 4; ++j) v[r][j] = xr[64 * j]; }
#pragma unroll
        for (int r = 0; r < 4; ++r) { float t = 0.f;
#pragma unroll
            for (int j = 0; j < 4; ++j) t += (v[r][j].x * v[r][j].x + v[r][j].y * v[r][j].y) + (v[r][j].z * v[r][j].z + v[r][j].w * v[r][j].w);
            s[r] = t; }
#pragma unroll
        for (int o = 1; o < 64; o <<= 1) {
#pragma unroll
            for (int r = 0; r < 4; ++r) s[r] += __shfl_xor(s[r], o); }
#pragma unroll
        for (int r = 0; r < 4; ++r) { const int m = m0 + r * NGW; if (m < M) { const float rs = 1.0f / sqrtf(s[r] * (1.f / DM) + 1e-6f);
            GAS v2u* o8 = (GAS v2u*)(HB + (size_t)m * DM) + lane;
#pragma unroll
            for (int j = 0; j < 4; ++j) { v2u w; w.x = pk2(v[r][j].x * rs * g[j].x, v[r][j].y * rs * g[j].y); w.y = pk2(v[r][j].z * rs * g[j].z, v[r][j].w * rs * g[j].w); o8[64 * j] = w; } } }
      }
      bf16* PB = WSP(bf16, WS_PB);
      for (int m0 = gw; m0 < M; m0 += 8 * NGW) {
        f32x4 pv[8];
#pragma unroll
        for (int r = 0; r < 8; ++r) { const int m = (m0 + r * NGW < M) ? m0 + r * NGW : m0; const float* prow = (m < MP) ? P.in[2] + (size_t)m * PLE : P.in[3] + (size_t)(m - MP) * PLE; pv[r] = ((const GAS f32x4*)prow)[lane]; }
#pragma unroll
        for (int r = 0; r < 8; ++r) { const int m = m0 + r * NGW; if (m < M) { v2u w; w.x = pk2(pv[r].x, pv[r].y); w.y = pk2(pv[r].z, pv[r].w); ((GAS v2u*)(PB + (size_t)m * PLE))[lane] = w; } }
      }
    }
    const int gt = vcu * (NWAVES * 64) + tid, NT = G * NWAVES * 64;
    { bf16* WRG = WSP(bf16, WS_WRG);
      for (int e = gt; e < 2 * 65536; e += NT) { const int mat = e >> 16, n = (e >> 12) & 15, o = (e >> 6) & 63, i = e & 63;
          WRG[e] = (bf16)f2bf(P.in[mat ? 19 : 17][(n * 64 + i) * 64 + o] * -1.4426950408889634f); }
      float* TAB = WSP(float, WS_TAB);
      for (int e = gt; e < 12 * 132; e += NT) { const int hh = e / 132, j = e % 132; float v = 0.f;
          if (j <= 128) { const int g = hh >> 2, dist = j << (2 * g); int bk;
              if (dist < 16) bk = dist; else { const double lg = log((double)dist / 16.0) / log(128.0) * 16.0; bk = 16 + (int)lg; if (bk > 31) bk = 31; }
              v = P.in[9][bk * 12 + hh] * 1.4426950408889634f; }
          TAB[e] = v; }
      for (int e = gt; e < 1024; e += NT) { const double x = (double)P.in[21][e]; const double ls = (x >= 0.0) ? -log1p(exp(-x)) : x - log1p(exp(x)); TAB[2048 + e] = (float)(8.0 * ls); }
    }
}

__device__ __forceinline__ unsigned offb(unsigned row, unsigned ch) { return 256u * row + 16u * (ch ^ (((row & 3u) << 2) | ((row >> 2) & 3u))); }
__device__ __forceinline__ s16x4 vtr(LAS const unsigned char* p) { typedef short v4i16_t __attribute__((ext_vector_type(4))); return __builtin_bit_cast(s16x4, __builtin_amdgcn_ds_read_tr16_b64_v4i16((LAS v4i16_t*)p)); }

__device__ __forceinline__ void attn_unit(const Ptrs& P, LAS unsigned char* lds, int uid, bool have_prev, int tid, int lane, int w, int probe) {
    const int blk = uid & 63, h4 = (uid >> 6) & 3, b = (uid >> 8) & 7, g = uid >> 11;
    const int gsh = 2 * g, hh = 4 * g + h4;
    const int nb = blk & ((64 >> gsh) - 1); const bool first = nb == 0;
    const int par = nb & 1; const unsigned xr = par ? 0u : 32768u;
    const size_t qrow0 = ((size_t)(b * 12 + hh) << 13) + (size_t)blk * 128;
    const bf16* Qb = WSP(bf16, WS_Q); const bf16* Kb = WSP(bf16, WS_K); const bf16* Vb = WSP(bf16, WS_V);
    LAS unsigned char* Kimg = lds; LAS unsigned char* Vimg = lds + 65536;
    const LAS float* bias = (const LAS float*)(lds + XCH_OFF) + hh * 132;
    const int qi = lane & 15, g4 = lane >> 4;
    {
        const int lr = lane >> 4, sl = lane & 15;
#pragma unroll
        for (int i = 0; i < 4; ++i) { const int pl = w * 4 + i, p = 32 * par + pl; const int ch = sl ^ ((lr << 2) | (p & 3));
            const size_t srow = qrow0 + 4 * pl + lr;
            __builtin_amdgcn_global_load_lds((const unsigned*)((const char*)Kb + srow * 256 + ch * 16), (LAS unsigned*)(Kimg + p * 1024), 16, 0, 0);
            __builtin_amdgcn_global_load_lds((const unsigned*)((const char*)Vb + srow * 256 + ch * 16), (LAS unsigned*)(Vimg + p * 1024), 16, 0, 0); }
        if (!first && !have_prev) {
#pragma unroll
            for (int i = 0; i < 4; ++i) { const int pl = w * 4 + i, p = 32 * (par ^ 1) + pl; const int ch = sl ^ ((lr << 2) | (p & 3));
                const size_t srow = qrow0 - 128 + 4 * pl + lr;
                __builtin_amdgcn_global_load_lds((const unsigned*)((const char*)Kb + srow * 256 + ch * 16), (LAS unsigned*)(Kimg + p * 1024), 16, 0, 0);
                __builtin_amdgcn_global_load_lds((const unsigned*)((const char*)Vb + srow * 256 + ch * 16), (LAS unsigned*)(Vimg + p * 1024), 16, 0, 0); } }
        if (first) {
#pragma unroll
            for (int i = 0; i < 4; ++i) *(LAS v4u*)(Vimg + 32768 * (par ^ 1) + (i * 512 + tid) * 16) = (v4u){0u, 0u, 0u, 0u}; }
    }
    bf16x8 Qf[4];
    { const bf16* qp = Qb + (qrow0 + 16 * w + qi) * 128 + 8 * g4;
#pragma unroll
      for (int s = 0; s < 4; ++s) Qf[s] = *(const bf16x8*)(qp + 32 * s); }
    VM_WAIT(); LDS_WAIT(); __syncthreads();
    f32x4 S[9];
    { const unsigned fl = ((lane & 3) << 2) | ((lane >> 2) & 3);
      const unsigned kb = 256u * (unsigned)(16 * w + qi);
#pragma unroll
      for (int jb = 0; jb < 9; ++jb) { S[jb] = (f32x4){0.f, 0.f, 0.f, 0.f};
#pragma unroll
          for (int s = 0; s < 4; ++s) { const bf16x8 a = *(const LAS bf16x8*)(Kimg + (((kb + jb * 4096u) ^ xr) + 16u * ((unsigned)(4 * s + g4) ^ fl)));
              S[jb] = __builtin_amdgcn_mfma_f32_16x16x32_bf16(a, Qf[s], S[jb], 0, 0, 0); } } }
    if (probe & 16) { float t_ = 0.f;
#pragma unroll
        for (int jb = 0; jb < 9; ++jb) t_ += S[jb][0] + S[jb][1] + S[jb][2] + S[jb][3];
        if (t_ == 1.2345e-30f) WSP(float, WS_LSE)[tid] = t_; __syncthreads(); return; }
    float mx = -1e30f;
#pragma unroll
    for (int jb = 0; jb < 9; ++jb)
#pragma unroll
        for (int i = 0; i < 4; ++i) { const int ki = 4 * g4 + i, rel = 16 * jb + ki - qi;
            int slot = 128 - rel; slot = slot < 0 ? 0 : (slot > 128 ? 128 : slot);
            bool ok = true; if (jb == 0) ok = rel >= 0; if (jb == 8) ok = rel <= 128;
            if (first) ok = ok && (16 * w + 16 * jb + ki >= 128);
            const float v = ok ? S[jb][i] + bias[slot] : -1e30f; S[jb][i] = v; mx = fmaxf(mx, v); }
    mx = fmaxf(mx, __shfl_xor(mx, 16)); mx = fmaxf(mx, __shfl_xor(mx, 32));
    float tot = 0.f;
#pragma unroll
    for (int jb = 0; jb < 9; ++jb)
#pragma unroll
        for (int i = 0; i < 4; ++i) { const float p = fexp2(S[jb][i] - mx); S[jb][i] = p; tot += p; }
    tot += __shfl_xor(tot, 16); tot += __shfl_xor(tot, 32);
    bf16x8 Pf[5];
#pragma unroll
    for (int ks = 0; ks < 5; ++ks) { v4u pk; pk.x = pk2(S[2 * ks][0], S[2 * ks][1]); pk.y = pk2(S[2 * ks][2], S[2 * ks][3]);
        if (ks < 4) { pk.z = pk2(S[2 * ks + 1][0], S[2 * ks + 1][1]); pk.w = pk2(S[2 * ks + 1][2], S[2 * ks + 1][3]); } else { pk.z = 0u; pk.w = 0u; }
        Pf[ks] = __builtin_bit_cast(bf16x8, pk); }
    f32x4 O[8];
#pragma unroll
    for (int c = 0; c < 8; ++c) O[c] = (f32x4){0.f, 0.f, 0.f, 0.f};
    { const int q = (lane & 15) >> 2, p = lane & 3; const unsigned fl = ((unsigned)q << 2) | (unsigned)g4;
      const unsigned vb = 256u * (unsigned)(16 * w + 4 * g4 + q);
#pragma unroll
      for (int ks = 0; ks < 5; ++ks)
#pragma unroll
          for (int c = 0; c < 8; ++c) { const unsigned co = 16u * (((unsigned)(2 * c + (p >> 1))) ^ fl) + 8u * (unsigned)(p & 1);
              const s16x4 lo = vtr(Vimg + (((vb + 256u * (32 * ks)) ^ xr) + co));
              const s16x4 hi = vtr(Vimg + (((vb + 256u * (32 * ks + (ks < 4 ? 16 : 0))) ^ xr) + co));
              const bf16x8 a = (bf16x8){lo[0], lo[1], lo[2], lo[3], hi[0], hi[1], hi[2], hi[3]};
              O[c] = __builtin_amdgcn_mfma_f32_16x16x32_bf16(a, Pf[ks], O[c], 0, 0, 0); } }
    const float inv = frcp(tot);
    const int mq = nb * 128 + 16 * w + qi, rr = blk >> (6 - gsh);
    const size_t R = (size_t)b * SEQ + ((size_t)mq << gsh) + rr;
    bf16* og = WSP(bf16, WS_OG) + ((size_t)g * MP + R) * MW + h4 * 128 + 4 * g4;
#pragma unroll
    for (int c = 0; c < 8; ++c) { v2u o; o.x = pk2(O[c][0] * inv, O[c][1] * inv); o.y = pk2(O[c][2] * inv, O[c][3] * inv); if (!(probe & 8) || o.x == 0x7fc17fc1u) *(GAS v2u*)(og + 16 * c) = o; }
    if (g4 == 0) WSP(float, WS_LSE)[((size_t)g * MP + R) * 4 + h4] = mx + __log2f(tot);
    __syncthreads();
}

__device__ __forceinline__ void glds16(const void* gsrc, unsigned lds_dst) { unsigned keep;
    asm volatile("s_mov_b32 %0, m0\n\ts_mov_b32 m0, %2\n\ts_nop 0\n\tglobal_load_lds_dwordx4 %1, off\n\ts_mov_b32 m0, %0" : "=&s"(keep) : "v"(gsrc), "s"(lds_dst) : "memory"); }
__device__ __forceinline__ void attn_dma_half(const bf16* src, LAS unsigned char* img, size_t row0, int half, int lane, int w) {
    const int lr = lane >> 4, sl = lane & 15; const unsigned img0 = (unsigned)(uintptr_t)img;
#pragma unroll
    for (int i = 0; i < 4; ++i) { const int pl = w * 4 + i, p = 32 * half + pl; const int ch = sl ^ ((lr << 2) | (p & 3));
        glds16((const char*)src + (row0 + 4 * pl + lr) * 256 + ch * 16, (unsigned)__builtin_amdgcn_readfirstlane((int)(img0 + p * 1024))); }
}
__device__ __forceinline__ void attn_qload(bf16x8 (&Qf)[4], const bf16* qp) {
    asm volatile("global_load_dwordx4 %0, %4, off\n\tglobal_load_dwordx4 %1, %4, off offset:64\n\tglobal_load_dwordx4 %2, %4, off offset:128\n\tglobal_load_dwordx4 %3, %4, off offset:192"
                 : "=&v"(Qf[0]), "=&v"(Qf[1]), "=&v"(Qf[2]), "=&v"(Qf[3]) : "v"(qp) : "memory"); }
#define ATT_WAIT(n) asm volatile("s_waitcnt vmcnt(" #n ")" ::: "memory")
#define ATT_WAITQ(n) asm volatile("s_waitcnt vmcnt(" #n ")" : "+v"(Qf[0]), "+v"(Qf[1]), "+v"(Qf[2]), "+v"(Qf[3]) :: "memory")
#define ATT_BAR() do { asm volatile("s_waitcnt lgkmcnt(0)" ::: "memory"); __builtin_amdgcn_s_barrier(); asm volatile("" ::: "memory"); } while (0)
__device__ __forceinline__ void attn_run(const Ptrs& P, LAS unsigned char* lds, int u0, int n, int tid, int lane, int w) {
    const bf16* Qb = WSP(bf16, WS_Q); const bf16* Kb = WSP(bf16, WS_K); const bf16* Vb = WSP(bf16, WS_V);
    LAS unsigned char* Kimg = lds; LAS unsigned char* Vimg = lds + 65536;
    const int qi = lane & 15, g4 = lane >> 4;
    const int blk0 = u0 & 63, h4 = (u0 >> 6) & 3, b = (u0 >> 8) & 7, g = u0 >> 11; const int gsh = 2 * g, hh = 4 * g + h4;
    const int nb0 = blk0 & ((64 >> gsh) - 1); const bool first0 = nb0 == 0;
    const size_t q00 = ((size_t)(b * 12 + hh) << 13) + (size_t)blk0 * 128;
    float bm[9][4];
    { const LAS float* bias = (const LAS float*)(lds + XCH_OFF) + hh * 132;
#pragma unroll
      for (int jb = 0; jb < 9; ++jb)
#pragma unroll
          for (int i = 0; i < 4; ++i) { const int ki = 4 * g4 + i, rel = 16 * jb + ki - qi; int slot = 128 - rel; slot = slot < 0 ? 0 : (slot > 128 ? 128 : slot);
              bool ok = true; if (jb == 0) ok = rel >= 0; if (jb == 8) ok = rel <= 128;
              bm[jb][i] = ok ? bias[slot] : -1e30f; } }
    bf16x8 Qf[4];
    { const int par = nb0 & 1;
      attn_dma_half(Kb, Kimg, q00, par, lane, w); attn_dma_half(Vb, Vimg, q00, par, lane, w);
      if (!first0) { attn_dma_half(Kb, Kimg, q00 - 128, par ^ 1, lane, w); attn_dma_half(Vb, Vimg, q00 - 128, par ^ 1, lane, w); }
      else {
#pragma unroll
          for (int i = 0; i < 4; ++i) *(LAS v4u*)(Vimg + 32768 * (par ^ 1) + (i * 512 + tid) * 16) = (v4u){0u, 0u, 0u, 0u}; }
      attn_qload(Qf, Qb + (q00 + 16 * w + qi) * 128 + 8 * g4);
      ATT_WAIT(0); }
#pragma unroll 1
    for (int it = 0; it < n; ++it) {
        const bool has_next = it + 1 < n; const bool first = first0 && it == 0;
        const int nb = nb0 + it, par = nb & 1; const unsigned xr = par ? 0u : 32768u; const size_t qrow0 = q00 + (size_t)it * 128;
        ATT_WAITQ(9);
        ATT_BAR();
        if (it > 0) attn_dma_half(Vb, Vimg, qrow0, par, lane, w);
        f32x4 S[9];
        { const unsigned fl = ((lane & 3) << 2) | ((lane >> 2) & 3);
          const unsigned kb = 256u * (unsigned)(16 * w + qi);
          unsigned ko[4];
#pragma unroll
          for (int s = 0; s < 4; ++s) ko[s] = 16u * ((unsigned)(4 * s + g4) ^ fl);
          bf16x8 kf[2][4];
#pragma unroll
          for (int s = 0; s < 4; ++s) kf[0][s] = *(const LAS bf16x8*)(Kimg + ((kb ^ xr) + ko[s]));
#pragma unroll
          for (int jb = 0; jb < 9; ++jb) {
              if (jb < 8) {
#pragma unroll
                  for (int s = 0; s < 4; ++s) kf[(jb + 1) & 1][s] = *(const LAS bf16x8*)(Kimg + (((kb + (jb + 1) * 4096u) ^ xr) + ko[s])); }
              S[jb] = (f32x4){0.f, 0.f, 0.f, 0.f};
#pragma unroll
              for (int s = 0; s < 4; ++s) S[jb] = __builtin_amdgcn_mfma_f32_16x16x32_bf16(kf[jb & 1][s], Qf[s], S[jb], 0, 0, 0); } }
        if (first) {
#pragma unroll
            for (int jb = 0; jb < 8; ++jb) if (w + jb < 8) S[jb] = (f32x4){-1e30f, -1e30f, -1e30f, -1e30f}; }
        float mx = -1e30f;
#pragma unroll
        for (int jb = 0; jb < 9; ++jb)
#pragma unroll
            for (int i = 0; i < 4; ++i) { const float v = S[jb][i] + bm[jb][i]; S[jb][i] = v; mx = fmaxf(mx, v); }
        mx = fmaxf(mx, __shfl_xor(mx, 16)); mx = fmaxf(mx, __shfl_xor(mx, 32));
        float tot = 0.f;
#pragma unroll
        for (int jb = 0; jb < 9; ++jb)
#pragma unroll
            for (int i = 0; i < 4; ++i) { const float p = fexp2(S[jb][i] - mx); S[jb][i] = p; tot += p; }
        tot += __shfl_xor(tot, 16); tot += __shfl_xor(tot, 32);
        bf16x8 Pf[5];
#pragma unroll
        for (int ks = 0; ks < 5; ++ks) { v4u pk; pk.x = pk2(S[2 * ks][0], S[2 * ks][1]); pk.y = pk2(S[2 * ks][2], S[2 * ks][3]);
            if (ks < 4) { pk.z = pk2(S[2 * ks + 1][0], S[2 * ks + 1][1]); pk.w = pk2(S[2 * ks + 1][2], S[2 * ks + 1][3]); } else { pk.z = 0u; pk.w = 0u; }
            Pf[ks] = __builtin_bit_cast(bf16x8, pk); }
        ATT_WAIT(0);
        ATT_BAR();
        if (has_next) attn_dma_half(Kb, Kimg, qrow0 + 128, par ^ 1, lane, w);
        attn_qload(Qf, Qb + (qrow0 + (has_next ? 128 : 0) + 16 * w + qi) * 128 + 8 * g4);
        f32x4 O[8];
#pragma unroll
        for (int c = 0; c < 8; ++c) O[c] = (f32x4){0.f, 0.f, 0.f, 0.f};
        { const int q = (lane & 15) >> 2, p = lane & 3; const unsigned fl = ((unsigned)q << 2) | (unsigned)g4;
          const unsigned vb = 256u * (unsigned)(16 * w + 4 * g4 + q);
          unsigned co[8];
#pragma unroll
          for (int c = 0; c < 8; ++c) co[c] = 16u * (((unsigned)(2 * c + (p >> 1))) ^ fl) + 8u * (unsigned)(p & 1);
          s16x4 lo[2][8], hi[2][8];
          { const unsigned r0 = vb ^ xr, r1 = (vb + 256u * 16u) ^ xr;
#pragma unroll
            for (int c = 0; c < 8; ++c) { lo[0][c] = vtr(Vimg + (r0 + co[c])); hi[0][c] = vtr(Vimg + (r1 + co[c])); } }
#pragma unroll
          for (int ks = 0; ks < 5; ++ks) {
              if (ks < 4) { const unsigned r0 = (vb + 256u * (32 * (ks + 1))) ^ xr, r1 = (vb + 256u * (32 * (ks + 1) + (ks + 1 < 4 ? 16 : 0))) ^ xr;
#pragma unroll
                  for (int c = 0; c < 8; ++c) { lo[(ks + 1) & 1][c] = vtr(Vimg + (r0 + co[c])); hi[(ks + 1) & 1][c] = vtr(Vimg + (r1 + co[c])); } }
#pragma unroll
              for (int c = 0; c < 8; ++c) { const s16x4 l_ = lo[ks & 1][c], h_ = hi[ks & 1][c];
                  const bf16x8 va = (bf16x8){l_[0], l_[1], l_[2], l_[3], h_[0], h_[1], h_[2], h_[3]};
                  O[c] = __builtin_amdgcn_mfma_f32_16x16x32_bf16(va, Pf[ks], O[c], 0, 0, 0); } } }
        const float inv = frcp(tot);
        const int mq = nb * 128 + 16 * w + qi, rr = blk0 >> (6 - gsh);
        const size_t R = (size_t)b * SEQ + ((size_t)mq << gsh) + rr;
        bf16* og = WSP(bf16, WS_OG) + ((size_t)g * MP + R) * MW + h4 * 128 + 4 * g4;
#pragma unroll
        for (int c = 0; c < 8; ++c) { v2u o; o.x = pk2(O[c][0] * inv, O[c][1] * inv); o.y = pk2(O[c][2] * inv, O[c][3] * inv); *(GAS v2u*)(og + 16 * c) = o; }
        WSP(float, WS_LSE)[((size_t)g * MP + R) * 4 + h4] = mx + __log2f(tot);
    }
    ATT_WAIT(0); ATT_BAR();
}

__device__ __forceinline__ const float* sattn_row(const float* cache, const float* knew, int b, int t, int gsh, int j) {
    const int nbuf = 128 << gsh, jj = j < 129 ? j : 128, ridx = nbuf + t - (jj << gsh);
    return (ridx >= nbuf) ? knew + (size_t)(b * 4 + (ridx - nbuf)) * 1024 : cache + ((size_t)b * nbuf + ridx) * 1024;
}
__device__ __forceinline__ void sattn_unit(const Ptrs& P, LAS unsigned char* lds, int su, int tid, int lane, int w) {
    constexpr int NSB = 4;
    const int b = su >> 2, t = su & 3; const int h = lane >> 4, sub = lane & 15;
    LAS float* LG = (LAS float*)lds;
    LAS float* PART = (LAS float*)(lds + 8192);
    const LAS float* bias = (const LAS float*)(lds + XCH_OFF);
    const float* QS = WSP(float, WS_QS) + (size_t)su * AW;
    const int lo = h * 128 + 8 * sub;
#pragma unroll
    for (int g = 0; g < 3; ++g) {
        const int gsh = 2 * g; const float* cache = g == 0 ? P.in[4] : (g == 1 ? P.in[5] : P.in[6]); const float* knew = P.out + pg8::kvs_off(g);
        const f32x4 q0 = *(const f32x4*)(QS + (4 * g + h) * 128 + 8 * sub), q1 = *(const f32x4*)(QS + (4 * g + h) * 128 + 8 * sub + 4);
        f32x4 n0[NSB], n1[NSB];
#pragma unroll
        for (int u = 0; u < NSB; ++u) { const float* rp = sattn_row(cache, knew, b, t, gsh, w + 8 * u) + lo; n0[u] = *(const f32x4*)rp; n1[u] = *(const f32x4*)(rp + 4); }
#pragma unroll 1
        for (int j0 = w; j0 < 129; j0 += 8 * NSB) {
            f32x4 k0[NSB], k1[NSB];
#pragma unroll
            for (int u = 0; u < NSB; ++u) { k0[u] = n0[u]; k1[u] = n1[u]; }
            if (j0 + 8 * NSB < 129) {
#pragma unroll
                for (int u = 0; u < NSB; ++u) { const float* rp = sattn_row(cache, knew, b, t, gsh, j0 + 8 * NSB + 8 * u) + lo; n0[u] = *(const f32x4*)rp; n1[u] = *(const f32x4*)(rp + 4); } }
#pragma unroll
            for (int u = 0; u < NSB; ++u) { const int j = j0 + 8 * u;
                float d = (q0[0] * k0[u][0] + q0[1] * k0[u][1]) + (q0[2] * k0[u][2] + q0[3] * k0[u][3]) + (q1[0] * k1[u][0] + q1[1] * k1[u][1]) + (q1[2] * k1[u][2] + q1[3] * k1[u][3]);
                d += __shfl_xor(d, 1); d += __shfl_xor(d, 2); d += __shfl_xor(d, 4); d += __shfl_xor(d, 8);
                if (sub == 0 && j < 129) LG[h * 392 + g * 129 + j] = d + bias[(4 * g + h) * 132 + j]; } }
    }
    LDS_WAIT(); __syncthreads();
    float mxh = 0.f, invh = 0.f;
#pragma unroll
    for (int hd = 0; hd < 4; ++hd) { float m = -1e30f;
        for (int i = lane; i < 387; i += 64) m = fmaxf(m, LG[hd * 392 + i]);
        m = wave_max(m); float s = 0.f;
        for (int i = lane; i < 387; i += 64) s += fexp2(LG[hd * 392 + i] - m);
        s = wave_sum(s); if (hd == h) { mxh = m; invh = 1.0f / s; } }
    float acc[8];
#pragma unroll
    for (int i = 0; i < 8; ++i) acc[i] = 0.f;
#pragma unroll
    for (int g = 0; g < 3; ++g) {
        const int gsh = 2 * g; const float* cache = g == 0 ? P.in[4] : (g == 1 ? P.in[5] : P.in[6]); const float* knew = P.out + pg8::kvs_off(g);
        f32x4 n0[NSB], n1[NSB];
#pragma unroll
        for (int u = 0; u < NSB; ++u) { const float* rp = sattn_row(cache, knew, b, t, gsh, w + 8 * u) + 512 + lo; n0[u] = *(const f32x4*)rp; n1[u] = *(const f32x4*)(rp + 4); }
#pragma unroll 1
        for (int j0 = w; j0 < 129; j0 += 8 * NSB) {
            f32x4 v0[NSB], v1[NSB];
#pragma unroll
            for (int u = 0; u < NSB; ++u) { v0[u] = n0[u]; v1[u] = n1[u]; }
            if (j0 + 8 * NSB < 129) {
#pragma unroll
                for (int u = 0; u < NSB; ++u) { const float* rp = sattn_row(cache, knew, b, t, gsh, j0 + 8 * NSB + 8 * u) + 512 + lo; n0[u] = *(const f32x4*)rp; n1[u] = *(const f32x4*)(rp + 4); } }
#pragma unroll
            for (int u = 0; u < NSB; ++u) { const int j = j0 + 8 * u;
                const float p = (j < 129) ? fexp2(LG[h * 392 + g * 129 + (j < 129 ? j : 128)] - mxh) * invh : 0.f;
#pragma unroll
                for (int i = 0; i < 4; ++i) { acc[i] += p * v0[u][i]; acc[4 + i] += p * v1[u][i]; } } }
    }
#pragma unroll
    for (int i = 0; i < 8; ++i) PART[w * 512 + lane * 8 + i] = acc[i];
    LDS_WAIT(); __syncthreads();
    { float s = 0.f;
#pragma unroll
      for (int k = 0; k < 8; ++k) s += PART[k * 512 + tid];
      WSP(bf16, WS_ATT)[(size_t)(MP + su) * MW + tid] = (bf16)f2bf(s); }
    __syncthreads();
}

struct CombItem { v4u a, b, c; float l0, l1, l2; };
__device__ __forceinline__ void comb_load(const Ptrs& P, int it, CombItem& x) {
    const bf16* OG = WSP(bf16, WS_OG); const float* LSE = WSP(float, WS_LSE); const int R = it >> 6, ck = it & 63, h4 = ck >> 4;
    x.l0 = LSE[((size_t)0 * MP + R) * 4 + h4]; x.l1 = LSE[((size_t)1 * MP + R) * 4 + h4]; x.l2 = LSE[((size_t)2 * MP + R) * 4 + h4];
    x.a = *(const v4u*)(OG + ((size_t)0 * MP + R) * MW + ck * 8); x.b = *(const v4u*)(OG + ((size_t)1 * MP + R) * MW + ck * 8); x.c = *(const v4u*)(OG + ((size_t)2 * MP + R) * MW + ck * 8);
}
__device__ __forceinline__ void comb_finish(const Ptrs& P, int it, const CombItem& x) {
    const float mx = fmaxf(x.l0, fmaxf(x.l1, x.l2)); float w0 = fexp2(x.l0 - mx), w1 = fexp2(x.l1 - mx), w2 = fexp2(x.l2 - mx); const float inv = frcp(w0 + w1 + w2); w0 *= inv; w1 *= inv; w2 *= inv;
    v4u o;
    o.x = pk2(w0 * bflo(x.a.x) + w1 * bflo(x.b.x) + w2 * bflo(x.c.x), w0 * bfhi(x.a.x) + w1 * bfhi(x.b.x) + w2 * bfhi(x.c.x));
    o.y = pk2(w0 * bflo(x.a.y) + w1 * bflo(x.b.y) + w2 * bflo(x.c.y), w0 * bfhi(x.a.y) + w1 * bfhi(x.b.y) + w2 * bfhi(x.c.y));
    o.z = pk2(w0 * bflo(x.a.z) + w1 * bflo(x.b.z) + w2 * bflo(x.c.z), w0 * bfhi(x.a.z) + w1 * bfhi(x.b.z) + w2 * bfhi(x.c.z));
    o.w = pk2(w0 * bflo(x.a.w) + w1 * bflo(x.b.w) + w2 * bflo(x.c.w), w0 * bfhi(x.a.w) + w1 * bfhi(x.b.w) + w2 * bfhi(x.c.w));
    *(v4u*)(WSP(bf16, WS_ATT) + (size_t)(it >> 6) * MW + (it & 63) * 8) = o;
}
__device__ __forceinline__ int crow(int r, int hi) { return (r & 3) + 8 * (r >> 2) + 4 * hi; }
constexpr int TAB_HC = 4096, TAB_SA = 12288, TAB_SB = 20480;
template <bool OUT> __device__ __forceinline__ void lru_unit(const Ptrs& P, LAS unsigned char* lds, int b, int n, int rg, int tid, int lane, int w, int comb_base = -1) {
    LAS unsigned char* AIMG = lds;
    LAS float* XC32 = (LAS float*)(lds + 16384);
    LAS float* HST = (LAS float*)(lds + 49152);
    LAS float* SUM = (LAS float*)(lds + 81920);
    LAS float* WC = (LAS float*)(lds + 84992);
    const int ch0 = 64 * n, tb = w >> 1, cb = w & 1, cl = lane & 31, hi = lane >> 5, mych = ch0 + 32 * cb + cl;
    if (tid < 320) { const int k = tid >> 6, i = tid & 63; WC[tid] = (k < 4) ? P.in[15][k * 1024 + ch0 + i] : P.in[16][ch0 + i]; }
    const bf16* WRG = WSP(bf16, WS_WRG);
    bf16x8 Bfa[4], Bfi[4];
#pragma unroll
    for (int s = 0; s < 4; ++s) { Bfa[s] = *(const bf16x8*)(WRG + ((size_t)(n * 64 + 32 * cb + cl) * 64 + 16 * s + 8 * hi));
                                  Bfi[s] = *(const bf16x8*)(WRG + 65536 + ((size_t)(n * 64 + 32 * cb + cl) * 64 + 16 * s + 8 * hi)); }
    const float ba = P.in[18][mych] * -1.4426950408889634f, bi = P.in[20][mych] * -1.4426950408889634f, c8l = WSP(float, WS_TAB)[2048 + mych] * 1.4426950408889634f;
    float hstate = 0.f, astate = 1.f;
    if (OUT && rg >= 1) { const float* T = WSP(float, WS_TAB) + b * 1024 + mych; hstate = T[TAB_HC]; if (rg == 2) hstate = T[TAB_SA] * hstate + T[TAB_SB]; }
    const int nch = (rg == 0) ? 32 : 16;
    const int tl = tid >> 2, cg = tid & 3;
    const bf16* XB = WSP(bf16, WS_XB); const bf16* GY = WSP(bf16, WS_GY); bf16* HRG = WSP(bf16, WS_HRG);
    v4u xv[4][2];
    const int tbase = (rg == 0) ? 0 : (rg == 1 ? 4096 : 6144);
    { const int t0 = tbase;
#pragma unroll
      for (int k = 0; k < 4; ++k) { const int t = t0 + tl - 3 + k;
          if (t >= 0) { const v4u* p = (const v4u*)(XB + ((size_t)b * SEQ + t) * DM + ch0 + 16 * cg); xv[k][0] = p[0]; xv[k][1] = p[1]; }
          else { xv[k][0] = (v4u){0u, 0u, 0u, 0u}; xv[k][1] = (v4u){0u, 0u, 0u, 0u}; } } }
    LDS_WAIT(); __syncthreads();
    for (int ci = 0; ci < nch; ++ci) {
        const int t0 = tbase + ci * 128; const size_t R0 = (size_t)b * SEQ + t0;
        {
            float xc[16];
#pragma unroll
            for (int q = 0; q < 4; ++q) { const f32x4 bc = *(const LAS f32x4*)(WC + 256 + 16 * cg + 4 * q); xc[4 * q] = bc[0]; xc[4 * q + 1] = bc[1]; xc[4 * q + 2] = bc[2]; xc[4 * q + 3] = bc[3]; }
#pragma unroll
            for (int k = 0; k < 4; ++k)
#pragma unroll
                for (int q = 0; q < 4; ++q) { const f32x4 wv = *(const LAS f32x4*)(WC + 64 * k + 16 * cg + 4 * q);
                    const unsigned u0 = xv[k][q >> 1][(q & 1) * 2], u1 = xv[k][q >> 1][(q & 1) * 2 + 1];
                    xc[4 * q] += wv[0] * bflo(u0); xc[4 * q + 1] += wv[1] * bfhi(u0); xc[4 * q + 2] += wv[2] * bflo(u1); xc[4 * q + 3] += wv[3] * bfhi(u1); }
#pragma unroll
            for (int q = 0; q < 4; ++q) *(LAS f32x4*)(XC32 + tl * 64 + 4 * ((4 * cg + q) ^ (tl & 15))) = (f32x4){xc[4 * q], xc[4 * q + 1], xc[4 * q + 2], xc[4 * q + 3]};
#pragma unroll
            for (int e = 0; e < 2; ++e) { v4u o; o.x = pk2(xc[8 * e], xc[8 * e + 1]); o.y = pk2(xc[8 * e + 2], xc[8 * e + 3]); o.z = pk2(xc[8 * e + 4], xc[8 * e + 5]); o.w = pk2(xc[8 * e + 6], xc[8 * e + 7]);
                *(LAS v4u*)(AIMG + tl * 128 + 16 * ((2 * cg + e) ^ ((tl >> 1) & 7))) = o; }
        }
        v4u gy0, gy1;
        if (OUT) { const v4u* p = (const v4u*)(GY + (R0 + tl) * DM + ch0 + 16 * cg); gy0 = p[0]; gy1 = p[1]; }
        CombItem cb0, cb1; const int cit = (comb_base + ci) * 1024 + tid;
        if (OUT && comb_base >= 0) { comb_load(P, cit, cb0); comb_load(P, cit + 512, cb1); }
        if (ci + 1 < nch) {
#pragma unroll
            for (int k = 0; k < 4; ++k) { const v4u* p = (const v4u*)(XB + (R0 + 128 + tl - 3 + k) * DM + ch0 + 16 * cg); xv[k][0] = p[0]; xv[k][1] = p[1]; } }
        LDS_WAIT(); __builtin_amdgcn_s_barrier(); asm volatile("" ::: "memory");
        f32x16 za, zi;
#pragma unroll
        for (int i = 0; i < 16; ++i) { za[i] = 0.f; zi[i] = 0.f; }
        { const int row = 32 * tb + cl;
#pragma unroll
          for (int s = 0; s < 4; ++s) { const bf16x8 a = *(const LAS bf16x8*)(AIMG + row * 128 + 16 * ((2 * s + hi) ^ ((row >> 1) & 7)));
              za = __builtin_amdgcn_mfma_f32_32x32x16_bf16(a, Bfa[s], za, 0, 0, 0); zi = __builtin_amdgcn_mfma_f32_32x32x16_bf16(a, Bfi[s], zi, 0, 0, 0); } }
        float av[16], bv[16];
#pragma unroll
        for (int i = 0; i < 16; ++i) { const int tk_ = 32 * tb + crow(i, hi); const float xcv = XC32[tk_ * 64 + 4 * (((32 * cb + cl) >> 2) ^ (tk_ & 15)) + (cl & 3)];
            const float r = frcp(1.0f + fexp2(za[i] + ba)), ig = frcp(1.0f + fexp2(zi[i] + bi)); const float a = fexp2(c8l * r); av[i] = a; bv[i] = __builtin_amdgcn_sqrtf(fmaf(-a, a, 1.0f)) * (ig * xcv); }
        float As[4], Bs[4], pAs[4], pBs[4], preA[4], preB[4];
#pragma unroll
        for (int sg = 0; sg < 4; ++sg) { float A = 1.f, B = 0.f;
#pragma unroll
            for (int e = 0; e < 4; ++e) { B = av[4 * sg + e] * B + bv[4 * sg + e]; A = av[4 * sg + e] * A; }
            As[sg] = A; Bs[sg] = B; pAs[sg] = __shfl_xor(A, 32); pBs[sg] = __shfl_xor(B, 32); }
        float PA = 1.f, PB = 0.f;
#pragma unroll
        for (int sg = 0; sg < 4; ++sg) {
            const float fA = hi ? pAs[sg] : As[sg], fB = hi ? pBs[sg] : Bs[sg], sA = hi ? As[sg] : pAs[sg], sB = hi ? Bs[sg] : pBs[sg];
            const float PB1 = fA * PB + fB, PA1 = fA * PA;
            preA[sg] = hi ? PA1 : PA; preB[sg] = hi ? PB1 : PB;
            PB = sA * PB1 + sB; PA = sA * PA1; }
        if (hi == 0) { SUM[(tb * 64 + 32 * cb + cl) * 2] = PA; SUM[(tb * 64 + 32 * cb + cl) * 2 + 1] = PB; }
        LDS_WAIT(); __builtin_amdgcn_s_barrier(); asm volatile("" ::: "memory");
        float hin = hstate, hnew = hstate;
#pragma unroll
        for (int t = 0; t < 4; ++t) { const float A = SUM[(t * 64 + 32 * cb + cl) * 2], B = SUM[(t * 64 + 32 * cb + cl) * 2 + 1];
            hnew = A * hnew + B; if (t < tb) hin = hnew; if (!OUT) astate *= A; }
        hstate = hnew;
        if (OUT) {
#pragma unroll
            for (int sg = 0; sg < 4; ++sg) { float hc = preA[sg] * hin + preB[sg];
#pragma unroll
                for (int e = 0; e < 4; ++e) { hc = av[4 * sg + e] * hc + bv[4 * sg + e]; const int tk_ = 32 * tb + 8 * sg + 4 * hi + e; HST[tk_ * 64 + 4 * (((32 * cb + cl) >> 2) ^ (tk_ & 15)) + (cl & 3)] = hc; } }
            LDS_WAIT(); __builtin_amdgcn_s_barrier(); asm volatile("" ::: "memory");
            f32x4 hv[4];
#pragma unroll
            for (int q = 0; q < 4; ++q) hv[q] = *(const LAS f32x4*)(HST + tl * 64 + 4 * ((4 * cg + q) ^ (tl & 15)));
            v4u o0, o1;
            o0.x = pk2(hv[0][0] * bflo(gy0.x), hv[0][1] * bfhi(gy0.x)); o0.y = pk2(hv[0][2] * bflo(gy0.y), hv[0][3] * bfhi(gy0.y));
            o0.z = pk2(hv[1][0] * bflo(gy0.z), hv[1][1] * bfhi(gy0.z)); o0.w = pk2(hv[1][2] * bflo(gy0.w), hv[1][3] * bfhi(gy0.w));
            o1.x = pk2(hv[2][0] * bflo(gy1.x), hv[2][1] * bfhi(gy1.x)); o1.y = pk2(hv[2][2] * bflo(gy1.y), hv[2][3] * bfhi(gy1.y));
            o1.z = pk2(hv[3][0] * bflo(gy1.z), hv[3][1] * bfhi(gy1.z)); o1.w = pk2(hv[3][2] * bflo(gy1.w), hv[3][3] * bfhi(gy1.w));
            v4u* op = (v4u*)(HRG + (R0 + tl) * DM + ch0 + 16 * cg); op[0] = o0; op[1] = o1;
            if (comb_base >= 0) { comb_finish(P, cit, cb0); comb_finish(P, cit + 512, cb1); }
        }
    }
    if (tb == 0 && hi == 0) {
        float* T = WSP(float, WS_TAB) + b * 1024 + mych;
        if (!OUT) { T[TAB_SA] = astate; T[TAB_SB] = hstate; }
        else if (rg == 0) T[TAB_HC] = hstate;
        else if (rg == 2) P.out[pg8::O_LRUP + (size_t)b * 1024 + mych] = hstate;
    }
    __syncthreads();
}

__device__ __forceinline__ void lru_sample(const Ptrs& P, int gt) {
    const int b = gt >> 10, ch = gt & 1023, n = ch >> 6, o = ch & 63;
    const float* XBS = WSP(float, WS_XBS); const float* sc = P.in[7] + (size_t)b * 3 * 1024; const float* wcv = P.in[15]; const float* bcv = P.in[16];
    float za[4] = {0.f, 0.f, 0.f, 0.f}, zi[4] = {0.f, 0.f, 0.f, 0.f}, xo[4] = {0.f, 0.f, 0.f, 0.f};
    for (int i = 0; i < 64; ++i) { const int c = 64 * n + i;
        float xcat[7];
#pragma unroll
        for (int k = 0; k < 3; ++k) xcat[k] = sc[k * 1024 + c];
#pragma unroll
        for (int k = 0; k < 4; ++k) xcat[3 + k] = XBS[(size_t)(4 * b + k) * 1024 + c];
        const float w0 = wcv[c], w1 = wcv[1024 + c], w2 = wcv[2048 + c], w3 = wcv[3072 + c], bc = bcv[c];
        const float wa = P.in[17][(n * 64 + i) * 64 + o], wi = P.in[19][(n * 64 + i) * 64 + o];
#pragma unroll
        for (int t = 0; t < 4; ++t) { const float xc = bc + w0 * xcat[t] + w1 * xcat[t + 1] + w2 * xcat[t + 2] + w3 * xcat[t + 3];
            za[t] += xc * wa; zi[t] += xc * wi; xo[t] = (i == o) ? xc : xo[t]; } }
    const float ba = P.in[18][ch], bi = P.in[20][ch], c8l = WSP(float, WS_TAB)[2048 + ch] * 1.4426950408889634f;
    float h = P.in[8][(size_t)b * 1024 + ch];
    const bf16* GY = WSP(bf16, WS_GY); bf16* HRG = WSP(bf16, WS_HRG);
#pragma unroll
    for (int t = 0; t < 4; ++t) { const float r = sigm(za[t] + ba), ig = sigm(zi[t] + bi), a = fexp2(c8l * r);
        h = a * h + sqrtf(fmaxf(1.0f - a * a, 0.f)) * (ig * xo[t]);
        const size_t idx = (size_t)(MP + 4 * b + t) * DM + ch;
        HRG[idx] = (bf16)f2bf(h * __uint_as_float((unsigned)GY[idx] << 16)); }
    P.out[pg8::O_LRUS + (size_t)b * 1024 + ch] = h;
}

enum { SG_AMIX = 0, SG_MIX = 1, SG_X1 = 2, SG_UP = 3, SG_X2 = 4, SG_PE = 5, SG_Y = 6 };
constexpr size_t TAB_SSS1 = 32768, TAB_SSS2 = 40960;
template <int MODE, int N, int K> __device__ __forceinline__ void sgemm_tile(const Ptrs& P, LAS unsigned char* lds, int tile, const bf16* A, const bf16* Bt, int tid, int lane, int w) {
    constexpr int NTC = N / 64, NKS = K / 128;
    const int tr = tile / NTC, tc = tile % NTC, s0 = 32 * tr, c0 = 64 * tc;
    const int r = lane & 31, h = lane >> 5;
    const bf16* ap = A + (size_t)(MP + s0 + r) * K + w * (K / 8) + 8 * h;
    const bf16* bp0 = Bt + (size_t)(c0 + r) * K + w * (K / 8) + 8 * h; const bf16* bp1 = bp0 + (size_t)32 * K;
    f32x16 acc0, acc1;
#pragma unroll
    for (int i = 0; i < 16; ++i) { acc0[i] = 0.f; acc1[i] = 0.f; }
#pragma unroll 4
    for (int ks = 0; ks < NKS; ++ks) { const bf16x8 a = *(const bf16x8*)(ap + 16 * ks), b0 = *(const bf16x8*)(bp0 + 16 * ks), b1 = *(const bf16x8*)(bp1 + 16 * ks);
        acc0 = __builtin_amdgcn_mfma_f32_32x32x16_bf16(a, b0, acc0, 0, 0, 0); acc1 = __builtin_amdgcn_mfma_f32_32x32x16_bf16(a, b1, acc1, 0, 0, 0); }
    LAS float* PART = (LAS float*)lds;
#pragma unroll
    for (int i = 0; i < 16; ++i) { const int row = crow(i, h); PART[(w * 32 + row) * 64 + r] = acc0[i]; PART[(w * 32 + row) * 64 + 32 + r] = acc1[i]; }
    LDS_WAIT(); __syncthreads();
    const int row = tid >> 4, c4 = (tid & 15) * 4;
    f32x4 v = (f32x4){0.f, 0.f, 0.f, 0.f};
#pragma unroll
    for (int k = 0; k < 8; ++k) v += *(const LAS f32x4*)(PART + (k * 32 + row) * 64 + c4);
    const int s = s0 + row, col = c0 + c4; const size_t R = (size_t)MP + s; const size_t idx = R * DM + col;
    float* TAB = WSP(float, WS_TAB);
    if (MODE == SG_AMIX) { const v2u g = *(const v2u*)(WSP(bf16, WS_SGA) + idx); v2u o; o.x = pk2(bflo(g.x) * v[0], bfhi(g.x) * v[1]); o.y = pk2(bflo(g.y) * v[2], bfhi(g.y) * v[3]); *(v2u*)(WSP(bf16, WS_AMIX) + idx) = o; }
    else if (MODE == SG_MIX) { const v2u g = *(const v2u*)(WSP(bf16, WS_SGB) + idx), m = *(const v2u*)(WSP(bf16, WS_AMIX) + idx); v2u o;
        o.x = pk2(bflo(m.x) + bflo(g.x) * v[0], bfhi(m.x) + bfhi(g.x) * v[1]); o.y = pk2(bflo(m.y) + bflo(g.y) * v[2], bfhi(m.y) + bfhi(g.y) * v[3]); *(v2u*)(WSP(bf16, WS_MIX) + idx) = o; }
    else if (MODE == SG_X1 || MODE == SG_X2) { f32x4 x;
        if (MODE == SG_X1) x = *(const f32x4*)(P.in[1] + (size_t)s * DM + col); else { const v2u m = *(const v2u*)(WSP(bf16, WS_X1B) + idx); x = (f32x4){bflo(m.x), bfhi(m.x), bflo(m.y), bfhi(m.y)}; }
        const f32x4 y = x + v; v2u o; o.x = pk2(y[0], y[1]); o.y = pk2(y[2], y[3]); *(v2u*)(WSP(bf16, MODE == SG_X1 ? WS_X1B : WS_X2B) + idx) = o;
        float ss = (y[0] * y[0] + y[1] * y[1]) + (y[2] * y[2] + y[3] * y[3]); ss += __shfl_xor(ss, 1); ss += __shfl_xor(ss, 2); ss += __shfl_xor(ss, 4); ss += __shfl_xor(ss, 8);
        if ((tid & 15) == 0) TAB[(MODE == SG_X1 ? TAB_SSS1 : TAB_SSS2) + s * 16 + tc] = ss; }
    else if (MODE == SG_PE) { v2u o; o.x = pk2(v[0], v[1]); o.y = pk2(v[2], v[3]); *(v2u*)(WSP(bf16, WS_PEP) + idx) = o; }
    else { const f32x4* q = (const f32x4*)(TAB + (MODE == SG_UP ? TAB_SSS1 : TAB_SSS2) + s * 16); const f32x4 q0 = q[0], q1 = q[1], q2 = q[2], q3 = q[3];
        const float tot = ((q0[0] + q0[1]) + (q0[2] + q0[3])) + ((q1[0] + q1[1]) + (q1[2] + q1[3])) + ((q2[0] + q2[1]) + (q2[2] + q2[3])) + ((q3[0] + q3[1]) + (q3[2] + q3[3]));
        const float rs = 1.0f / sqrtf(tot * (1.0f / 1024.0f) + 1e-6f);
        if (MODE == SG_UP) { v2u o; float u0 = fmaxf(v[0] * rs, 0.f), u1 = fmaxf(v[1] * rs, 0.f), u2 = fmaxf(v[2] * rs, 0.f), u3 = fmaxf(v[3] * rs, 0.f);
            o.x = pk2(u0 * u0, u1 * u1); o.y = pk2(u2 * u2, u3 * u3); *(v2u*)(WSP(bf16, WS_U) + R * FF + col) = o; }
        else { const v2u m = *(const v2u*)(WSP(bf16, WS_X2B) + idx), pe = *(const v2u*)(WSP(bf16, WS_PEP) + idx);
            f32x4 y; y[0] = bflo(m.x) + sigm(v[0] * rs) * bflo(pe.x); y[1] = bfhi(m.x) + sigm(v[1] * rs) * bfhi(pe.x); y[2] = bflo(m.y) + sigm(v[2] * rs) * bflo(pe.y); y[3] = bfhi(m.y) + sigm(v[3] * rs) * bfhi(pe.y);
            *(f32x4*)(P.out + idx) = y; } }
    __syncthreads();
}
#if defined(PROBE_DUP)
#define MK_PROBE_BITS(s) ((s) & 24)
#else
#define MK_PROBE_BITS(s) 0
#endif
__device__ __forceinline__ int opq_s(int v) { v = __builtin_amdgcn_readfirstlane(v); asm volatile("" : "+s"(v)); return v; }
struct Args { const float* in[30]; float* out; unsigned char* ws; int ph_lo, ph_hi, li, sub; };
__global__ void __launch_bounds__(NWAVES * 64, 2) fwd_kernel(Args args) {
    extern __shared__ __attribute__((aligned(16))) unsigned char lds_raw[];
    LAS unsigned char* lds = (LAS unsigned char*)lds_raw;
    volatile LAS unsigned* MISC = (volatile LAS unsigned*)(lds + MISC_OFF);
    const int tid0 = threadIdx.x; const int wave0 = __builtin_amdgcn_readfirstlane(tid0 >> 6);
    const int G = gridDim.x, bx = blockIdx.x; const int vcu = (G % 8 == 0) ? (bx % 8) * (G / 8) + bx / 8 : bx;
    typedef __attribute__((address_space(4))) const Args* KArgs;
    KArgs ap0 = (KArgs)__builtin_amdgcn_kernarg_segment_ptr();
    gu32* ctl = (gu32*)(args.ws + WS_CTL);
    for (int u = tid0; u < 32; u += NWAVES * 64) MISC[u] = 0u;
    __syncthreads();
    XcdBarrier bar; bar.bar = (unsigned*)(ctl + CW_BAR) + args.li * XCD_BAR_WORDS; bar.x = 0; bar.st = nullptr;
    if (N_LAUNCHES != PER_PHASE) bar = xcd_barrier_post((unsigned*)(ctl + CW_BAR) + args.li * XCD_BAR_WORDS, MISC + 8);
#define GRID_BAR() do { if (N_LAUNCHES != PER_PHASE) xcd_barrier(bar); } while (0)
    const int lo = args.ph_lo, hi = args.ph_hi, sub = args.sub;
#ifndef PH_MASK
#define PH_MASK 0x1ff
#endif
#define IN(k) (((PH_MASK >> (k)) & 1) && lo <= (k) && (k) < hi)
#define BOTH(k) (IN(k) && IN((k) + 1))
    LAS float* XCH = (LAS float*)(lds + XCH_OFF);
    const int NT = G * NWAVES * 64;

#define LOAD_P() KArgs ap = ap0; asm volatile("" : "+s"(ap)); Ptrs P; _Pragma("unroll") for (int i_ = 0; i_ < 30; ++i_) P.in[i_] = ap->in[i_]; P.out = ap->out; P.ws = ap->ws
#define OPAQUE_TID2() int tid; asm volatile("v_mbcnt_lo_u32_b32 %0, -1, 0\n\tv_mbcnt_hi_u32_b32 %0, -1, %0" : "=v"(tid)); tid |= wave0 << 6; const int lane = tid & 63, wave = wave0
#define OPAQUE_TID() LOAD_P(); int tid; asm volatile("v_mbcnt_lo_u32_b32 %0, -1, 0\n\tv_mbcnt_hi_u32_b32 %0, -1, %0" : "=v"(tid)); tid |= wave0 << 6; const int lane = tid & 63, wave = wave0; const int gt = vcu * (NWAVES * 64) + tid
    if (IN(0)) { OPAQUE_TID(); p0_prologue(P, lds, tid, lane, wave, vcu, G); if (BOTH(0)) GRID_BAR(); }

    if (IN(1)) {
        LOAD_P();
        pg8::Gemm g{WSP(pg8::bf16_t, WS_HB), WSP(pg8::bf16_t, WS_WIN), M, NIN, DM}; pg8::StaticOrder S; S.init(M, NIN, G, opq_s(blockIdx.x));
        pg8::Epi1 E{P.ws, P.out, P.in[12], P.in[13], XCH, MK_PROBE_BITS(sub)};
        pg8::gemm_phase<pg8::Epi1, pg8::StaticOrder, true, true>(lds + RING_OFF, g, S, E, wave0);
        if (BOTH(1)) GRID_BAR();
    }

    if (IN(2)) {
        OPAQUE_TID();
        { const float* TAB = WSP(float, WS_TAB); for (int e = tid; e < 12 * 132; e += NWAVES * 64) XCH[e] = TAB[e]; }
        LDS_WAIT(); __syncthreads();
#define TASK_LOOP(QI, NTASK, BODY) { gu32* qw = ctl + CW_Q + 64 * (4 * args.li + (QI)); volatile LAS unsigned* QT = MISC + 16; unsigned nxt = 0u; \
          if (tid == 0) nxt = __hip_atomic_fetch_add(qw, 1u, RLX_AGENT); \
          for (;;) { if (tid == 0) QT[0] = nxt; LDS_WAIT(); __syncthreads(); const int task = (int)__builtin_amdgcn_readfirstlane(QT[0]); __syncthreads(); if (task >= (NTASK)) break; \
              if (tid == 0) nxt = __hip_atomic_fetch_add(qw, 1u, RLX_AGENT); BODY } }
        if (sub & 1) TASK_LOOP(0, 128, lru_unit<true>(P, lds, task >> 4, task & 15, 0, tid, lane, wave);)
        if (sub & 1) TASK_LOOP(3, 128, lru_unit<false>(P, lds, task >> 4, task & 15, 1, tid, lane, wave);)
        if (sub & 2) TASK_LOOP(1, 512, sattn_unit(P, lds, task, tid, lane, wave);)
        if (sub & 4) TASK_LOOP(2, 1536, attn_run(P, lds, 4 * task, 4, tid, lane, wave);)
#undef TASK_LOOP
        if (BOTH(2)) GRID_BAR();
    }

    if (IN(3)) {
        OPAQUE_TID();
        if (sub & 1) for (int u = vcu; u < 256; u += G) lru_unit<true>(P, lds, u >> 5, (u >> 1) & 15, 1 + (u & 1), tid, lane, wave, 16 * u);
        if (sub & 2) for (int t = gt; t < DBATCH * 1024; t += NT) lru_sample(P, t);
        if (BOTH(3)) GRID_BAR();
    }

    if (IN(4)) {
        LOAD_P();
        { OPAQUE_TID2();
          for (int t = vcu; t < 256; t += G) sgemm_tile<SG_AMIX, DM, MW>(P, lds, t, WSP(bf16, WS_ATT), WSP(bf16, WS_WOA), tid, lane, wave);
          for (int t = vcu; t < 256; t += G) sgemm_tile<SG_MIX, DM, DM>(P, lds, t, WSP(bf16, WS_HRG), WSP(bf16, WS_WOB), tid, lane, wave); }
        { pg8::Gemm g{WSP(pg8::bf16_t, WS_ATT), WSP(pg8::bf16_t, WS_WOA), MP, DM, MW}; pg8::StaticOrder S; S.init(MP, DM, G, opq_s(blockIdx.x));
          pg8::Epi2<pg8::E_AMIX> E{WSP(pg8::bf16_t, WS_SGA), nullptr, WSP(pg8::bf16_t, WS_AMIX), nullptr, nullptr, nullptr, nullptr, nullptr, XCH, 0};
          pg8::gemm_phase<pg8::Epi2<pg8::E_AMIX>, pg8::StaticOrder, true, true>(lds + RING_OFF, g, S, E, wave0); }
        VM_WAIT(); __syncthreads();
        { pg8::Gemm g{WSP(pg8::bf16_t, WS_HRG), WSP(pg8::bf16_t, WS_WOB), MP, DM, DM}; pg8::StaticOrder S; S.init(MP, DM, G, opq_s(blockIdx.x));
          pg8::Epi2<pg8::E_MIX> E{WSP(pg8::bf16_t, WS_SGB), WSP(pg8::bf16_t, WS_AMIX), WSP(pg8::bf16_t, WS_MIX), nullptr, nullptr, nullptr, nullptr, nullptr, XCH, 0};
          pg8::gemm_phase<pg8::Epi2<pg8::E_MIX>, pg8::StaticOrder, true, true>(lds + RING_OFF, g, S, E, wave0); }
        if (BOTH(4)) GRID_BAR();
    }

    if (IN(5)) {
        LOAD_P();
        { OPAQUE_TID2(); for (int t = vcu; t < 256; t += G) sgemm_tile<SG_X1, DM, DM>(P, lds, t, WSP(bf16, WS_MIX), WSP(bf16, WS_WO), tid, lane, wave); }
        pg8::Gemm g{WSP(pg8::bf16_t, WS_MIX), WSP(pg8::bf16_t, WS_WO), MP, DM, DM}; pg8::StaticOrder S; S.init(MP, DM, G, opq_s(blockIdx.x));
        pg8::Epi2<pg8::E_X1> E{nullptr, nullptr, WSP(pg8::bf16_t, WS_X1B), nullptr, P.in[0], P.in[1], WSP(float, WS_SS1), nullptr, XCH, 0};
        pg8::gemm_phase<pg8::Epi2<pg8::E_X1>, pg8::StaticOrder, true, true>(lds + RING_OFF, g, S, E, wave0);
        if (BOTH(5)) GRID_BAR();
    }

    if (IN(6)) {
        LOAD_P();
        { OPAQUE_TID2(); for (int t = vcu; t < 1024; t += G) sgemm_tile<SG_UP, FF, DM>(P, lds, t, WSP(bf16, WS_X1B), WSP(bf16, WS_WUP), tid, lane, wave); }
        pg8::Gemm g{WSP(pg8::bf16_t, WS_X1B), WSP(pg8::bf16_t, WS_WUP), MP, FF, DM}; pg8::StaticOrder S; S.init(MP, FF, G, opq_s(blockIdx.x));
        pg8::Epi2<pg8::E_UP> E{nullptr, nullptr, WSP(pg8::bf16_t, WS_U), nullptr, nullptr, nullptr, nullptr, WSP(float, WS_SS1), XCH, MK_PROBE_BITS(sub)};
        pg8::gemm_phase<pg8::Epi2<pg8::E_UP>, pg8::StaticOrder, true, true>(lds + RING_OFF, g, S, E, wave0);
        if (BOTH(6)) GRID_BAR();
    }

    if (IN(7)) {
        LOAD_P();
        { OPAQUE_TID2(); for (int t = vcu; t < 256; t += G) sgemm_tile<SG_X2, DM, FF>(P, lds, t, WSP(bf16, WS_U), WSP(bf16, WS_WDN), tid, lane, wave); }
        pg8::Gemm g{WSP(pg8::bf16_t, WS_U), WSP(pg8::bf16_t, WS_WDN), MP, DM, FF}; pg8::StaticOrder S; S.init(MP, DM, G, opq_s(blockIdx.x));
        pg8::Epi2<pg8::E_X2> E{WSP(pg8::bf16_t, WS_X1B), nullptr, WSP(pg8::bf16_t, WS_X2B), nullptr, nullptr, nullptr, WSP(float, WS_SS2), nullptr, XCH, 0};
        pg8::gemm_phase<pg8::Epi2<pg8::E_X2>, pg8::StaticOrder, true, true>(lds + RING_OFF, g, S, E, wave0);
        if (BOTH(7)) GRID_BAR();
    }

    if (IN(8)) {
        LOAD_P();
        { OPAQUE_TID2();
          for (int t = vcu; t < 256; t += G) sgemm_tile<SG_PE, DM, PLE>(P, lds, t, WSP(bf16, WS_PB), WSP(bf16, WS_WPE), tid, lane, wave);
          for (int t = vcu; t < 256; t += G) sgemm_tile<SG_Y, DM, DM>(P, lds, t, WSP(bf16, WS_X2B), WSP(bf16, WS_WPG), tid, lane, wave); }
        { pg8::Gemm g{WSP(pg8::bf16_t, WS_PB), WSP(pg8::bf16_t, WS_WPE), MP, DM, PLE}; pg8::StaticOrder S; S.init(MP, DM, G, opq_s(blockIdx.x));
          pg8::Epi2<pg8::E_PE> E{nullptr, nullptr, WSP(pg8::bf16_t, WS_PEP), nullptr, nullptr, nullptr, nullptr, nullptr, XCH, 0};
          pg8::gemm_phase<pg8::Epi2<pg8::E_PE>, pg8::StaticOrder, true, true>(lds + RING_OFF, g, S, E, wave0); }
        VM_WAIT(); __syncthreads();
        { pg8::Gemm g{WSP(pg8::bf16_t, WS_X2B), WSP(pg8::bf16_t, WS_WPG), MP, DM, DM}; pg8::StaticOrder S; S.init(MP, DM, G, opq_s(blockIdx.x));
          pg8::Epi2<pg8::E_Y> E{WSP(pg8::bf16_t, WS_PEP), WSP(pg8::bf16_t, WS_X2B), nullptr, P.out, nullptr, nullptr, nullptr, WSP(float, WS_SS2), XCH, 0};
          pg8::gemm_phase<pg8::Epi2<pg8::E_Y>, pg8::StaticOrder, true, true>(lds + RING_OFF, g, S, E, wave0); }
    }
#undef IN
#undef BOTH
#undef GRID_BAR
}

extern "C" void kernel_launch(void* const* d_in, const int* in_sizes, int n_in, void* d_out, int out_size, void* d_ws, size_t ws_size, hipStream_t stream) {
    static int grid = 0;
    if (grid == 0) {
        if (n_in != 30 || in_sizes[0] != MP * DM || out_size != (int)pg8::O_END || ws_size < WS_END) {
            fprintf(stderr, "kernel_launch: unexpected shapes (n_in %d, in0 %d, out %d, ws %zu, need %zu); nothing launched\n", n_in, n_in > 0 ? in_sizes[0] : -1, out_size, ws_size, (size_t)WS_END); grid = -1; return; }
        int dev = 0, cus = 0, per_cu = 0;
        if (hipGetDevice(&dev) != hipSuccess || hipDeviceGetAttribute(&cus, hipDeviceAttributeMultiprocessorCount, dev) != hipSuccess) { grid = -1; return; }
        if (hipFuncSetAttribute((const void*)fwd_kernel, hipFuncAttributeMaxDynamicSharedMemorySize, LDS_BYTES) != hipSuccess) { fprintf(stderr, "kernel_launch: hipFuncSetAttribute failed\n"); grid = -1; return; }
        if (hipOccupancyMaxActiveBlocksPerMultiprocessor(&per_cu, (const void*)fwd_kernel, NWAVES * 64, LDS_BYTES) != hipSuccess || per_cu < 1)
            fprintf(stderr, "kernel_launch: note: occupancy query reports %d workgroups per CU\n", per_cu);
        (void)hipGetLastError();
        grid = cus;
    }
    if (grid < 0) return;
    if (hipMemsetAsync((char*)d_ws + WS_CTL, 0, CTL_ZERO_BYTES, stream) != hipSuccess) { fprintf(stderr, "kernel_launch: hipMemsetAsync failed\n"); return; }
    Args a{};
    for (int i = 0; i < 30; ++i) a.in[i] = (const float*)d_in[i];
    a.out = (float*)d_out; a.ws = (unsigned char*)d_ws;
#if defined(PROBE_DUP)
    const int cut[4] = {0, PROBE_DUP + 1, PROBE_DUP + 1, PER_PHASE};
    for (int li = 0; li < 3; ++li) {
        a.ph_lo = (li == 1) ? PROBE_DUP : cut[li]; a.ph_hi = (li == 1) ? PROBE_DUP + 1 : cut[li + 1]; a.li = li; a.sub = (li == 1) ? PROBE_SUB : 7;
        if (a.ph_lo >= a.ph_hi) continue;
        hipLaunchKernelGGL(fwd_kernel, dim3(grid), dim3(NWAVES * 64), LDS_BYTES, stream, a);
    }
#else
    for (int li = 0; li < N_LAUNCHES; ++li) {
        a.ph_lo = (N_LAUNCHES == PER_PHASE) ? li : 0; a.ph_hi = (N_LAUNCHES == PER_PHASE) ? li + 1 : PER_PHASE; a.li = (N_LAUNCHES == PER_PHASE) ? 0 : li; a.sub = 7;
        hipLaunchKernelGGL(fwd_kernel, dim3(grid), dim3(NWAVES * 64), LDS_BYTES, stream, a);
        const hipError_t le = hipPeekAtLastError();
        if (le != hipSuccess) { fprintf(stderr, "kernel_launch: launch %d failed: %s\n", li, hipGetErrorName(le)); break; }
    }
#endif
}
```

```cpp
#include <hip/hip_runtime.h>
#include <cstdio>
#include <cstdint>
#include <cmath>
#define MK_N_LAUNCHES 1

constexpr int NWAVES = 8;
#ifndef MK_N_LAUNCHES
#define MK_N_LAUNCHES 1
#endif
constexpr int N_LAUNCHES = MK_N_LAUNCHES;
constexpr int PER_PHASE = 9;

constexpr int DM = 1024, NBATCH = 8, SEQ = 8192, DBATCH = 128, DSEQ = 4;
constexpr int MP = NBATCH * SEQ, MS = DBATCH * DSEQ, M = MP + MS;
constexpr int NIN = 8704, FF = 4096, PLE = 256, AW = 1536, MW = 512;
static_assert(M % 256 == 0 && NIN % 256 == 0, "tile shapes");

constexpr size_t MiB = 1u << 20;
constexpr size_t al(size_t x) { return (x + MiB - 1) / MiB * MiB; }
constexpr size_t WS_CTL = 0, CTL_ZERO_BYTES = 1 * MiB;
constexpr size_t WS_WIN = 1 * MiB;
constexpr size_t WS_WOA = WS_WIN + al((size_t)NIN * DM * 2);
constexpr size_t WS_WOB = WS_WOA + al((size_t)DM * MW * 2);
constexpr size_t WS_WO = WS_WOB + al((size_t)DM * DM * 2);
constexpr size_t WS_WUP = WS_WO + al((size_t)DM * DM * 2);
constexpr size_t WS_WDN = WS_WUP + al((size_t)FF * DM * 2);
constexpr size_t WS_WPG = WS_WDN + al((size_t)FF * DM * 2);
constexpr size_t WS_WPE = WS_WPG + al((size_t)DM * DM * 2);
constexpr size_t WS_WRG = WS_WPE + al((size_t)DM * PLE * 2);
constexpr size_t WS_TAB = WS_WRG + MiB;
constexpr size_t WS_HB = WS_TAB + MiB;
constexpr size_t ACT = al((size_t)M * DM * 2);
constexpr size_t WS_Q = WS_HB + ACT;
constexpr size_t QKV = (size_t)MP * AW * 2;
constexpr size_t WS_K = WS_Q + QKV, WS_V = WS_K + QKV;
constexpr size_t WS_XB = WS_V + QKV, WS_GY = WS_XB + ACT, WS_SGA = WS_GY + ACT, WS_SGB = WS_SGA + ACT;
constexpr size_t WS_QS = WS_SGB + ACT;
constexpr size_t WS_XBS = WS_QS + al((size_t)MS * AW * 4);
constexpr size_t WS_OG = WS_XBS + al((size_t)MS * DM * 4);
constexpr size_t WS_LSE = WS_OG + al((size_t)3 * MP * MW * 2);
constexpr size_t WS_ATT = WS_LSE + al((size_t)3 * MP * 4 * 4);
constexpr size_t WS_HRG = WS_ATT + al((size_t)M * MW * 2);
constexpr size_t WS_AMIX = WS_HRG + ACT, WS_MIX = WS_AMIX + ACT, WS_X1B = WS_MIX + ACT, WS_X2B = WS_X1B + ACT;
constexpr size_t WS_U = WS_X2B + ACT;
constexpr size_t WS_PB = WS_U + al((size_t)M * FF * 2);
constexpr size_t WS_PEP = WS_PB + al((size_t)M * PLE * 2);
constexpr size_t WS_SS1 = WS_PEP + ACT;
constexpr size_t WS_SS2 = WS_SS1 + al((size_t)M * 4 * 4);
constexpr size_t WS_DUMP = WS_SS2 + al((size_t)M * 4 * 4);
constexpr size_t WS_END = WS_DUMP + 32 * MiB;
constexpr int CW_Q = 16384;
constexpr int CW_BAR = 4096;

constexpr int RING_OFF = 0, RING_BYTES = 131072;
constexpr int XCH_OFF = 131072;
constexpr int MISC_OFF = 139264;
constexpr int LDS_BYTES = 147456;

#define GAS __attribute__((address_space(1)))
#define LAS __attribute__((address_space(3)))
typedef unsigned short bf16;
typedef unsigned v4u __attribute__((ext_vector_type(4)));
typedef unsigned v2u __attribute__((ext_vector_type(2)));
typedef float f32x4 __attribute__((ext_vector_type(4)));
typedef float f32x16 __attribute__((ext_vector_type(16)));
typedef short bf16x8 __attribute__((ext_vector_type(8)));
typedef short s16x4 __attribute__((ext_vector_type(4)));
typedef GAS unsigned gu32;
#define RLX_AGENT __ATOMIC_RELAXED, __HIP_MEMORY_SCOPE_AGENT
#define LDS_WAIT() asm volatile("s_waitcnt lgkmcnt(0)" ::: "memory")
#define VM_WAIT() asm volatile("s_waitcnt vmcnt(0)" ::: "memory")
__device__ __forceinline__ unsigned f2bf(float f) { unsigned u = __builtin_bit_cast(unsigned, f); return (u + 0x7fffu + ((u >> 16) & 1u)) >> 16; }
typedef float f32x2_t __attribute__((ext_vector_type(2))); typedef __bf16 bf16x2_t __attribute__((ext_vector_type(2)));
__device__ __forceinline__ unsigned pk2(float lo, float hi) { f32x2_t v = {lo, hi}; bf16x2_t b = __builtin_convertvector(v, bf16x2_t); return __builtin_bit_cast(unsigned, b); }
__device__ __forceinline__ float bflo(unsigned w) { return __uint_as_float(w << 16); }
__device__ __forceinline__ float bfhi(unsigned w) { return __uint_as_float(w & 0xffff0000u); }
__device__ __forceinline__ float fexp2(float x) { return __builtin_amdgcn_exp2f(x); }
__device__ __forceinline__ float frcp(float x) { return __builtin_amdgcn_rcpf(x); }
__device__ __forceinline__ float sigm(float x) { return frcp(1.0f + fexp2(-1.4426950408889634f * x)); }
namespace pg8 {
#define PG8_LAS __attribute__((address_space(3)))
typedef unsigned short bf16_t;
typedef short bf16x8 __attribute__((ext_vector_type(8)));
typedef float f32x4 __attribute__((ext_vector_type(4)));
typedef unsigned u32x4 __attribute__((ext_vector_type(4)));
constexpr int BM = 256, BK = 64, HALF = 128, HTB = HALF * BK * 2  , STAGE_BYTES = 8 * HTB, NXCD = 8, WGM = 4;

__host__ __device__ __forceinline__ int lds_byte(int r, int c) { const int st = (r >> 4) * 2 + (c >> 5), rr = r & 15, cc = c & 31, ob = rr * 64 + cc * 2; return st * 1024 + (ob ^ (((ob >> 9) & 1) << 5)); }
__host__ __device__ __forceinline__ void stage_rc(int b, int& R, int& C) { const int st = b / 1024, sb = b % 1024, swz = sb ^ (((sb >> 9) & 1) << 5); R = (st >> 1) * 16 + swz / 64; C = (st & 1) * 32 + (swz % 64) / 2; }
__host__ __device__ __forceinline__ int perm32(int rho) { const int n = rho >> 4, i = rho & 15; return 8 * (i >> 2) + 4 * n + (i & 3); }

struct Unit { int pm, pn; };
struct Gemm { const bf16_t* A; const bf16_t* Bt; int M, N, K; };

struct StaticOrder {
    int nM, nN, nwg, G, c;
    __host__ __device__ void init(int M, int N, int G_, int c_) { nM = M / BM; nN = N / BM; nwg = nM * nN; G = G_; c = c_; }
    __host__ __device__ bool next(int i, Unit& u) const {
        const long L = (long)i * G + c; if (L >= nwg) return false;
        int wgid = (int)L; { const int q = nwg / NXCD, r = nwg % NXCD, xcd = wgid % NXCD, off = wgid / NXCD; wgid = (xcd < r ? xcd * (q + 1) : r * (q + 1) + (xcd - r) * q) + off; }
        const int nig = WGM * nN, gid = wgid / nig, fm = gid * WGM, gsz = (nM - fm) < WGM ? (nM - fm) : WGM;
        u.pm = fm + ((wgid % nig) % gsz); u.pn = (wgid % nig) / gsz; return true;
    }
    __device__ __forceinline__ void a_ready(const Unit&) const {}
    __device__ __forceinline__ void done(const Unit&) const {}
};
__device__ __forceinline__ unsigned cvt_pk_bf16(float lo, float hi) { unsigned r; asm volatile("v_cvt_pk_bf16_f32 %0, %1, %2" : "=v"(r) : "v"(lo), "v"(hi)); return r; }
typedef float f32x2 __attribute__((ext_vector_type(2)));
typedef unsigned u32x2 __attribute__((ext_vector_type(2)));
constexpr float RMS_EPS = 1e-6f;
constexpr float QSCALE = 0.08838834764831845f * 1.4426950408889634f;
constexpr size_t O_YP = 0, O_YS = 67108864, O_KV1P = 67633152, O_KV2P = 68681728, O_KV3P = 72876032, O_CONVP = 89653248, O_LRUP = 89677824,
                 O_KV1S = 89686016, O_KV2S = 90210304, O_KV3S = 90734592, O_CONVS = 91258880, O_LRUS = 91652096, O_END = 91783168;
__device__ __forceinline__ size_t kvp_off(int g) { return g == 0 ? O_KV1P : (g == 1 ? O_KV2P : O_KV3P); }
__device__ __forceinline__ size_t kvs_off(int g) { return g == 0 ? O_KV1S : (g == 1 ? O_KV2S : O_KV3S); }

__device__ __forceinline__ float fsigmoid(float x) { return __builtin_amdgcn_rcpf(1.0f + __builtin_amdgcn_exp2f(-1.4426950408889634f * x)); }
__device__ __forceinline__ float fgelu_tanh(float x) { const float u = x + 0.044715f * x * x * x; return x * __builtin_amdgcn_rcpf(1.0f + __builtin_amdgcn_exp2f(-2.3022082232f * u)); }
__device__ __forceinline__ float bf_lo(unsigned w) { return __uint_as_float(w << 16); }
__device__ __forceinline__ float bf_hi(unsigned w) { return __uint_as_float(w & 0xffff0000u); }
__device__ __forceinline__ u32x4 pack8(const f32x4& a, const f32x4& b) { u32x4 w; w.x = cvt_pk_bf16(a[0], a[1]); w.y = cvt_pk_bf16(a[2], a[3]); w.z = cvt_pk_bf16(b[0], b[1]); w.w = cvt_pk_bf16(b[2], b[3]); return w; }
__device__ __forceinline__ void unpack8(const u32x4& w, f32x4& a, f32x4& b) { a = (f32x4){bf_lo(w.x), bf_hi(w.x), bf_lo(w.y), bf_hi(w.y)}; b = (f32x4){bf_lo(w.z), bf_hi(w.z), bf_lo(w.w), bf_hi(w.w)}; }
__device__ __forceinline__ float sq8(const f32x4& a, const f32x4& b) { return (a[0] * a[0] + a[1] * a[1]) + (a[2] * a[2] + a[3] * a[3]) + (b[0] * b[0] + b[1] * b[1]) + (b[2] * b[2] + b[3] * b[3]); }

__device__ __forceinline__ void rowss_exchange(float (&ss)[2][4][2], PG8_LAS float* P, int wr, int wc, int fr, int fq) {
#pragma unroll
    for (int ai = 0; ai < 2; ++ai)
#pragma unroll
        for (int m = 0; m < 4; ++m)
#pragma unroll
            for (int bj = 0; bj < 2; ++bj) { float s = ss[ai][m][bj]; s += __shfl_xor(s, 16); s += __shfl_xor(s, 32);
                if (fq == 0) P[(ai * HALF + wr * 64 + m * 16 + fr) * 8 + bj * 4 + wc] = s; }
    asm volatile("s_waitcnt lgkmcnt(0)" ::: "memory"); __builtin_amdgcn_s_barrier(); asm volatile("" ::: "memory");
#pragma unroll
    for (int ai = 0; ai < 2; ++ai)
#pragma unroll
        for (int m = 0; m < 4; ++m) { const PG8_LAS f32x4* p = (const PG8_LAS f32x4*)(P + (ai * HALF + wr * 64 + m * 16 + fr) * 8);
            const f32x4 a = p[0], b = p[1]; ss[ai][m][0] = (a[0] + a[1]) + (a[2] + a[3]); ss[ai][m][1] = (b[0] + b[1]) + (b[2] + b[3]); }
}

struct Epi1 {
    static constexpr bool PERM = true, AFTER_DRAIN = false; static constexpr int NST = 16;
    unsigned char* ws; float* out; const float *gq, *gk; PG8_LAS float* P; int probe;
    __device__ __forceinline__ void operator()(const f32x4 (&acc)[2][2][4][2], const Unit& u, int wr, int wc, int fr, int fq) const {
        if (probe & 16) return;
        const int pn = u.pn; const bool sample = u.pm >= 256;
        asm volatile("" : "+v"(fr), "+v"(fq));
        const int colw = wc * 32 + fq * 8;
        const int row0 = u.pm * BM + wr * 64 + fr;
        if (pn < 12) {
            const bool isq = pn < 6; const int hbase = 2 * (isq ? pn : pn - 6);
            float ss[2][4][2];
#pragma unroll
            for (int ai = 0; ai < 2; ++ai)
#pragma unroll
                for (int m = 0; m < 4; ++m)
#pragma unroll
                    for (int bj = 0; bj < 2; ++bj) ss[ai][m][bj] = sq8(acc[ai][bj][m][0], acc[ai][bj][m][1]);
            rowss_exchange(ss, P, wr, wc, fr, fq);
            const f32x4 gq0 = *(const f32x4*)(gq + colw), gq1 = *(const f32x4*)(gq + colw + 4), gk0 = *(const f32x4*)(gk + colw), gk1 = *(const f32x4*)(gk + colw + 4);
            f32x4 g0, g1;
#pragma unroll
            for (int e = 0; e < 4; ++e) { g0[e] = isq ? gq0[e] * QSCALE : gk0[e]; g1[e] = isq ? gq1[e] * QSCALE : gk1[e]; }
            bf16_t* const QK = (bf16_t*)(ws + (isq ? WS_Q : WS_K)); float* const QS = (float*)(ws + WS_QS);
#pragma unroll
            for (int ai = 0; ai < 2; ++ai)
#pragma unroll
                for (int m = 0; m < 4; ++m) { const int R = row0 + ai * HALF + m * 16;
#pragma unroll
                    for (int bj = 0; bj < 2; ++bj) { const int hh = hbase + bj, grp = hh >> 2, gsh = 2 * grp;
                        const float rs = __builtin_amdgcn_rsqf(ss[ai][m][bj] * (1.0f / 128.0f) + RMS_EPS);
                        const f32x4 v0 = acc[ai][bj][m][0] * rs * g0, v1 = acc[ai][bj][m][1] * rs * g1;
                        if (!sample) { const int b = R >> 13, t = R & 8191; const int rr = t & ((1 << gsh) - 1), mm = t >> gsh;
                            const size_t rowp = ((size_t)(b * 12 + hh) << 13) + (size_t)(rr << (13 - gsh)) + mm;
                            { const u32x4 w_ = pack8(v0, v1); if (!(probe & 8) || w_.x == 0x7fc17fc1u) *(u32x4*)(QK + rowp * 128 + colw) = w_; }
                            if (!isq) { const int W = 128 << gsh, trel = t - (8192 - W);
                                if (trel >= 0) { float* o = out + kvp_off(grp) + ((((size_t)b * W + trel) * 2 + 0) * 4 + (hh & 3)) * 128 + colw; *(f32x4*)o = v0; *(f32x4*)(o + 4) = v1; } }
                        } else { const int s = R - MP;
                            float* o = isq ? QS + (size_t)s * 1536 + hh * 128 + colw : out + kvs_off(grp) + (((size_t)s * 2 + 0) * 4 + (hh & 3)) * 128 + colw;
                            *(f32x4*)o = v0; *(f32x4*)(o + 4) = v1; } } }
        } else if (pn < 18) {
            const int hbase = 2 * (pn - 12); bf16_t* const V = (bf16_t*)(ws + WS_V);
#pragma unroll
            for (int ai = 0; ai < 2; ++ai)
#pragma unroll
                for (int m = 0; m < 4; ++m) { const int R = row0 + ai * HALF + m * 16;
#pragma unroll
                    for (int bj = 0; bj < 2; ++bj) { const int hh = hbase + bj, grp = hh >> 2, gsh = 2 * grp;
                        const f32x4 v0 = acc[ai][bj][m][0], v1 = acc[ai][bj][m][1];
                        if (!sample) { const int b = R >> 13, t = R & 8191; const int rr = t & ((1 << gsh) - 1), mm = t >> gsh;
                            const size_t rowp = ((size_t)(b * 12 + hh) << 13) + (size_t)(rr << (13 - gsh)) + mm;
                            { const u32x4 w_ = pack8(v0, v1); if (!(probe & 8) || w_.x == 0x7fc17fc1u) *(u32x4*)(V + rowp * 128 + colw) = w_; }
                            const int W = 128 << gsh, trel = t - (8192 - W);
                            if (trel >= 0) { float* o = out + kvp_off(grp) + ((((size_t)b * W + trel) * 2 + 1) * 4 + (hh & 3)) * 128 + colw; *(f32x4*)o = v0; *(f32x4*)(o + 4) = v1; }
                        } else { const int s = R - MP;
                            float* o = out + kvs_off(grp) + (((size_t)s * 2 + 1) * 4 + (hh & 3)) * 128 + colw; *(f32x4*)o = v0; *(f32x4*)(o + 4) = v1; } } }
        } else if (pn < 22) {
            const int cb = (pn - 18) * BM + colw; bf16_t* const XB = (bf16_t*)(ws + WS_XB); float* const XBS = (float*)(ws + WS_XBS);
#pragma unroll
            for (int ai = 0; ai < 2; ++ai)
#pragma unroll
                for (int m = 0; m < 4; ++m) { const int R = row0 + ai * HALF + m * 16;
#pragma unroll
                    for (int bj = 0; bj < 2; ++bj) { const int col = cb + bj * HALF; const f32x4 v0 = acc[ai][bj][m][0], v1 = acc[ai][bj][m][1];
                        if (!sample) { const int b = R >> 13, t = R & 8191;
                            { const u32x4 w_ = pack8(v0, v1); if (!(probe & 8) || w_.x == 0x7fc17fc1u) *(u32x4*)(XB + (size_t)R * 1024 + col) = w_; }
                            if (t >= 8189) { float* o = out + O_CONVP + ((size_t)b * 3 + (t - 8189)) * 1024 + col; *(f32x4*)o = v0; *(f32x4*)(o + 4) = v1; }
                        } else { const int s = R - MP, b = s >> 2, t = s & 3;
                            float* o = XBS + (size_t)s * 1024 + col; *(f32x4*)o = v0; *(f32x4*)(o + 4) = v1;
                            if (t >= 1) { float* o2 = out + O_CONVS + ((size_t)b * 3 + (t - 1)) * 1024 + col; *(f32x4*)o2 = v0; *(f32x4*)(o2 + 4) = v1; } } } }
        } else {
            const int seg = (pn - 22) >> 2; const int cb = ((pn - 22) & 3) * BM + colw; bf16_t* const dst = (bf16_t*)(ws + (seg == 0 ? WS_GY : (seg == 1 ? WS_SGA : WS_SGB)));
#pragma unroll
            for (int ai = 0; ai < 2; ++ai)
#pragma unroll
                for (int m = 0; m < 4; ++m) { const int R = row0 + ai * HALF + m * 16;
#pragma unroll
                    for (int bj = 0; bj < 2; ++bj) { const int col = cb + bj * HALF; f32x4 v0 = acc[ai][bj][m][0], v1 = acc[ai][bj][m][1];
                        if (seg == 0) {
#pragma unroll
                            for (int e = 0; e < 4; ++e) { v0[e] = fgelu_tanh(v0[e]); v1[e] = fgelu_tanh(v1[e]); }
                        } else {
#pragma unroll
                            for (int e = 0; e < 4; ++e) { v0[e] = fsigmoid(v0[e]); v1[e] = fsigmoid(v1[e]); }
                        }
                        { const u32x4 w_ = pack8(v0, v1); if (!(probe & 8) || w_.x == 0x7fc17fc1u) *(u32x4*)(dst + (size_t)R * 1024 + col) = w_; } } }
        }
    }
};

enum { E_AMIX = 0, E_MIX = 1, E_X1 = 2, E_UP = 3, E_X2 = 4, E_PE = 5, E_Y = 6 };
template <int MODE> struct Epi2 {
    static constexpr bool PERM = true, AFTER_DRAIN = false; static constexpr int NST = (MODE == E_Y) ? 32 : 16;
    const bf16_t* g1; const bf16_t* g2; bf16_t* o1; float* of; const float* xp; const float* xs; float* ss_out; const float* ss_in; PG8_LAS float* P; int probe;
    static constexpr int NG = (MODE == E_MIX || MODE == E_X1 || MODE == E_Y) ? 2 : 1, GA = 2 / NG;
    __device__ __forceinline__ void operator()(const f32x4 (&acc)[2][2][4][2], const Unit& u, int wr, int wc, int fr, int fq) const {
        if (probe & 16) return;
        asm volatile("" : "+v"(fr), "+v"(fq));
        const int colw = u.pn * BM + wc * 32 + fq * 8; const int row0 = u.pm * BM + wr * 64 + fr;
        float ss[2][4][2];
#pragma unroll
        for (int gi = 0; gi < NG; ++gi) {
            u32x4 L1[GA][4][2], L2[GA][4][2]; f32x4 X0[GA][4][2], X1v[GA][4][2], SQ[GA][4];
#pragma unroll
            for (int a = 0; a < GA; ++a)
#pragma unroll
                for (int m = 0; m < 4; ++m) { const int ai = gi * GA + a; const int R = row0 + ai * HALF + m * 16;
                    if (MODE == E_UP || MODE == E_Y) SQ[a][m] = *(const f32x4*)(ss_in + (size_t)R * 4);
#pragma unroll
                    for (int bj = 0; bj < 2; ++bj) { const size_t idx = (size_t)R * 1024 + colw + bj * HALF;
                        if (MODE == E_AMIX || MODE == E_MIX || MODE == E_X2 || MODE == E_Y) L1[a][m][bj] = *(const u32x4*)(g1 + idx);
                        if (MODE == E_MIX || MODE == E_Y) L2[a][m][bj] = *(const u32x4*)(g2 + idx);
                        if (MODE == E_X1) { const float* xr = (R < MP) ? xp + idx : xs + (idx - (size_t)MP * 1024); X0[a][m][bj] = *(const f32x4*)xr; X1v[a][m][bj] = *(const f32x4*)(xr + 4); } } }
#pragma unroll
            for (int a = 0; a < GA; ++a)
#pragma unroll
                for (int m = 0; m < 4; ++m) { const int ai = gi * GA + a; const int R = row0 + ai * HALF + m * 16;
                    float rs = 1.0f;
                    if (MODE == E_UP || MODE == E_Y) { const f32x4 q = SQ[a][m]; rs = __builtin_amdgcn_rsqf(((q[0] + q[1]) + (q[2] + q[3])) * (1.0f / 1024.0f) + RMS_EPS); }
#pragma unroll
                    for (int bj = 0; bj < 2; ++bj) { const int col = colw + bj * HALF; const size_t idx = (size_t)R * 1024 + col;
                        const f32x4 a0 = acc[ai][bj][m][0], a1 = acc[ai][bj][m][1];
                        if (MODE == E_AMIX) { f32x4 s0, s1; unpack8(L1[a][m][bj], s0, s1); *(u32x4*)(o1 + idx) = pack8(s0 * a0, s1 * a1); }
                        else if (MODE == E_MIX) { f32x4 s0, s1, p0, p1; unpack8(L1[a][m][bj], s0, s1); unpack8(L2[a][m][bj], p0, p1); *(u32x4*)(o1 + idx) = pack8(p0 + s0 * a0, p1 + s1 * a1); }
                        else if (MODE == E_X1) { const f32x4 v0 = X0[a][m][bj] + a0, v1 = X1v[a][m][bj] + a1;
                            *(u32x4*)(o1 + idx) = pack8(v0, v1); ss[ai][m][bj] = sq8(v0, v1); }
                        else if (MODE == E_UP) { f32x4 v0 = a0 * rs, v1 = a1 * rs;
#pragma unroll
                            for (int e = 0; e < 4; ++e) { const float p = fmaxf(v0[e], 0.f), q = fmaxf(v1[e], 0.f); v0[e] = p * p; v1[e] = q * q; }
                            const u32x4 w_ = pack8(v0, v1); if (!(probe & 8) || w_.x == 0x7fc17fc1u) *(u32x4*)(o1 + (size_t)R * 4096 + col) = w_; }
                        else if (MODE == E_X2) { f32x4 p0, p1; unpack8(L1[a][m][bj], p0, p1); const f32x4 v0 = p0 + a0, v1 = p1 + a1;
                            *(u32x4*)(o1 + idx) = pack8(v0, v1); ss[ai][m][bj] = sq8(v0, v1); }
                        else if (MODE == E_PE) { *(u32x4*)(o1 + idx) = pack8(a0, a1); }
                        else { f32x4 p0, p1, v0, v1; unpack8(L1[a][m][bj], p0, p1); unpack8(L2[a][m][bj], v0, v1);
#pragma unroll
                            for (int e = 0; e < 4; ++e) { v0[e] += fsigmoid(a0[e] * rs) * p0[e]; v1[e] += fsigmoid(a1[e] * rs) * p1[e]; }
                            *(f32x4*)(of + idx) = v0; *(f32x4*)(of + idx + 4) = v1; } } }
            if (NG > 1) asm volatile("" ::: "memory");
        }
        if (MODE == E_X1 || MODE == E_X2) {
            rowss_exchange(ss, P, wr, wc, fr, fq);
            if (wc == 0 && fq == 0) {
#pragma unroll
                for (int ai = 0; ai < 2; ++ai)
#pragma unroll
                    for (int m = 0; m < 4; ++m) ss_out[(size_t)(row0 + ai * HALF + m * 16) * 4 + u.pn] = ss[ai][m][0] + ss[ai][m][1]; }
        }
    }
};
template <class Epi, class Sched, bool ALIGN_EPI = false, bool SP2 = false>
__device__ __forceinline__ void gemm_phase(PG8_LAS unsigned char* lds, const Gemm g, const Sched& S, const Epi& E, const int wave0, const unsigned stag_ticks = 0u) {
    int tid_; asm volatile("v_mbcnt_lo_u32_b32 %0, -1, 0\n\tv_mbcnt_hi_u32_b32 %0, -1, %0" : "=v"(tid_)); tid_ |= wave0 << 6;
    const int tid = tid_, wid = __builtin_amdgcn_readfirstlane(tid >> 6), lane = tid & 63, wr = wid >> 2, wc = wid & 3, fr = lane & 15, fq = lane >> 4;
    const int K = g.K, nt = K / BK;
    unsigned voffA[2], voffB[2];
#pragma unroll
    for (int i = 0; i < 2; ++i) { int R, C; stage_rc(tid * 16 + i * 8192, R, C); const int Rb = Epi::PERM ? ((R & ~31) + perm32(R & 31)) : R;
        voffA[i] = (unsigned)(R * K + C) * 2u; voffB[i] = (unsigned)(Rb * K + C) * 2u; }
    const size_t kstep = (size_t)(BK * 2);
    const size_t hstep = (size_t)HALF * K * 2;
    const size_t tstep = 2 * hstep;
    const unsigned ldsw = (unsigned)wid * 1024u;
    const int aoff = lds_byte(wr * 64 + fr, fq * 8), boff = lds_byte(wc * 32 + fr, fq * 8);
#define PG8_SA(b, h) (((b) * 2 + (h)) * HTB)
#define PG8_SB(b, h) ((4 + (b) * 2 + (h)) * HTB)
#define PG8_STAGE(bufoff, gbase, voff) do { _Pragma("unroll") for (int _i = 0; _i < 2; ++_i) \
        __builtin_amdgcn_global_load_lds((const unsigned*)((const char*)(gbase) + (voff)[_i]), (PG8_LAS unsigned*)(lds + (bufoff) + ldsw + _i * 8192), 16, 0, 0); } while (0)
#define PG8_LDA(dst, b, h) do { _Pragma("unroll") for (int m = 0; m < 4; ++m) _Pragma("unroll") for (int k = 0; k < 2; ++k) dst[m][k] = *(const PG8_LAS bf16x8*)(lds + PG8_SA(b, h) + aoff + m * 2048 + k * 1024); } while (0)
#define PG8_LDB(dst, b, h) do { _Pragma("unroll") for (int n = 0; n < 2; ++n) _Pragma("unroll") for (int k = 0; k < 2; ++k) dst[n][k] = *(const PG8_LAS bf16x8*)(lds + PG8_SB(b, h) + boff + n * 2048 + k * 1024); } while (0)
#define PG8_MMA(ai, bj, At, Bt) do { __builtin_amdgcn_s_setprio(1); _Pragma("unroll") for (int m = 0; m < 4; ++m) _Pragma("unroll") for (int n = 0; n < 2; ++n) _Pragma("unroll") for (int k = 0; k < 2; ++k) \
        acc[ai][bj][m][n] = __builtin_amdgcn_mfma_f32_16x16x32_bf16(Bt[n][k], At[m][k], acc[ai][bj][m][n], 0, 0, 0); __builtin_amdgcn_s_setprio(0); } while (0)
#define PG8_WAIT_V(n) asm volatile("s_waitcnt vmcnt(" #n ")" ::: "memory")
#define PG8_WAIT_L(n) asm volatile("s_waitcnt lgkmcnt(" #n ")" ::: "memory")
#define PG8_WAIT_V_EPI(flag, n) asm volatile("s_cmp_eq_u32 %0, 0\n\ts_cbranch_scc1 1f\n\ts_waitcnt vmcnt(" #n ")\n\ts_branch 2f\n1:\n\ts_waitcnt vmcnt(8)\n2:" :: "s"(flag) : "memory", "scc")
#define PG8_BAR __builtin_amdgcn_s_barrier()
#define PG8_SCHED __builtin_amdgcn_sched_barrier(0)
    Unit cur, nxt; int ui = 0;
    if (!S.next(0, cur)) return;
    if (stag_ticks) {
        const unsigned long long t0_ = __builtin_amdgcn_s_memrealtime();
        while (__builtin_amdgcn_s_memrealtime() - t0_ < (unsigned long long)stag_ticks) __builtin_amdgcn_s_sleep(16);
    }
    f32x4 acc[2][2][4][2];
#pragma unroll
    for (int a = 0; a < 2; ++a)
#pragma unroll
        for (int b = 0; b < 2; ++b)
#pragma unroll
            for (int m = 0; m < 4; ++m)
#pragma unroll
                for (int n = 0; n < 2; ++n) acc[a][b][m][n] = (f32x4){0.f, 0.f, 0.f, 0.f};
    bf16x8 At[4][2], B0[2][2], B1[2][2];
    const char* cA = (const char*)g.A + (size_t)cur.pm * tstep; const char* cB = (const char*)g.Bt + (size_t)cur.pn * tstep;
    S.a_ready(cur);
    if constexpr (SP2) {
        PG8_STAGE(PG8_SB(0, 0), cB, voffB); PG8_STAGE(PG8_SB(0, 1), cB + hstep, voffB); PG8_STAGE(PG8_SA(0, 0), cA, voffA); PG8_STAGE(PG8_SA(0, 1), cA + hstep, voffA);
        if (wr == 1) PG8_BAR;
        PG8_WAIT_V(2); PG8_BAR;
        PG8_STAGE(PG8_SB(1, 0), cB + kstep, voffB); PG8_STAGE(PG8_SA(1, 0), cA + kstep, voffA); PG8_STAGE(PG8_SB(1, 1), cB + hstep + kstep, voffB);
        PG8_WAIT_V(6); PG8_BAR;
    } else {
        PG8_STAGE(PG8_SB(0, 0), cB, voffB); PG8_STAGE(PG8_SA(0, 0), cA, voffA); PG8_STAGE(PG8_SB(0, 1), cB + hstep, voffB); PG8_STAGE(PG8_SA(0, 1), cA + hstep, voffA);
        if (wr == 1) PG8_BAR;
        PG8_WAIT_V(4); PG8_BAR;
        PG8_STAGE(PG8_SB(1, 0), cB + kstep, voffB); PG8_STAGE(PG8_SA(1, 0), cA + kstep, voffA); PG8_STAGE(PG8_SB(1, 1), cB + hstep + kstep, voffB);
        PG8_WAIT_V(6); PG8_BAR;
    }
    for (;;) {
        const bool has_next = S.next(ui + 1, nxt);
        const char* nA = has_next ? (const char*)g.A + (size_t)nxt.pm * tstep : cA; const char* nB = has_next ? (const char*)g.Bt + (size_t)nxt.pn * tstep : cB;
        for (int t = 0; t < nt; t += 2) {
            const bool last = (t == nt - 2);
            const char* a1 = cA + (size_t)(t + 1) * kstep;
            const char* a2 = last ? nA : cA + (size_t)(t + 2) * kstep; const char* b2 = last ? nB : cB + (size_t)(t + 2) * kstep;
            const char* a3 = a2 + kstep; const char* b3 = b2 + kstep;
            if (last && has_next) S.a_ready(nxt);
            if constexpr (SP2) {
            const int after_epi = __builtin_amdgcn_readfirstlane(((t == 0) && (ui > 0)) ? 1 : 0);
            PG8_LDB(B0, 0, 0); PG8_LDB(B1, 0, 1); PG8_SCHED; PG8_LDA(At, 0, 0); PG8_STAGE(PG8_SA(1, 1), a1 + hstep, voffA);
            if constexpr (Epi::NST >= 32) PG8_WAIT_V_EPI(after_epi, 40); else PG8_WAIT_V_EPI(after_epi, 24);
            PG8_WAIT_L(0); PG8_BAR; PG8_MMA(0, 0, At, B0); PG8_MMA(0, 1, At, B1); PG8_BAR; PG8_SCHED;
            PG8_LDA(At, 0, 1); PG8_STAGE(PG8_SB(0, 0), b2, voffB); PG8_STAGE(PG8_SB(0, 1), b2 + hstep, voffB); PG8_STAGE(PG8_SA(0, 0), a2, voffA);
            if constexpr (Epi::NST >= 32) PG8_WAIT_V_EPI(after_epi, 40); else PG8_WAIT_V_EPI(after_epi, 24);
            PG8_WAIT_L(0); PG8_BAR; PG8_MMA(1, 0, At, B0); PG8_MMA(1, 1, At, B1); PG8_BAR; PG8_SCHED;
            PG8_LDB(B0, 1, 0); PG8_LDB(B1, 1, 1); PG8_SCHED; PG8_LDA(At, 1, 0); PG8_STAGE(PG8_SA(0, 1), a2 + hstep, voffA);
            PG8_WAIT_V(8); PG8_WAIT_L(0); PG8_BAR; PG8_MMA(0, 0, At, B0); PG8_MMA(0, 1, At, B1); PG8_BAR; PG8_SCHED;
            PG8_LDA(At, 1, 1); PG8_STAGE(PG8_SB(1, 0), b3, voffB); PG8_STAGE(PG8_SB(1, 1), b3 + hstep, voffB); PG8_STAGE(PG8_SA(1, 0), a3, voffA);
            PG8_WAIT_V(8); PG8_WAIT_L(0); PG8_BAR; PG8_MMA(1, 0, At, B0); PG8_MMA(1, 1, At, B1); PG8_BAR; PG8_SCHED;
            } else {
            PG8_LDB(B0, 0, 0); PG8_SCHED; PG8_LDA(At, 0, 0); PG8_STAGE(PG8_SA(1, 1), a1 + hstep, voffA);
            PG8_WAIT_L(8); PG8_BAR; PG8_WAIT_L(0); PG8_MMA(0, 0, At, B0); PG8_BAR; PG8_SCHED;
            PG8_LDB(B1, 0, 1); PG8_STAGE(PG8_SB(0, 0), b2, voffB);
            PG8_BAR; PG8_WAIT_L(0); PG8_MMA(0, 1, At, B1); PG8_BAR;
            PG8_LDA(At, 0, 1); PG8_STAGE(PG8_SA(0, 0), a2, voffA);
            PG8_BAR; PG8_WAIT_L(0); PG8_MMA(1, 0, At, B0); PG8_BAR; PG8_SCHED;
            PG8_STAGE(PG8_SB(0, 1), b2 + hstep, voffB);
            PG8_WAIT_V(6); PG8_BAR; PG8_MMA(1, 1, At, B1); PG8_BAR;
            PG8_LDB(B0, 1, 0); PG8_SCHED; PG8_LDA(At, 1, 0); PG8_STAGE(PG8_SA(0, 1), a2 + hstep, voffA);
            PG8_WAIT_L(8); PG8_BAR; PG8_WAIT_L(0); PG8_MMA(0, 0, At, B0); PG8_BAR; PG8_SCHED;
            PG8_LDB(B1, 1, 1); PG8_STAGE(PG8_SB(1, 0), b3, voffB);
            PG8_BAR; PG8_WAIT_L(0); PG8_MMA(0, 1, At, B1); PG8_BAR;
            PG8_LDA(At, 1, 1); PG8_STAGE(PG8_SA(1, 0), a3, voffA);
            PG8_BAR; PG8_WAIT_L(0); PG8_MMA(1, 0, At, B0); PG8_BAR; PG8_SCHED;
            PG8_STAGE(PG8_SB(1, 1), b3 + hstep, voffB);
            PG8_WAIT_V(6); PG8_BAR; PG8_MMA(1, 1, At, B1); PG8_BAR;
            }
        }
        if constexpr (ALIGN_EPI) { if (wr == 0) PG8_BAR; }
        if constexpr (!Epi::AFTER_DRAIN) { E(acc, cur, wr, wc, fr, fq); S.done(cur); }
        if (!has_next) break;
#pragma unroll
        for (int a = 0; a < 2; ++a)
#pragma unroll
            for (int b = 0; b < 2; ++b)
#pragma unroll
                for (int m = 0; m < 4; ++m)
#pragma unroll
                    for (int n = 0; n < 2; ++n) acc[a][b][m][n] = (f32x4){0.f, 0.f, 0.f, 0.f};
        cur = nxt; cA = nA; cB = nB; ++ui;
        if constexpr (ALIGN_EPI) { if (wr == 1) PG8_BAR; }
    }
    PG8_WAIT_V(0);
    if constexpr (!ALIGN_EPI) { if (wr == 0) PG8_BAR; }
    PG8_BAR;
    if constexpr (Epi::AFTER_DRAIN) { E.fused(acc, cur, wr, wc, fr, fq, lds, wid, lane); S.done(cur); }
#undef PG8_SA
#undef PG8_SB
#undef PG8_STAGE
#undef PG8_LDA
#undef PG8_LDB
#undef PG8_MMA
#undef PG8_WAIT_V
#undef PG8_WAIT_L
#undef PG8_WAIT_V_EPI
#undef PG8_BAR
#undef PG8_SCHED
}
}
#define XB_TMO      128
#define XB_XCNT(j)  (256  + 64 * (j))
#define XB_XSUB(j)  (1280 + 64 * (j))
#define XB_XGEN(j)  (2304 + 64 * (j))
#define XB_TOP      3328
#define XB_TOPGEN   3392
#define XCD_BAR_WORDS 3456
#define XB_SPIN_CAP (1u << 18)

__device__ __forceinline__ unsigned xb_ld(unsigned* p)              { return __hip_atomic_load(p, __ATOMIC_RELAXED, __HIP_MEMORY_SCOPE_AGENT); }
__device__ __forceinline__ unsigned xb_add(unsigned* p, unsigned v) { return __hip_atomic_fetch_add(p, v, __ATOMIC_RELAXED, __HIP_MEMORY_SCOPE_AGENT); }
__device__ __forceinline__ unsigned xb_xcc_id() { return (unsigned)__builtin_amdgcn_s_getreg((3 << 11) | 20) & 0xFu; }
#define XB_SPIN(cond, bar) do { unsigned _sp = 0; while (cond) { __builtin_amdgcn_s_sleep(1); \
    if ((++_sp & 255u) == 0u) { if (xb_ld(&(bar)[XB_TMO])) break; if (_sp > XB_SPIN_CAP) { atomicAdd(&(bar)[XB_TMO], 1u); break; } } } } while (0)

struct XcdBarrier {
    unsigned* bar; unsigned x;
    volatile LAS unsigned* st;
};

__device__ __forceinline__ XcdBarrier xcd_barrier_post(unsigned* bar, volatile LAS unsigned* st) {
    XcdBarrier b; b.bar = bar; b.x = xb_xcc_id(); b.st = st;
    if (threadIdx.x == 0) (void)xb_add(&bar[XB_XCNT(b.x)], 1u);
    return b;
}
__device__ __forceinline__ void xcd_barrier_complete(unsigned* bar, unsigned x, unsigned& nloc, unsigned& nx) {
    const unsigned G = gridDim.x * gridDim.y * gridDim.z;
    unsigned sum, cnt, mine, sp = 0u;
    for (;;) {
        sum = 0u; cnt = 0u; mine = 0u;
#pragma unroll
        for (unsigned j = 0; j < 16; ++j) { const unsigned c = xb_ld(&bar[XB_XCNT(j)]); sum += c; cnt += (c > 0u) ? 1u : 0u; mine = (j == x) ? c : mine; }
        if (sum == G) break;
        __builtin_amdgcn_s_sleep(1);
        if ((++sp & 255u) == 0u) { if (xb_ld(&bar[XB_TMO])) break; if (sp > XB_SPIN_CAP) { atomicAdd(&bar[XB_TMO], 1u); break; } }
    }
    nloc = mine > 0u ? mine : 1u; nx = cnt > 0u ? cnt : 1u;
}

__device__ __forceinline__ void xcd_barrier(const XcdBarrier& b) {
    asm volatile("s_waitcnt vmcnt(0)" ::: "memory");
    __syncthreads();
    if (threadIdx.x == 0) {
        unsigned* bar = b.bar;
        __builtin_amdgcn_s_waitcnt(0);
        unsigned nloc = b.st[0], nx = b.st[1];
        if (nloc == 0u) { xcd_barrier_complete(bar, b.x, nloc, nx); b.st[0] = nloc; b.st[1] = nx; }
        const unsigned old = xb_add(&bar[XB_XSUB(b.x)], 1u);
        const unsigned gen = old / nloc;
        if (old + 1u == (gen + 1u) * nloc) {
            __builtin_amdgcn_fence(__ATOMIC_RELEASE, "agent");
            asm volatile("s_waitcnt vmcnt(0)" ::: "memory");
            const unsigned og = xb_add(&bar[XB_TOP], 1u);
            const unsigned tg = og / nx;
            if (og + 1u == (tg + 1u) * nx) xb_add(&bar[XB_TOPGEN], 1u);
            else XB_SPIN(xb_ld(&bar[XB_TOPGEN]) == tg, bar);
            __builtin_amdgcn_fence(__ATOMIC_ACQUIRE, "agent");
            xb_add(&bar[XB_XGEN(b.x)], 1u);
            asm volatile("s_waitcnt vmcnt(0)" ::: "memory");
        } else {
            XB_SPIN(xb_ld(&bar[XB_XGEN(b.x)]) == gen, bar);
            __builtin_amdgcn_fence(__ATOMIC_ACQUIRE, "agent");
            asm volatile("s_waitcnt vmcnt(0)" ::: "memory");
        }
    }
    __syncthreads();
}
__device__ __forceinline__ float wave_sum(float v) {
#pragma unroll
    for (int o = 1; o < 64; o <<= 1) v += __shfl_xor(v, o);
    return v;
}
__device__ __forceinline__ float wave_max(float v) {
#pragma unroll
    for (int o = 1; o < 64; o <<= 1) v = fmaxf(v, __shfl_xor(v, o));
    return v;
}
__device__ __forceinline__ void p0_transpose_item(const float* W, int K, int N, bf16* WT, const float* ks, LAS float* scr, int item, int lane) {
    const int nblk = N / 32, kb = item / nblk, nb = item % nblk, k0 = 64 * kb, n0 = 32 * nb;
#pragma unroll 8
    for (int i = 0; i < 32; ++i) { const int kk = 2 * i + (lane >> 5); float w = W[(size_t)(k0 + kk) * N + n0 + (lane & 31)]; if (ks) w *= ks[k0 + kk]; scr[kk * 33 + (lane & 31)] = w; }
    LDS_WAIT(); asm volatile("" ::: "memory");
    const int c = lane & 7;
#pragma unroll
    for (int j = 0; j < 4; ++j) { const int n = (lane >> 3) + 8 * j; const LAS float* s = scr + (8 * c) * 33 + n;
        v4u o; o.x = pk2(s[0 * 33], s[1 * 33]); o.y = pk2(s[2 * 33], s[3 * 33]); o.z = pk2(s[4 * 33], s[5 * 33]); o.w = pk2(s[6 * 33], s[7 * 33]);
        *(GAS v4u*)(WT + (size_t)(n0 + n) * K + k0 + 8 * c) = o; }
    LDS_WAIT(); asm volatile("" ::: "memory");
}

struct Ptrs {
    const float* in[30]; float* out; unsigned char* ws;
};
#define WSP(T, off) ((T*)(P.ws + (off)))

__device__ __forceinline__ void p0_prologue(const Ptrs& P, LAS unsigned char* lds, int tid, int lane, int wave, int vcu, int G) {
    LAS float* scr = (LAS float*)(lds + RING_OFF + wave * 16384);
    const int gw = vcu * NWAVES + wave, NGW = G * NWAVES;
    constexpr int I0 = (DM / 64) * (NIN / 32), I1 = (MW / 64) * (DM / 32), I2 = (DM / 64) * (DM / 32), I3 = I2, I4 = (DM / 64) * (FF / 32), I5 = (FF / 64) * (DM / 32), I6 = I2, I7 = (PLE / 64) * (DM / 32);
    constexpr int NITEMS = I0 + I1 + I2 + I3 + I4 + I5 + I6 + I7;
    for (int it = gw; it < NITEMS; it += NGW) {
        int r = it;
        if (r < I0) { p0_transpose_item(P.in[11], DM, NIN, WSP(bf16, WS_WIN), nullptr, scr, r, lane); continue; } r -= I0;
        if (r < I1) { p0_transpose_item(P.in[14], MW, DM, WSP(bf16, WS_WOA), nullptr, scr, r, lane); continue; } r -= I1;
        if (r < I2) { p0_transpose_item(P.in[22], DM, DM, WSP(bf16, WS_WOB), nullptr, scr, r, lane); continue; } r -= I2;
        if (r < I3) { p0_transpose_item(P.in[23], DM, DM, WSP(bf16, WS_WO), nullptr, scr, r, lane); continue; } r -= I3;
        if (r < I4) { p0_transpose_item(P.in[25], DM, FF, WSP(bf16, WS_WUP), P.in[24], scr, r, lane); continue; } r -= I4;
        if (r < I5) { p0_transpose_item(P.in[26], FF, DM, WSP(bf16, WS_WDN), nullptr, scr, r, lane); continue; } r -= I5;
        if (r < I6) { p0_transpose_item(P.in[28], DM, DM, WSP(bf16, WS_WPG), P.in[27], scr, r, lane); continue; } r -= I6;
        p0_transpose_item(P.in[29], PLE, DM, WSP(bf16, WS_WPE), nullptr, scr, r, lane);
    }
    { const GAS f32x4* gm = (const GAS f32x4*)P.in[10] + lane; f32x4 g[4];
#pragma unroll
      for (int j = 0; j < 4; ++j) g[j] = gm[64 * j];
      bf16* HB = WSP(bf16, WS_HB);
      for (int m0 = gw; m0 < M; m0 += 4 * NGW) {
        f32x4 v[4][4]; float s[4];
#pragma unroll
        for (int r = 0; r < 4; ++r) { const int m = (m0 + r * NGW < M) ? m0 + r * NGW : m0; const float* xrow = (m < MP) ? P.in[0] + (size_t)m * DM : P.in[1] + (size_t)(m - MP) * DM;
            const GAS f32x4* xr = (const GAS f32x4*)xrow + lane;
#pragma unroll
            for (int j = 0; j < 4; ++j) v[r][j] = xr[64 * j]; }
#pragma unroll
        for (int r = 0; r < 4; ++r) { float t = 0.f;
#pragma unroll
            for (int j = 0; j < 4; ++j) t += (v[r][j].x * v[r][j].x + v[r][j].y * v[r][j].y) + (v[r][j].z * v[r][j].z + v[r][j].w * v[r][j].w);
            s[r] = t; }
#pragma unroll
        for (int o = 1; o < 64; o <<= 1) {
#pragma unroll
            for (int r = 0; r < 4; ++r) s[r] += __shfl_xor(s[r], o); }
#pragma unroll
        for (int r = 0; r < 4; ++r) { const int m = m0 + r * NGW; if (m < M) { const float rs = 1.0f / sqrtf(s[r] * (1.f / DM) + 1e-6f);
            GAS v2u* o8 = (GAS v2u*)(HB + (size_t)m * DM) + lane;
#pragma unroll
            for (int j = 0; j < 4; ++j) { v2u w; w.x = pk2(v[r][j].x * rs * g[j].x, v[r][j].y * rs * g[j].y); w.y = pk2(v[r][j].z * rs * g[j].z, v[r][j].w * rs * g[j].w); o8[64 * j] = w; } } }
      }
      bf16* PB = WSP(bf16, WS_PB);
      for (int m0 = gw; m0 < M; m0 += 8 * NGW) {
        f32x4 pv[8];
#pragma unroll
        for (int r = 0; r < 8; ++r) { const int m = (m0 + r * NGW < M) ? m0 + r * NGW : m0; const float* prow = (m < MP) ? P.in[2] + (size_t)m * PLE : P.in[3] + (size_t)(m - MP) * PLE; pv[r] = ((const GAS f32x4*)prow)[lane]; }
#pragma unroll
        for (int r = 0; r < 8; ++r) { const int m = m0 + r * NGW; if (m < M) { v2u w; w.x = pk2(pv[r].x, pv[r].y); w.y = pk2(pv[r].z, pv[r].w); ((GAS v2u*)(PB + (size_t)m * PLE))[lane] = w; } }
      }
    }
    const int gt = vcu * (NWAVES * 64) + tid, NT = G * NWAVES * 64;
    { bf16* WRG = WSP(bf16, WS_WRG);
      for (int e = gt; e < 2 * 65536; e += NT) { const int mat = e >> 16, n = (e >> 12) & 15, o = (e >> 6) & 63, i = e & 63;
          WRG[e] = (bf16)f2bf(P.in[mat ? 19 : 17][(n * 64 + i) * 64 + o] * -1.4426950408889634f); }
      float* TAB = WSP(float, WS_TAB);
      for (int e = gt; e < 12 * 132; e += NT) { const int hh = e / 132, j = e % 132; float v = 0.f;
          if (j <= 128) { const int g = hh >> 2, dist = j << (2 * g); int bk;
              if (dist < 16) bk = dist; else { const double lg = log((double)dist / 16.0) / log(128.0) * 16.0; bk = 16 + (int)lg; if (bk > 31) bk = 31; }
              v = P.in[9][bk * 12 + hh] * 1.4426950408889634f; }
          TAB[e] = v; }
      for (int e = gt; e < 1024; e += NT) { const double x = (double)P.in[21][e]; const double ls = (x >= 0.0) ? -log1p(exp(-x)) : x - log1p(exp(x)); TAB[2048 + e] = (float)(8.0 * ls); }
    }
}

__device__ __forceinline__ unsigned offb(unsigned row, unsigned ch) { return 256u * row + 16u * (ch ^ (((row & 3u) << 2) | ((row >> 2) & 3u))); }
__device__ __forceinline__ s16x4 vtr(LAS const unsigned char* p) { typedef short v4i16_t __attribute__((ext_vector_type(4))); return __builtin_bit_cast(s16x4, __builtin_amdgcn_ds_read_tr16_b64_v4i16((LAS v4i16_t*)p)); }

__device__ __forceinline__ void attn_unit(const Ptrs& P, LAS unsigned char* lds, int uid, bool have_prev, int tid, int lane, int w, int probe) {
    const int blk = uid & 63, h4 = (uid >> 6) & 3, b = (uid >> 8) & 7, g = uid >> 11;
    const int gsh = 2 * g, hh = 4 * g + h4;
    const int nb = blk & ((64 >> gsh) - 1); const bool first = nb == 0;
    const int par = nb & 1; const unsigned xr = par ? 0u : 32768u;
    const size_t qrow0 = ((size_t)(b * 12 + hh) << 13) + (size_t)blk * 128;
    const bf16* Qb = WSP(bf16, WS_Q); const bf16* Kb = WSP(bf16, WS_K); const bf16* Vb = WSP(bf16, WS_V);
    LAS unsigned char* Kimg = lds; LAS unsigned char* Vimg = lds + 65536;
    const LAS float* bias = (const LAS float*)(lds + XCH_OFF) + hh * 132;
    const int qi = lane & 15, g4 = lane >> 4;
    {
        const int lr = lane >> 4, sl = lane & 15;
#pragma unroll
        for (int i = 0; i < 4; ++i) { const int pl = w * 4 + i, p = 32 * par + pl; const int ch = sl ^ ((lr << 2) | (p & 3));
            const size_t srow = qrow0 + 4 * pl + lr;
            __builtin_amdgcn_global_load_lds((const unsigned*)((const char*)Kb + srow * 256 + ch * 16), (LAS unsigned*)(Kimg + p * 1024), 16, 0, 0);
            __builtin_amdgcn_global_load_lds((const unsigned*)((const char*)Vb + srow * 256 + ch * 16), (LAS unsigned*)(Vimg + p * 1024), 16, 0, 0); }
        if (!first && !have_prev) {
#pragma unroll
            for (int i = 0; i < 4; ++i) { const int pl = w * 4 + i, p = 32 * (par ^ 1) + pl; const int ch = sl ^ ((lr << 2) | (p & 3));
                const size_t srow = qrow0 - 128 + 4 * pl + lr;
                __builtin_amdgcn_global_load_lds((const unsigned*)((const char*)Kb + srow * 256 + ch * 16), (LAS unsigned*)(Kimg + p * 1024), 16, 0, 0);
                __builtin_amdgcn_global_load_lds((const unsigned*)((const char*)Vb + srow * 256 + ch * 16), (LAS unsigned*)(Vimg + p * 1024), 16, 0, 0); } }
        if (first) {
#pragma unroll
            for (int i = 0; i < 4; ++i) *(LAS v4u*)(Vimg + 32768 * (par ^ 1) + (i * 512 + tid) * 16) = (v4u){0u, 0u, 0u, 0u}; }
    }
    bf16x8 Qf[4];
    { const bf16* qp = Qb + (qrow0 + 16 * w + qi) * 128 + 8 * g4;
#pragma unroll
      for (int s = 0; s < 4; ++s) Qf[s] = *(const bf16x8*)(qp + 32 * s); }
    VM_WAIT(); LDS_WAIT(); __syncthreads();
    f32x4 S[9];
    { const unsigned fl = ((lane & 3) << 2) | ((lane >> 2) & 3);
      const unsigned kb = 256u * (unsigned)(16 * w + qi);
#pragma unroll
      for (int jb = 0; jb < 9; ++jb) { S[jb] = (f32x4){0.f, 0.f, 0.f, 0.f};
#pragma unroll
          for (int s = 0; s < 4; ++s) { const bf16x8 a = *(const LAS bf16x8*)(Kimg + (((kb + jb * 4096u) ^ xr) + 16u * ((unsigned)(4 * s + g4) ^ fl)));
              S[jb] = __builtin_amdgcn_mfma_f32_16x16x32_bf16(a, Qf[s], S[jb], 0, 0, 0); } } }
    if (probe & 16) { float t_ = 0.f;
#pragma unroll
        for (int jb = 0; jb < 9; ++jb) t_ += S[jb][0] + S[jb][1] + S[jb][2] + S[jb][3];
        if (t_ == 1.2345e-30f) WSP(float, WS_LSE)[tid] = t_; __syncthreads(); return; }
    float mx = -1e30f;
#pragma unroll
    for (int jb = 0; jb < 9; ++jb)
#pragma unroll
        for (int i = 0; i < 4; ++i) { const int ki = 4 * g4 + i, rel = 16 * jb + ki - qi;
            int slot = 128 - rel; slot = slot < 0 ? 0 : (slot > 128 ? 128 : slot);
            bool ok = true; if (jb == 0) ok = rel >= 0; if (jb == 8) ok = rel <= 128;
            if (first) ok = ok && (16 * w + 16 * jb + ki >= 128);
            const float v = ok ? S[jb][i] + bias[slot] : -1e30f; S[jb][i] = v; mx = fmaxf(mx, v); }
    mx = fmaxf(mx, __shfl_xor(mx, 16)); mx = fmaxf(mx, __shfl_xor(mx, 32));
    float tot = 0.f;
#pragma unroll
    for (int jb = 0; jb < 9; ++jb)
#pragma unroll
        for (int i = 0; i < 4; ++i) { const float p = fexp2(S[jb][i] - mx); S[jb][i] = p; tot += p; }
    tot += __shfl_xor(tot, 16); tot += __shfl_xor(tot, 32);
    bf16x8 Pf[5];
#pragma unroll
    for (int ks = 0; ks < 5; ++ks) { v4u pk; pk.x = pk2(S[2 * ks][0], S[2 * ks][1]); pk.y = pk2(S[2 * ks][2], S[2 * ks][3]);
        if (ks < 4) { pk.z = pk2(S[2 * ks + 1][0], S[2 * ks + 1][1]); pk.w = pk2(S[2 * ks + 1][2], S[2 * ks + 1][3]); } else { pk.z = 0u; pk.w = 0u; }
        Pf[ks] = __builtin_bit_cast(bf16x8, pk); }
    f32x4 O[8];
#pragma unroll
    for (int c = 0; c < 8; ++c) O[c] = (f32x4){0.f, 0.f, 0.f, 0.f};
    { const int q = (lane & 15) >> 2, p = lane & 3; const unsigned fl = ((unsigned)q << 2) | (unsigned)g4;
      const unsigned vb = 256u * (unsigned)(16 * w + 4 * g4 + q);
#pragma unroll
      for (int ks = 0; ks < 5; ++ks)
#pragma unroll
          for (int c = 0; c < 8; ++c) { const unsigned co = 16u * (((unsigned)(2 * c + (p >> 1))) ^ fl) + 8u * (unsigned)(p & 1);
              const s16x4 lo = vtr(Vimg + (((vb + 256u * (32 * ks)) ^ xr) + co));
              const s16x4 hi = vtr(Vimg + (((vb + 256u * (32 * ks + (ks < 4 ? 16 : 0))) ^ xr) + co));
              const bf16x8 a = (bf16x8){lo[0], lo[1], lo[2], lo[3], hi[0], hi[1], hi[2], hi[3]};
              O[c] = __builtin_amdgcn_mfma_f32_16x16x32_bf16(a, Pf[ks], O[c], 0, 0, 0); } }
    const float inv = frcp(tot);
    const int mq = nb * 128 + 16 * w + qi, rr = blk >> (6 - gsh);
    const size_t R = (size_t)b * SEQ + ((size_t)mq << gsh) + rr;
    bf16* og = WSP(bf16, WS_OG) + ((size_t)g * MP + R) * MW + h4 * 128 + 4 * g4;
#pragma unroll
    for (int c = 0; c < 8; ++c) { v2u o; o.x = pk2(O[c][0] * inv, O[c][1] * inv); o.y = pk2(O[c][2] * inv, O[c][3] * inv); if (!(probe & 8) || o.x == 0x7fc17fc1u) *(GAS v2u*)(og + 16 * c) = o; }
    if (g4 == 0) WSP(float, WS_LSE)[((size_t)g * MP + R) * 4 + h4] = mx + __log2f(tot);
    __syncthreads();
}

__device__ __forceinline__ void glds16(const void* gsrc, unsigned lds_dst) { unsigned keep;
    asm volatile("s_mov_b32 %0, m0\n\ts_mov_b32 m0, %2\n\ts_nop 0\n\tglobal_load_lds_dwordx4 %1, off\n\ts_mov_b32 m0, %0" : "=&s"(keep) : "v"(gsrc), "s"(lds_dst) : "memory"); }
__device__ __forceinline__ void attn_dma_half(const bf16* src, LAS unsigned char* img, size_t row0, int half, int lane, int w) {
    const int lr = lane >> 4, sl = lane & 15; const unsigned img0 = (unsigned)(uintptr_t)img;
#pragma unroll
    for (int i = 0; i < 4; ++i) { const int pl = w * 4 + i, p = 32 * half + pl; const int ch = sl ^ ((lr << 2) | (p & 3));
        glds16((const char*)src + (row0 + 4 * pl + lr) * 256 + ch * 16, (unsigned)__builtin_amdgcn_readfirstlane((int)(img0 + p * 1024))); }
}
__device__ __forceinline__ void attn_qload(bf16x8 (&Qf)[4], const bf16* qp) {
    asm volatile("global_load_dwordx4 %0, %4, off\n\tglobal_load_dwordx4 %1, %4, off offset:64\n\tglobal_load_dwordx4 %2, %4, off offset:128\n\tglobal_load_dwordx4 %3, %4, off offset:192"
                 : "=&v"(Qf[0]), "=&v"(Qf[1]), "=&v"(Qf[2]), "=&v"(Qf[3]) : "v"(qp) : "memory"); }
#define ATT_WAIT(n) asm volatile("s_waitcnt vmcnt(" #n ")" ::: "memory")
#define ATT_WAITQ(n) asm volatile("s_waitcnt vmcnt(" #n ")" : "+v"(Qf[0]), "+v"(Qf[1]), "+v"(Qf[2]), "+v"(Qf[3]) :: "memory")
#define ATT_BAR() do { asm volatile("s_waitcnt lgkmcnt(0)" ::: "memory"); __builtin_amdgcn_s_barrier(); asm volatile("" ::: "memory"); } while (0)
__device__ __forceinline__ void attn_run(const Ptrs& P, LAS unsigned char* lds, int u0, int n, int tid, int lane, int w) {
    const bf16* Qb = WSP(bf16, WS_Q); const bf16* Kb = WSP(bf16, WS_K); const bf16* Vb = WSP(bf16, WS_V);
    LAS unsigned char* Kimg = lds; LAS unsigned char* Vimg = lds + 65536;
    const int qi = lane & 15, g4 = lane >> 4;
    const int blk0 = u0 & 63, h4 = (u0 >> 6) & 3, b = (u0 >> 8) & 7, g = u0 >> 11; const int gsh = 2 * g, hh = 4 * g + h4;
    const int nb0 = blk0 & ((64 >> gsh) - 1); const bool first0 = nb0 == 0;
    const size_t q00 = ((size_t)(b * 12 + hh) << 13) + (size_t)blk0 * 128;
    float bm[9][4];
    { const LAS float* bias = (const LAS float*)(lds + XCH_OFF) + hh * 132;
#pragma unroll
      for (int jb = 0; jb < 9; ++jb)
#pragma unroll
          for (int i = 0; i < 4; ++i) { const int ki = 4 * g4 + i, rel = 16 * jb + ki - qi; int slot = 128 - rel; slot = slot < 0 ? 0 : (slot > 128 ? 128 : slot);
              bool ok = true; if (jb == 0) ok = rel >= 0; if (jb == 8) ok = rel <= 128;
              bm[jb][i] = ok ? bias[slot] : -1e30f; } }
    bf16x8 Qf[4];
    { const int par = nb0 & 1;
      attn_dma_half(Kb, Kimg, q00, par, lane, w); attn_dma_half(Vb, Vimg, q00, par, lane, w);
      if (!first0) { attn_dma_half(Kb, Kimg, q00 - 128, par ^ 1, lane, w); attn_dma_half(Vb, Vimg, q00 - 128, par ^ 1, lane, w); }
      else {
#pragma unroll
          for (int i = 0; i < 4; ++i) *(LAS v4u*)(Vimg + 32768 * (par ^ 1) + (i * 512 + tid) * 16) = (v4u){0u, 0u, 0u, 0u}; }
      attn_qload(Qf, Qb + (q00 + 16 * w + qi) * 128 + 8 * g4);
      ATT_WAIT(0); }
#pragma unroll 1
    for (int it = 0; it < n; ++it) {
        const bool has_next = it + 1 < n; const bool first = first0 && it == 0;
        const int nb = nb0 + it, par = nb & 1; const unsigned xr = par ? 0u : 32768u; const size_t qrow0 = q00 + (size_t)it * 128;
        ATT_WAITQ(9);
        ATT_BAR();
        if (it > 0) attn_dma_half(Vb, Vimg, qrow0, par, lane, w);
        f32x4 S[9];
        { const unsigned fl = ((lane & 3) << 2) | ((lane >> 2) & 3);
          const unsigned kb = 256u * (unsigned)(16 * w + qi);
          unsigned ko[4];
#pragma unroll
          for (int s = 0; s < 4; ++s) ko[s] = 16u * ((unsigned)(4 * s + g4) ^ fl);
          bf16x8 kf[2][4];
#pragma unroll
          for (int s = 0; s < 4; ++s) kf[0][s] = *(const LAS bf16x8*)(Kimg + ((kb ^ xr) + ko[s]));
#pragma unroll
          for (int jb = 0; jb < 9; ++jb) {
              if (jb < 8) {
#pragma unroll
                  for (int s = 0; s < 4; ++s) kf[(jb + 1) & 1][s] = *(const LAS bf16x8*)(Kimg + (((kb + (jb + 1) * 4096u) ^ xr) + ko[s])); }
              S[jb] = (f32x4){0.f, 0.f, 0.f, 0.f};
#pragma unroll
              for (int s = 0; s < 4; ++s) S[jb] = __builtin_amdgcn_mfma_f32_16x16x32_bf16(kf[jb & 1][s], Qf[s], S[jb], 0, 0, 0); } }
        if (first) {
#pragma unroll
            for (int jb = 0; jb < 8; ++jb) if (w + jb < 8) S[jb] = (f32x4){-1e30f, -1e30f, -1e30f, -1e30f}; }
        float mx = -1e30f;
#pragma unroll
        for (int jb = 0; jb < 9; ++jb)
#pragma unroll
            for (int i = 0; i < 4; ++i) { const float v = S[jb][i] + bm[jb][i]; S[jb][i] = v; mx = fmaxf(mx, v); }
        mx = fmaxf(mx, __shfl_xor(mx, 16)); mx = fmaxf(mx, __shfl_xor(mx, 32));
        float tot = 0.f;
#pragma unroll
        for (int jb = 0; jb < 9; ++jb)
#pragma unroll
            for (int i = 0; i < 4; ++i) { const float p = fexp2(S[jb][i] - mx); S[jb][i] = p; tot += p; }
        tot += __shfl_xor(tot, 16); tot += __shfl_xor(tot, 32);
        bf16x8 Pf[5];
#pragma unroll
        for (int ks = 0; ks < 5; ++ks) { v4u pk; pk.x = pk2(S[2 * ks][0], S[2 * ks][1]); pk.y = pk2(S[2 * ks][2], S[2 * ks][3]);
            if (ks < 4) { pk.z = pk2(S[2 * ks + 1][0], S[2 * ks + 1][1]); pk.w = pk2(S[2 * ks + 1][2], S[2 * ks + 1][3]); } else { pk.z = 0u; pk.w = 0u; }
            Pf[ks] = __builtin_bit_cast(bf16x8, pk); }
        ATT_WAIT(0);
        ATT_BAR();
        if (has_next) attn_dma_half(Kb, Kimg, qrow0 + 128, par ^ 1, lane, w);
        attn_qload(Qf, Qb + (qrow0 + (has_next ? 128 : 0) + 16 * w + qi) * 128 + 8 * g4);
        f32x4 O[8];
#pragma unroll
        for (int c = 0; c < 8; ++c) O[c] = (f32x4){0.f, 0.f, 0.f, 0.f};
        { const int q = (lane & 15) >> 2, p = lane & 3; const unsigned fl = ((unsigned)q << 2) | (unsigned)g4;
          const unsigned vb = 256u * (unsigned)(16 * w + 4 * g4 + q);
          unsigned co[8];
#pragma unroll
          for (int c = 0; c < 8; ++c) co[c] = 16u * (((unsigned)(2 * c + (p >> 1))) ^ fl) + 8u * (unsigned)(p & 1);
          s16x4 lo[2][8], hi[2][8];
          { const unsigned r0 = vb ^ xr, r1 = (vb + 256u * 16u) ^ xr;
#pragma unroll
            for (int c = 0; c < 8; ++c) { lo[0][c] = vtr(Vimg + (r0 + co[c])); hi[0][c] = vtr(Vimg + (r1 + co[c])); } }
#pragma unroll
          for (int ks = 0; ks < 5; ++ks) {
              if (ks < 4) { const unsigned r0 = (vb + 256u * (32 * (ks + 1))) ^ xr, r1 = (vb + 256u * (32 * (ks + 1) + (ks + 1 < 4 ? 16 : 0))) ^ xr;
#pragma unroll
                  for (int c = 0; c < 8; ++c) { lo[(ks + 1) & 1][c] = vtr(Vimg + (r0 + co[c])); hi[(ks + 1) & 1][c] = vtr(Vimg + (r1 + co[c])); } }
#pragma unroll
              for (int c = 0; c < 8; ++c) { const s16x4 l_ = lo[ks & 1][c], h_ = hi[ks & 1][c];
                  const bf16x8 va = (bf16x8){l_[0], l_[1], l_[2], l_[3], h_[0], h_[1], h_[2], h_[3]};
                  O[c] = __builtin_amdgcn_mfma_f32_16x16x32_bf16(va, Pf[ks], O[c], 0, 0, 0); } } }
        const float inv = frcp(tot);
        const int mq = nb * 128 + 16 * w + qi, rr = blk0 >> (6 - gsh);
        const size_t R = (size_t)b * SEQ + ((size_t)mq << gsh) + rr;
        bf16* og = WSP(bf16, WS_OG) + ((size_t)g * MP + R) * MW + h4 * 128 + 4 * g4;
#pragma unroll
        for (int c = 0; c < 8; ++c) { v2u o; o.x = pk2(O[c][0] * inv, O[c][1] * inv); o.y = pk2(O[c][2] * inv, O[c][3] * inv); *(GAS v2u*)(og + 16 * c) = o; }
        WSP(float, WS_LSE)[((size_t)g * MP + R) * 4 + h4] = mx + __log2f(tot);
    }
    ATT_WAIT(0); ATT_BAR();
}

__device__ __forceinline__ const float* sattn_row(const float* cache, const float* knew, int b, int t, int gsh, int j) {
    const int nbuf = 128 << gsh, jj = j < 129 ? j : 128, ridx = nbuf + t - (jj << gsh);
    return (ridx >= nbuf) ? knew + (size_t)(b * 4 + (ridx - nbuf)) * 1024 : cache + ((size_t)b * nbuf + ridx) * 1024;
}
__device__ __forceinline__ void sattn_unit(const Ptrs& P, LAS unsigned char* lds, int su, int tid, int lane, int w) {
    constexpr int NSB = 4;
    const int b = su >> 2, t = su & 3; const int h = lane >> 4, sub = lane & 15;
    LAS float* LG = (LAS float*)lds;
    LAS float* PART = (LAS float*)(lds + 8192);
    const LAS float* bias = (const LAS float*)(lds + XCH_OFF);
    const float* QS = WSP(float, WS_QS) + (size_t)su * AW;
    const int lo = h * 128 + 8 * sub;
#pragma unroll
    for (int g = 0; g < 3; ++g) {
        const int gsh = 2 * g; const float* cache = g == 0 ? P.in[4] : (g == 1 ? P.in[5] : P.in[6]); const float* knew = P.out + pg8::kvs_off(g);
        const f32x4 q0 = *(const f32x4*)(QS + (4 * g + h) * 128 + 8 * sub), q1 = *(const f32x4*)(QS + (4 * g + h) * 128 + 8 * sub + 4);
        f32x4 n0[NSB], n1[NSB];
#pragma unroll
        for (int u = 0; u < NSB; ++u) { const float* rp = sattn_row(cache, knew, b, t, gsh, w + 8 * u) + lo; n0[u] = *(const f32x4*)rp; n1[u] = *(const f32x4*)(rp + 4); }
#pragma unroll 1
        for (int j0 = w; j0 < 129; j0 += 8 * NSB) {
            f32x4 k0[NSB], k1[NSB];
#pragma unroll
            for (int u = 0; u < NSB; ++u) { k0[u] = n0[u]; k1[u] = n1[u]; }
            if (j0 + 8 * NSB < 129) {
#pragma unroll
                for (int u = 0; u < NSB; ++u) { const float* rp = sattn_row(cache, knew, b, t, gsh, j0 + 8 * NSB + 8 * u) + lo; n0[u] = *(const f32x4*)rp; n1[u] = *(const f32x4*)(rp + 4); } }
#pragma unroll
            for (int u = 0; u < NSB; ++u) { const int j = j0 + 8 * u;
                float d = (q0[0] * k0[u][0] + q0[1] * k0[u][1]) + (q0[2] * k0[u][2] + q0[3] * k0[u][3]) + (q1[0] * k1[u][0] + q1[1] * k1[u][1]) + (q1[2] * k1[u][2] + q1[3] * k1[u][3]);
                d += __shfl_xor(d, 1); d += __shfl_xor(d, 2); d += __shfl_xor(d, 4); d += __shfl_xor(d, 8);
                if (sub == 0 && j < 129) LG[h * 392 + g * 129 + j] = d + bias[(4 * g + h) * 132 + j]; } }
    }
    LDS_WAIT(); __syncthreads();
    float mxh = 0.f, invh = 0.f;
#pragma unroll
    for (int hd = 0; hd < 4; ++hd) { float m = -1e30f;
        for (int i = lane; i < 387; i += 64) m = fmaxf(m, LG[hd * 392 + i]);
        m = wave_max(m); float s = 0.f;
        for (int i = lane; i < 387; i += 64) s += fexp2(LG[hd * 392 + i] - m);
        s = wave_sum(s); if (hd == h) { mxh = m; invh = 1.0f / s; } }
    float acc[8];
#pragma unroll
    for (int i = 0; i < 8; ++i) acc[i] = 0.f;
#pragma unroll
    for (int g = 0; g < 3; ++g) {
        const int gsh = 2 * g; const float* cache = g == 0 ? P.in[4] : (g == 1 ? P.in[5] : P.in[6]); const float* knew = P.out + pg8::kvs_off(g);
        f32x4 n0[NSB], n1[NSB];
#pragma unroll
        for (int u = 0; u < NSB; ++u) { const float* rp = sattn_row(cache, knew, b, t, gsh, w + 8 * u) + 512 + lo; n0[u] = *(const f32x4*)rp; n1[u] = *(const f32x4*)(rp + 4); }
#pragma unroll 1
        for (int j0 = w; j0 < 129; j0 += 8 * NSB) {
            f32x4 v0[NSB], v1[NSB];
#pragma unroll
            for (int u = 0; u < NSB; ++u) { v0[u] = n0[u]; v1[u] = n1[u]; }
            if (j0 + 8 * NSB < 129) {
#pragma unroll
                for (int u = 0; u < NSB; ++u) { const float* rp = sattn_row(cache, knew, b, t, gsh, j0 + 8 * NSB + 8 * u) + 512 + lo; n0[u] = *(const f32x4*)rp; n1[u] = *(const f32x4*)(rp + 4); } }
#pragma unroll
            for (int u = 0; u < NSB; ++u) { const int j = j0 + 8 * u;
                const float p = (j < 129) ? fexp2(LG[h * 392 + g * 129 + (j < 129 ? j : 128)] - mxh) * invh : 0.f;
#pragma unroll
                for (int i = 0; i < 4; ++i) { acc[i] += p * v0[u][i]; acc[4 + i] += p * v1[u][i]; } } }
    }
#pragma unroll
    for (int i = 0; i < 8; ++i) PART[w * 512 + lane * 8 + i] = acc[i];
    LDS_WAIT(); __syncthreads();
    { float s = 0.f;
#pragma unroll
      for (int k = 0; k < 8; ++k) s += PART[k * 512 + tid];
      WSP(bf16, WS_ATT)[(size_t)(MP + su) * MW + tid] = (bf16)f2bf(s); }
    __syncthreads();
}

struct CombItem { v4u a, b, c; float l0, l1, l2; };
__device__ __forceinline__ void comb_load(const Ptrs& P, int it, CombItem& x) {
    const bf16* OG = WSP(bf16, WS_OG); const float* LSE = WSP(float, WS_LSE); const int R = it >> 6, ck = it & 63, h4 = ck >> 4;
    x.l0 = LSE[((size_t)0 * MP + R) * 4 + h4]; x.l1 = LSE[((size_t)1 * MP + R) * 4 + h4]; x.l2 = LSE[((size_t)2 * MP + R) * 4 + h4];
    x.a = *(const v4u*)(OG + ((size_t)0 * MP + R) * MW + ck * 8); x.b = *(const v4u*)(OG + ((size_t)1 * MP + R) * MW + ck * 8); x.c = *(const v4u*)(OG + ((size_t)2 * MP + R) * MW + ck * 8);
}
__device__ __forceinline__ void comb_finish(const Ptrs& P, int it, const CombItem& x) {
    const float mx = fmaxf(x.l0, fmaxf(x.l1, x.l2)); float w0 = fexp2(x.l0 - mx), w1 = fexp2(x.l1 - mx), w2 = fexp2(x.l2 - mx); const float inv = frcp(w0 + w1 + w2); w0 *= inv; w1 *= inv; w2 *= inv;
    v4u o;
    o.x = pk2(w0 * bflo(x.a.x) + w1 * bflo(x.b.x) + w2 * bflo(x.c.x), w0 * bfhi(x.a.x) + w1 * bfhi(x.b.x) + w2 * bfhi(x.c.x));
    o.y = pk2(w0 * bflo(x.a.y) + w1 * bflo(x.b.y) + w2 * bflo(x.c.y), w0 * bfhi(x.a.y) + w1 * bfhi(x.b.y) + w2 * bfhi(x.c.y));
    o.z = pk2(w0 * bflo(x.a.z) + w1 * bflo(x.b.z) + w2 * bflo(x.c.z), w0 * bfhi(x.a.z) + w1 * bfhi(x.b.z) + w2 * bfhi(x.c.z));
    o.w = pk2(w0 * bflo(x.a.w) + w1 * bflo(x.b.w) + w2 * bflo(x.c.w), w0 * bfhi(x.a.w) + w1 * bfhi(x.b.w) + w2 * bfhi(x.c.w));
    *(v4u*)(WSP(bf16, WS_ATT) + (size_t)(it >> 6) * MW + (it & 63) * 8) = o;
}
__device__ __forceinline__ int crow(int r, int hi) { return (r & 3) + 8 * (r >> 2) + 4 * hi; }
constexpr int TAB_HC = 4096, TAB_SA = 12288, TAB_SB = 20480;
template <bool OUT> __device__ __forceinline__ void lru_unit(const Ptrs& P, LAS unsigned char* lds, int b, int n, int rg, int tid, int lane, int w, int comb_base = -1) {
    LAS unsigned char* AIMG = lds;
    LAS float* XC32 = (LAS float*)(lds + 16384);
    LAS float* HST = (LAS float*)(lds + 49152);
    LAS float* SUM = (LAS float*)(lds + 81920);
    LAS float* WC = (LAS float*)(lds + 84992);
    const int ch0 = 64 * n, tb = w >> 1, cb = w & 1, cl = lane & 31, hi = lane >> 5, mych = ch0 + 32 * cb + cl;
    if (tid < 320) { const int k = tid >> 6, i = tid & 63; WC[tid] = (k < 4) ? P.in[15][k * 1024 + ch0 + i] : P.in[16][ch0 + i]; }
    const bf16* WRG = WSP(bf16, WS_WRG);
    bf16x8 Bfa[4], Bfi[4];
#pragma unroll
    for (int s = 0; s < 4; ++s) { Bfa[s] = *(const bf16x8*)(WRG + ((size_t)(n * 64 + 32 * cb + cl) * 64 + 16 * s + 8 * hi));
                                  Bfi[s] = *(const bf16x8*)(WRG + 65536 + ((size_t)(n * 64 + 32 * cb + cl) * 64 + 16 * s + 8 * hi)); }
    const float ba = P.in[18][mych] * -1.4426950408889634f, bi = P.in[20][mych] * -1.4426950408889634f, c8l = WSP(float, WS_TAB)[2048 + mych] * 1.4426950408889634f;
    float hstate = 0.f, astate = 1.f;
    if (OUT && rg >= 1) { const float* T = WSP(float, WS_TAB) + b * 1024 + mych; hstate = T[TAB_HC]; if (rg == 2) hstate = T[TAB_SA] * hstate + T[TAB_SB]; }
    const int nch = (rg == 0) ? 32 : 16;
    const int tl = tid >> 2, cg = tid & 3;
    const bf16* XB = WSP(bf16, WS_XB); const bf16* GY = WSP(bf16, WS_GY); bf16* HRG = WSP(bf16, WS_HRG);
    v4u xv[4][2];
    const int tbase = (rg == 0) ? 0 : (rg == 1 ? 4096 : 6144);
    { const int t0 = tbase;
#pragma unroll
      for (int k = 0; k < 4; ++k) { const int t = t0 + tl - 3 + k;
          if (t >= 0) { const v4u* p = (const v4u*)(XB + ((size_t)b * SEQ + t) * DM + ch0 + 16 * cg); xv[k][0] = p[0]; xv[k][1] = p[1]; }
          else { xv[k][0] = (v4u){0u, 0u, 0u, 0u}; xv[k][1] = (v4u){0u, 0u, 0u, 0u}; } } }
    LDS_WAIT(); __syncthreads();
    for (int ci = 0; ci < nch; ++ci) {
        const int t0 = tbase + ci * 128; const size_t R0 = (size_t)b * SEQ + t0;
        {
            float xc[16];
#pragma unroll
            for (int q = 0; q < 4; ++q) { const f32x4 bc = *(const LAS f32x4*)(WC + 256 + 16 * cg + 4 * q); xc[4 * q] = bc[0]; xc[4 * q + 1] = bc[1]; xc[4 * q + 2] = bc[2]; xc[4 * q + 3] = bc[3]; }
#pragma unroll
            for (int k = 0; k < 4; ++k)
#pragma unroll
                for (int q = 0; q < 4; ++q) { const f32x4 wv = *(const LAS f32x4*)(WC + 64 * k + 16 * cg + 4 * q);
                    const unsigned u0 = xv[k][q >> 1][(q & 1) * 2], u1 = xv[k][q >> 1][(q & 1) * 2 + 1];
                    xc[4 * q] += wv[0] * bflo(u0); xc[4 * q + 1] += wv[1] * bfhi(u0); xc[4 * q + 2] += wv[2] * bflo(u1); xc[4 * q + 3] += wv[3] * bfhi(u1); }
#pragma unroll
            for (int q = 0; q < 4; ++q) *(LAS f32x4*)(XC32 + tl * 64 + 4 * ((4 * cg + q) ^ (tl & 15))) = (f32x4){xc[4 * q], xc[4 * q + 1], xc[4 * q + 2], xc[4 * q + 3]};
#pragma unroll
            for (int e = 0; e < 2; ++e) { v4u o; o.x = pk2(xc[8 * e], xc[8 * e + 1]); o.y = pk2(xc[8 * e + 2], xc[8 * e + 3]); o.z = pk2(xc[8 * e + 4], xc[8 * e + 5]); o.w = pk2(xc[8 * e + 6], xc[8 * e + 7]);
                *(LAS v4u*)(AIMG + tl * 128 + 16 * ((2 * cg + e) ^ ((tl >> 1) & 7))) = o; }
        }
        v4u gy0, gy1;
        if (OUT) { const v4u* p = (const v4u*)(GY + (R0 + tl) * DM + ch0 + 16 * cg); gy0 = p[0]; gy1 = p[1]; }
        CombItem cb0, cb1; const int cit = (comb_base + ci) * 1024 + tid;
        if (OUT && comb_base >= 0) { comb_load(P, cit, cb0); comb_load(P, cit + 512, cb1); }
        if (ci + 1 < nch) {
#pragma unroll
            for (int k = 0; k < 4; ++k) { const v4u* p = (const v4u*)(XB + (R0 + 128 + tl - 3 + k) * DM + ch0 + 16 * cg); xv[k][0] = p[0]; xv[k][1] = p[1]; } }
        LDS_WAIT(); __builtin_amdgcn_s_barrier(); asm volatile("" ::: "memory");
        f32x16 za, zi;
#pragma unroll
        for (int i = 0; i < 16; ++i) { za[i] = 0.f; zi[i] = 0.f; }
        { const int row = 32 * tb + cl;
#pragma unroll
          for (int s = 0; s < 4; ++s) { const bf16x8 a = *(const LAS bf16x8*)(AIMG + row * 128 + 16 * ((2 * s + hi) ^ ((row >> 1) & 7)));
              za = __builtin_amdgcn_mfma_f32_32x32x16_bf16(a, Bfa[s], za, 0, 0, 0); zi = __builtin_amdgcn_mfma_f32_32x32x16_bf16(a, Bfi[s], zi, 0, 0, 0); } }
        float av[16], bv[16];
#pragma unroll
        for (int i = 0; i < 16; ++i) { const int tk_ = 32 * tb + crow(i, hi); const float xcv = XC32[tk_ * 64 + 4 * (((32 * cb + cl) >> 2) ^ (tk_ & 15)) + (cl & 3)];
            const float r = frcp(1.0f + fexp2(za[i] + ba)), ig = frcp(1.0f + fexp2(zi[i] + bi)); const float a = fexp2(c8l * r); av[i] = a; bv[i] = __builtin_amdgcn_sqrtf(fmaf(-a, a, 1.0f)) * (ig * xcv); }
        float As[4], Bs[4], pAs[4], pBs[4], preA[4], preB[4];
#pragma unroll
        for (int sg = 0; sg < 4; ++sg) { float A = 1.f, B = 0.f;
#pragma unroll
            for (int e = 0; e < 4; ++e) { B = av[4 * sg + e] * B + bv[4 * sg + e]; A = av[4 * sg + e] * A; }
            As[sg] = A; Bs[sg] = B; pAs[sg] = __shfl_xor(A, 32); pBs[sg] = __shfl_xor(B, 32); }
        float PA = 1.f, PB = 0.f;
#pragma unroll
        for (int sg = 0; sg < 4; ++sg) {
            const float fA = hi ? pAs[sg] : As[sg], fB = hi ? pBs[sg] : Bs[sg], sA = hi ? As[sg] : pAs[sg], sB = hi ? Bs[sg] : pBs[sg];
            const float PB1 = fA * PB + fB, PA1 = fA * PA;
            preA[sg] = hi ? PA1 : PA; preB[sg] = hi ? PB1 : PB;
            PB = sA * PB1 + sB; PA = sA * PA1; }
        if (hi == 0) { SUM[(tb * 64 + 32 * cb + cl) * 2] = PA; SUM[(tb * 64 + 32 * cb + cl) * 2 + 1] = PB; }
        LDS_WAIT(); __builtin_amdgcn_s_barrier(); asm volatile("" ::: "memory");
        float hin = hstate, hnew = hstate;
#pragma unroll
        for (int t = 0; t < 4; ++t) { const float A = SUM[(t * 64 + 32 * cb + cl) * 2], B = SUM[(t * 64 + 32 * cb + cl) * 2 + 1];
            hnew = A * hnew + B; if (t < tb) hin = hnew; if (!OUT) astate *= A; }
        hstate = hnew;
        if (OUT) {
#pragma unroll
            for (int sg = 0; sg < 4; ++sg) { float hc = preA[sg] * hin + preB[sg];
#pragma unroll
                for (int e = 0; e < 4; ++e) { hc = av[4 * sg + e] * hc + bv[4 * sg + e]; const int tk_ = 32 * tb + 8 * sg + 4 * hi + e; HST[tk_ * 64 + 4 * (((32 * cb + cl) >> 2) ^ (tk_ & 15)) + (cl & 3)] = hc; } }
            LDS_WAIT(); __builtin_amdgcn_s_barrier(); asm volatile("" ::: "memory");
            f32x4 hv[4];
#pragma unroll
            for (int q = 0; q < 4; ++q) hv[q] = *(const LAS f32x4*)(HST + tl * 64 + 4 * ((4 * cg + q) ^ (tl & 15)));
            v4u o0, o1;
            o0.x = pk2(hv[0][0] * bflo(gy0.x), hv[0][1] * bfhi(gy0.x)); o0.y = pk2(hv[0][2] * bflo(gy0.y), hv[0][3] * bfhi(gy0.y));
            o0.z = pk2(hv[1][0] * bflo(gy0.z), hv[1][1] * bfhi(gy0.z)); o0.w = pk2(hv[1][2] * bflo(gy0.w), hv[1][3] * bfhi(gy0.w));
            o1.x = pk2(hv[2][0] * bflo(gy1.x), hv[2][1] * bfhi(gy1.x)); o1.y = pk2(hv[2][2] * bflo(gy1.y), hv[2][3] * bfhi(gy1.y));
            o1.z = pk2(hv[3][0] * bflo(gy1.z), hv[3][1] * bfhi(gy1.z)); o1.w = pk2(hv[3][2] * bflo(gy1.w), hv[3][3] * bfhi(gy1.w));
            v4u* op = (v4u*)(HRG + (R0 + tl) * DM + ch0 + 16 * cg); op[0] = o0; op[1] = o1;
            if (comb_base >= 0) { comb_finish(P, cit, cb0); comb_finish(P, cit + 512, cb1); }
        }
    }
    if (tb == 0 && hi == 0) {
        float* T = WSP(float, WS_TAB) + b * 1024 + mych;
        if (!OUT) { T[TAB_SA] = astate; T[TAB_SB] = hstate; }
        else if (rg == 0) T[TAB_HC] = hstate;
        else if (rg == 2) P.out[pg8::O_LRUP + (size_t)b * 1024 + mych] = hstate;
    }
    __syncthreads();
}

__device__ __forceinline__ void lru_sample(const Ptrs& P, int gt) {
    const int b = __builtin_amdgcn_readfirstlane(gt >> 10), ch = gt & 1023, n = __builtin_amdgcn_readfirstlane(ch >> 6), o = ch & 63;
    const float* XBS = WSP(float, WS_XBS); const float* sc = P.in[7] + (size_t)b * 3 * 1024; const float* wcv = P.in[15]; const float* bcv = P.in[16];
    float za[4] = {0.f, 0.f, 0.f, 0.f}, zi[4] = {0.f, 0.f, 0.f, 0.f}, xo[4] = {0.f, 0.f, 0.f, 0.f};
    for (int i = 0; i < 64; ++i) { const int c = 64 * n + i;
        float xcat[7];
#pragma unroll
        for (int k = 0; k < 3; ++k) xcat[k] = sc[k * 1024 + c];
#pragma unroll
        for (int k = 0; k < 4; ++k) xcat[3 + k] = XBS[(size_t)(4 * b + k) * 1024 + c];
        const float w0 = wcv[c], w1 = wcv[1024 + c], w2 = wcv[2048 + c], w3 = wcv[3072 + c], bc = bcv[c];
        const float wa = P.in[17][(n * 64 + i) * 64 + o], wi = P.in[19][(n * 64 + i) * 64 + o];
#pragma unroll
        for (int t = 0; t < 4; ++t) { const float xc = bc + w0 * xcat[t] + w1 * xcat[t + 1] + w2 * xcat[t + 2] + w3 * xcat[t + 3];
            za[t] += xc * wa; zi[t] += xc * wi; xo[t] = (i == o) ? xc : xo[t]; } }
    const float ba = P.in[18][ch], bi = P.in[20][ch], c8l = WSP(float, WS_TAB)[2048 + ch] * 1.4426950408889634f;
    float h = P.in[8][(size_t)b * 1024 + ch];
    const bf16* GY = WSP(bf16, WS_GY); bf16* HRG = WSP(bf16, WS_HRG);
#pragma unroll
    for (int t = 0; t < 4; ++t) { const float r = sigm(za[t] + ba), ig = sigm(zi[t] + bi), a = fexp2(c8l * r);
        h = a * h + sqrtf(fmaxf(1.0f - a * a, 0.f)) * (ig * xo[t]);
        const size_t idx = (size_t)(MP + 4 * b + t) * DM + ch;
        HRG[idx] = (bf16)f2bf(h * __uint_as_float((unsigned)GY[idx] << 16)); }
    P.out[pg8::O_LRUS + (size_t)b * 1024 + ch] = h;
}

enum { SG_AMIX = 0, SG_MIX = 1, SG_X1 = 2, SG_UP = 3, SG_X2 = 4, SG_PE = 5, SG_Y = 6 };
constexpr size_t TAB_SSS1 = 32768, TAB_SSS2 = 40960;
template <int MODE, int N, int K> __device__ __forceinline__ void sgemm_tile(const Ptrs& P, LAS unsigned char* lds, int tile, const bf16* A, const bf16* Bt, int tid, int lane, int w) {
    constexpr int NTC = N / 64, NKS = K / 128;
    const int tr = tile / NTC, tc = tile % NTC, s0 = 32 * tr, c0 = 64 * tc;
    const int r = lane & 31, h = lane >> 5;
    const bf16* ap = A + (size_t)(MP + s0 + r) * K + w * (K / 8) + 8 * h;
    const bf16* bp0 = Bt + (size_t)(c0 + r) * K + w * (K / 8) + 8 * h; const bf16* bp1 = bp0 + (size_t)32 * K;
    f32x16 acc0, acc1;
#pragma unroll
    for (int i = 0; i < 16; ++i) { acc0[i] = 0.f; acc1[i] = 0.f; }
#pragma unroll 4
    for (int ks = 0; ks < NKS; ++ks) { const bf16x8 a = *(const bf16x8*)(ap + 16 * ks), b0 = *(const bf16x8*)(bp0 + 16 * ks), b1 = *(const bf16x8*)(bp1 + 16 * ks);
        acc0 = __builtin_amdgcn_mfma_f32_32x32x16_bf16(a, b0, acc0, 0, 0, 0); acc1 = __builtin_amdgcn_mfma_f32_32x32x16_bf16(a, b1, acc1, 0, 0, 0); }
    LAS float* PART = (LAS float*)lds;
#pragma unroll
    for (int i = 0; i < 16; ++i) { const int row = crow(i, h); PART[(w * 32 + row) * 64 + r] = acc0[i]; PART[(w * 32 + row) * 64 + 32 + r] = acc1[i]; }
    LDS_WAIT(); __syncthreads();
    const int row = tid >> 4, c4 = (tid & 15) * 4;
    f32x4 v = (f32x4){0.f, 0.f, 0.f, 0.f};
#pragma unroll
    for (int k = 0; k < 8; ++k) v += *(const LAS f32x4*)(PART + (k * 32 + row) * 64 + c4);
    const int s = s0 + row, col = c0 + c4; const size_t R = (size_t)MP + s; const size_t idx = R * DM + col;
    float* TAB = WSP(float, WS_TAB);
    if (MODE == SG_AMIX) { const v2u g = *(const v2u*)(WSP(bf16, WS_SGA) + idx); v2u o; o.x = pk2(bflo(g.x) * v[0], bfhi(g.x) * v[1]); o.y = pk2(bflo(g.y) * v[2], bfhi(g.y) * v[3]); *(v2u*)(WSP(bf16, WS_AMIX) + idx) = o; }
    else if (MODE == SG_MIX) { const v2u g = *(const v2u*)(WSP(bf16, WS_SGB) + idx), m = *(const v2u*)(WSP(bf16, WS_AMIX) + idx); v2u o;
        o.x = pk2(bflo(m.x) + bflo(g.x) * v[0], bfhi(m.x) + bfhi(g.x) * v[1]); o.y = pk2(bflo(m.y) + bflo(g.y) * v[2], bfhi(m.y) + bfhi(g.y) * v[3]); *(v2u*)(WSP(bf16, WS_MIX) + idx) = o; }
    else if (MODE == SG_X1 || MODE == SG_X2) { f32x4 x;
        if (MODE == SG_X1) x = *(const f32x4*)(P.in[1] + (size_t)s * DM + col); else { const v2u m = *(const v2u*)(WSP(bf16, WS_X1B) + idx); x = (f32x4){bflo(m.x), bfhi(m.x), bflo(m.y), bfhi(m.y)}; }
        const f32x4 y = x + v; v2u o; o.x = pk2(y[0], y[1]); o.y = pk2(y[2], y[3]); *(v2u*)(WSP(bf16, MODE == SG_X1 ? WS_X1B : WS_X2B) + idx) = o;
        float ss = (y[0] * y[0] + y[1] * y[1]) + (y[2] * y[2] + y[3] * y[3]); ss += __shfl_xor(ss, 1); ss += __shfl_xor(ss, 2); ss += __shfl_xor(ss, 4); ss += __shfl_xor(ss, 8);
        if ((tid & 15) == 0) TAB[(MODE == SG_X1 ? TAB_SSS1 : TAB_SSS2) + s * 16 + tc] = ss; }
    else if (MODE == SG_PE) { v2u o; o.x = pk2(v[0], v[1]); o.y = pk2(v[2], v[3]); *(v2u*)(WSP(bf16, WS_PEP) + idx) = o; }
    else { const f32x4* q = (const f32x4*)(TAB + (MODE == SG_UP ? TAB_SSS1 : TAB_SSS2) + s * 16); const f32x4 q0 = q[0], q1 = q[1], q2 = q[2], q3 = q[3];
        const float tot = ((q0[0] + q0[1]) + (q0[2] + q0[3])) + ((q1[0] + q1[1]) + (q1[2] + q1[3])) + ((q2[0] + q2[1]) + (q2[2] + q2[3])) + ((q3[0] + q3[1]) + (q3[2] + q3[3]));
        const float rs = 1.0f / sqrtf(tot * (1.0f / 1024.0f) + 1e-6f);
        if (MODE == SG_UP) { v2u o; float u0 = fmaxf(v[0] * rs, 0.f), u1 = fmaxf(v[1] * rs, 0.f), u2 = fmaxf(v[2] * rs, 0.f), u3 = fmaxf(v[3] * rs, 0.f);
            o.x = pk2(u0 * u0, u1 * u1); o.y = pk2(u2 * u2, u3 * u3); *(v2u*)(WSP(bf16, WS_U) + R * FF + col) = o; }
        else { const v2u m = *(const v2u*)(WSP(bf16, WS_X2B) + idx), pe = *(const v2u*)(WSP(bf16, WS_PEP) + idx);
            f32x4 y; y[0] = bflo(m.x) + sigm(v[0] * rs) * bflo(pe.x); y[1] = bfhi(m.x) + sigm(v[1] * rs) * bfhi(pe.x); y[2] = bflo(m.y) + sigm(v[2] * rs) * bflo(pe.y); y[3] = bfhi(m.y) + sigm(v[3] * rs) * bfhi(pe.y);
            *(f32x4*)(P.out + idx) = y; } }
    __syncthreads();
}
#if defined(PROBE_DUP)
#define MK_PROBE_BITS(s) ((s) & 24)
#else
#define MK_PROBE_BITS(s) 0
#endif
__device__ __forceinline__ int opq_s(int v) { v = __builtin_amdgcn_readfirstlane(v); asm volatile("" : "+s"(v)); return v; }
struct Args { const float* in[30]; float* out; unsigned char* ws; int ph_lo, ph_hi, li, sub; };
__global__ void __launch_bounds__(NWAVES * 64, 2) fwd_kernel(Args args) {
    extern __shared__ __attribute__((aligned(16))) unsigned char lds_raw[];
    LAS unsigned char* lds = (LAS unsigned char*)lds_raw;
    volatile LAS unsigned* MISC = (volatile LAS unsigned*)(lds + MISC_OFF);
    const int tid0 = threadIdx.x; const int wave0 = __builtin_amdgcn_readfirstlane(tid0 >> 6);
    const int G = gridDim.x, bx = blockIdx.x; const int vcu = (G % 8 == 0) ? (bx % 8) * (G / 8) + bx / 8 : bx;
    typedef __attribute__((address_space(4))) const Args* KArgs;
    KArgs ap0 = (KArgs)__builtin_amdgcn_kernarg_segment_ptr();
    gu32* ctl = (gu32*)(args.ws + WS_CTL);
    for (int u = tid0; u < 32; u += NWAVES * 64) MISC[u] = 0u;
    __syncthreads();
    XcdBarrier bar; bar.bar = (unsigned*)(ctl + CW_BAR) + args.li * XCD_BAR_WORDS; bar.x = 0; bar.st = nullptr;
    if (N_LAUNCHES != PER_PHASE) bar = xcd_barrier_post((unsigned*)(ctl + CW_BAR) + args.li * XCD_BAR_WORDS, MISC + 8);
#define GRID_BAR() do { if (N_LAUNCHES != PER_PHASE) xcd_barrier(bar); } while (0)
    const int lo = args.ph_lo, hi = args.ph_hi, sub = args.sub;
#ifndef PH_MASK
#define PH_MASK 0x1ff
#endif
#define IN(k) (((PH_MASK >> (k)) & 1) && lo <= (k) && (k) < hi)
#define BOTH(k) (IN(k) && IN((k) + 1))
    LAS float* XCH = (LAS float*)(lds + XCH_OFF);
    const int NT = G * NWAVES * 64;

#define LOAD_P() KArgs ap = ap0; asm volatile("" : "+s"(ap)); Ptrs P; _Pragma("unroll") for (int i_ = 0; i_ < 30; ++i_) P.in[i_] = ap->in[i_]; P.out = ap->out; P.ws = ap->ws
#define OPAQUE_TID2() int tid; asm volatile("v_mbcnt_lo_u32_b32 %0, -1, 0\n\tv_mbcnt_hi_u32_b32 %0, -1, %0" : "=v"(tid)); tid |= wave0 << 6; const int lane = tid & 63, wave = wave0
#define OPAQUE_TID() LOAD_P(); int tid; asm volatile("v_mbcnt_lo_u32_b32 %0, -1, 0\n\tv_mbcnt_hi_u32_b32 %0, -1, %0" : "=v"(tid)); tid |= wave0 << 6; const int lane = tid & 63, wave = wave0; const int gt = vcu * (NWAVES * 64) + tid
    if (IN(0)) { OPAQUE_TID(); p0_prologue(P, lds, tid, lane, wave, vcu, G); if (BOTH(0)) GRID_BAR(); }

    if (IN(1)) {
        LOAD_P();
        pg8::Gemm g{WSP(pg8::bf16_t, WS_HB), WSP(pg8::bf16_t, WS_WIN), M, NIN, DM}; pg8::StaticOrder S; S.init(M, NIN, G, opq_s(blockIdx.x));
        pg8::Epi1 E{P.ws, P.out, P.in[12], P.in[13], XCH, MK_PROBE_BITS(sub)};
        pg8::gemm_phase<pg8::Epi1, pg8::StaticOrder, true, true>(lds + RING_OFF, g, S, E, wave0);
        if (BOTH(1)) GRID_BAR();
    }

    if (IN(2)) {
        OPAQUE_TID();
        { const float* TAB = WSP(float, WS_TAB); for (int e = tid; e < 12 * 132; e += NWAVES * 64) XCH[e] = TAB[e]; }
        LDS_WAIT(); __syncthreads();
#define TASK_LOOP(QI, NTASK, BODY) { gu32* qw = ctl + CW_Q + 64 * (4 * args.li + (QI)); volatile LAS unsigned* QT = MISC + 16; unsigned nxt = 0u; \
          if (tid == 0) nxt = __hip_atomic_fetch_add(qw, 1u, RLX_AGENT); \
          for (;;) { if (tid == 0) QT[0] = nxt; LDS_WAIT(); __syncthreads(); const int task = (int)__builtin_amdgcn_readfirstlane(QT[0]); __syncthreads(); if (task >= (NTASK)) break; \
              if (tid == 0) nxt = __hip_atomic_fetch_add(qw, 1u, RLX_AGENT); BODY } }
        if (sub & 1) TASK_LOOP(0, 128, lru_unit<true>(P, lds, task >> 4, task & 15, 0, tid, lane, wave);)
        if (sub & 1) TASK_LOOP(3, 128, lru_unit<false>(P, lds, task >> 4, task & 15, 1, tid, lane, wave);)
        if (sub & 2) TASK_LOOP(1, 512, sattn_unit(P, lds, task, tid, lane, wave);)
        if (sub & 4) TASK_LOOP(2, 1536, attn_run(P, lds, 4 * task, 4, tid, lane, wave);)
#undef TASK_LOOP
        if (BOTH(2)) GRID_BAR();
    }

    if (IN(3)) {
        OPAQUE_TID();
        if (sub & 1) for (int u = vcu; u < 256; u += G) lru_unit<true>(P, lds, u >> 5, (u >> 1) & 15, 1 + (u & 1), tid, lane, wave, 16 * u);
        if (sub & 2) for (int t = gt; t < DBATCH * 1024; t += NT) lru_sample(P, t);
        if (BOTH(3)) GRID_BAR();
    }

    if (IN(4)) {
        LOAD_P();
        { OPAQUE_TID2();
          for (int t = vcu; t < 256; t += G) sgemm_tile<SG_AMIX, DM, MW>(P, lds, t, WSP(bf16, WS_ATT), WSP(bf16, WS_WOA), tid, lane, wave);
          for (int t = vcu; t < 256; t += G) sgemm_tile<SG_MIX, DM, DM>(P, lds, t, WSP(bf16, WS_HRG), WSP(bf16, WS_WOB), tid, lane, wave); }
        { pg8::Gemm g{WSP(pg8::bf16_t, WS_ATT), WSP(pg8::bf16_t, WS_WOA), MP, DM, MW}; pg8::StaticOrder S; S.init(MP, DM, G, opq_s(blockIdx.x));
          pg8::Epi2<pg8::E_AMIX> E{WSP(pg8::bf16_t, WS_SGA), nullptr, WSP(pg8::bf16_t, WS_AMIX), nullptr, nullptr, nullptr, nullptr, nullptr, XCH, 0};
          pg8::gemm_phase<pg8::Epi2<pg8::E_AMIX>, pg8::StaticOrder, true, true>(lds + RING_OFF, g, S, E, wave0); }
        VM_WAIT(); __syncthreads();
        { pg8::Gemm g{WSP(pg8::bf16_t, WS_HRG), WSP(pg8::bf16_t, WS_WOB), MP, DM, DM}; pg8::StaticOrder S; S.init(MP, DM, G, opq_s(blockIdx.x));
          pg8::Epi2<pg8::E_MIX> E{WSP(pg8::bf16_t, WS_SGB), WSP(pg8::bf16_t, WS_AMIX), WSP(pg8::bf16_t, WS_MIX), nullptr, nullptr, nullptr, nullptr, nullptr, XCH, 0};
          pg8::gemm_phase<pg8::Epi2<pg8::E_MIX>, pg8::StaticOrder, true, true>(lds + RING_OFF, g, S, E, wave0); }
        if (BOTH(4)) GRID_BAR();
    }

    if (IN(5)) {
        LOAD_P();
        { OPAQUE_TID2(); for (int t = vcu; t < 256; t += G) sgemm_tile<SG_X1, DM, DM>(P, lds, t, WSP(bf16, WS_MIX), WSP(bf16, WS_WO), tid, lane, wave); }
        pg8::Gemm g{WSP(pg8::bf16_t, WS_MIX), WSP(pg8::bf16_t, WS_WO), MP, DM, DM}; pg8::StaticOrder S; S.init(MP, DM, G, opq_s(blockIdx.x));
        pg8::Epi2<pg8::E_X1> E{nullptr, nullptr, WSP(pg8::bf16_t, WS_X1B), nullptr, P.in[0], P.in[1], WSP(float, WS_SS1), nullptr, XCH, 0};
        pg8::gemm_phase<pg8::Epi2<pg8::E_X1>, pg8::StaticOrder, true, true>(lds + RING_OFF, g, S, E, wave0);
        if (BOTH(5)) GRID_BAR();
    }

    if (IN(6)) {
        LOAD_P();
        { OPAQUE_TID2(); for (int t = vcu; t < 1024; t += G) sgemm_tile<SG_UP, FF, DM>(P, lds, t, WSP(bf16, WS_X1B), WSP(bf16, WS_WUP), tid, lane, wave); }
        pg8::Gemm g{WSP(pg8::bf16_t, WS_X1B), WSP(pg8::bf16_t, WS_WUP), MP, FF, DM}; pg8::StaticOrder S; S.init(MP, FF, G, opq_s(blockIdx.x));
        pg8::Epi2<pg8::E_UP> E{nullptr, nullptr, WSP(pg8::bf16_t, WS_U), nullptr, nullptr, nullptr, nullptr, WSP(float, WS_SS1), XCH, MK_PROBE_BITS(sub)};
        pg8::gemm_phase<pg8::Epi2<pg8::E_UP>, pg8::StaticOrder, true, true>(lds + RING_OFF, g, S, E, wave0);
        if (BOTH(6)) GRID_BAR();
    }

    if (IN(7)) {
        LOAD_P();
        { OPAQUE_TID2(); for (int t = vcu; t < 256; t += G) sgemm_tile<SG_X2, DM, FF>(P, lds, t, WSP(bf16, WS_U), WSP(bf16, WS_WDN), tid, lane, wave); }
        pg8::Gemm g{WSP(pg8::bf16_t, WS_U), WSP(pg8::bf16_t, WS_WDN), MP, DM, FF}; pg8::StaticOrder S; S.init(MP, DM, G, opq_s(blockIdx.x));
        pg8::Epi2<pg8::E_X2> E{WSP(pg8::bf16_t, WS_X1B), nullptr, WSP(pg8::bf16_t, WS_X2B), nullptr, nullptr, nullptr, WSP(float, WS_SS2), nullptr, XCH, 0};
        pg8::gemm_phase<pg8::Epi2<pg8::E_X2>, pg8::StaticOrder, true, true>(lds + RING_OFF, g, S, E, wave0);
        if (BOTH(7)) GRID_BAR();
    }

    if (IN(8)) {
        LOAD_P();
        { OPAQUE_TID2();
          for (int t = vcu; t < 256; t += G) sgemm_tile<SG_PE, DM, PLE>(P, lds, t, WSP(bf16, WS_PB), WSP(bf16, WS_WPE), tid, lane, wave);
          for (int t = vcu; t < 256; t += G) sgemm_tile<SG_Y, DM, DM>(P, lds, t, WSP(bf16, WS_X2B), WSP(bf16, WS_WPG), tid, lane, wave); }
        { pg8::Gemm g{WSP(pg8::bf16_t, WS_PB), WSP(pg8::bf16_t, WS_WPE), MP, DM, PLE}; pg8::StaticOrder S; S.init(MP, DM, G, opq_s(blockIdx.x));
          pg8::Epi2<pg8::E_PE> E{nullptr, nullptr, WSP(pg8::bf16_t, WS_PEP), nullptr, nullptr, nullptr, nullptr, nullptr, XCH, 0};
          pg8::gemm_phase<pg8::Epi2<pg8::E_PE>, pg8::StaticOrder, true, true>(lds + RING_OFF, g, S, E, wave0); }
        VM_WAIT(); __syncthreads();
        { pg8::Gemm g{WSP(pg8::bf16_t, WS_X2B), WSP(pg8::bf16_t, WS_WPG), MP, DM, DM}; pg8::StaticOrder S; S.init(MP, DM, G, opq_s(blockIdx.x));
          pg8::Epi2<pg8::E_Y> E{WSP(pg8::bf16_t, WS_PEP), WSP(pg8::bf16_t, WS_X2B), nullptr, P.out, nullptr, nullptr, nullptr, WSP(float, WS_SS2), XCH, 0};
          pg8::gemm_phase<pg8::Epi2<pg8::E_Y>, pg8::StaticOrder, true, true>(lds + RING_OFF, g, S, E, wave0); }
    }
#undef IN
#undef BOTH
#undef GRID_BAR
}

extern "C" void kernel_launch(void* const* d_in, const int* in_sizes, int n_in, void* d_out, int out_size, void* d_ws, size_t ws_size, hipStream_t stream) {
    static int grid = 0;
    if (grid == 0) {
        if (n_in != 30 || in_sizes[0] != MP * DM || out_size != (int)pg8::O_END || ws_size < WS_END) {
            fprintf(stderr, "kernel_launch: unexpected shapes (n_in %d, in0 %d, out %d, ws %zu, need %zu); nothing launched\n", n_in, n_in > 0 ? in_sizes[0] : -1, out_size, ws_size, (size_t)WS_END); grid = -1; return; }
        int dev = 0, cus = 0, per_cu = 0;
        if (hipGetDevice(&dev) != hipSuccess || hipDeviceGetAttribute(&cus, hipDeviceAttributeMultiprocessorCount, dev) != hipSuccess) { grid = -1; return; }
        if (hipFuncSetAttribute((const void*)fwd_kernel, hipFuncAttributeMaxDynamicSharedMemorySize, LDS_BYTES) != hipSuccess) { fprintf(stderr, "kernel_launch: hipFuncSetAttribute failed\n"); grid = -1; return; }
        if (hipOccupancyMaxActiveBlocksPerMultiprocessor(&per_cu, (const void*)fwd_kernel, NWAVES * 64, LDS_BYTES) != hipSuccess || per_cu < 1)
            fprintf(stderr, "kernel_launch: note: occupancy query reports %d workgroups per CU\n", per_cu);
        (void)hipGetLastError();
        grid = cus;
    }
    if (grid < 0) return;
    if (hipMemsetAsync((char*)d_ws + WS_CTL, 0, CTL_ZERO_BYTES, stream) != hipSuccess) { fprintf(stderr, "kernel_launch: hipMemsetAsync failed\n"); return; }
    Args a{};
    for (int i = 0; i < 30; ++i) a.in[i] = (const float*)d_in[i];
    a.out = (float*)d_out; a.ws = (unsigned char*)d_ws;
#if defined(PROBE_DUP)
    const int cut[4] = {0, PROBE_DUP + 1, PROBE_DUP + 1, PER_PHASE};
    for (int li = 0; li < 3; ++li) {
        a.ph_lo = (li == 1) ? PROBE_DUP : cut[li]; a.ph_hi = (li == 1) ? PROBE_DUP + 1 : cut[li + 1]; a.li = li; a.sub = (li == 1) ? PROBE_SUB : 7;
        if (a.ph_lo >= a.ph_hi) continue;
        hipLaunchKernelGGL(fwd_kernel, dim3(grid), dim3(NWAVES * 64), LDS_BYTES, stream, a);
    }
#else
    for (int li = 0; li < N_LAUNCHES; ++li) {
        a.ph_lo = (N_LAUNCHES == PER_PHASE) ? li : 0; a.ph_hi = (N_LAUNCHES == PER_PHASE) ? li + 1 : PER_PHASE; a.li = (N_LAUNCHES == PER_PHASE) ? 0 : li; a.sub = 7;
        hipLaunchKernelGGL(fwd_kernel, dim3(grid), dim3(NWAVES * 64), LDS_BYTES, stream, a);
        const hipError_t le = hipPeekAtLastError();
        if (le != hipSuccess) { fprintf(stderr, "kernel_launch: launch %d failed: %s\n", li, hipGetErrorName(le)); break; }
    }
#endif
}
```

```cpp
#include <hip/hip_runtime.h>
#include <cstdio>
#include <cstdint>
#include <cmath>
#define MK_N_LAUNCHES 1

constexpr int NWAVES = 8;
#ifndef MK_N_LAUNCHES
#define MK_N_LAUNCHES 1
#endif
constexpr int N_LAUNCHES = MK_N_LAUNCHES;
constexpr int PER_PHASE = 9;

constexpr int DM = 1024, NBATCH = 8, SEQ = 8192, DBATCH = 128, DSEQ = 4;
constexpr int MP = NBATCH * SEQ, MS = DBATCH * DSEQ, M = MP + MS;
constexpr int NIN = 8704, FF = 4096, PLE = 256, AW = 1536, MW = 512;
static_assert(M % 256 == 0 && NIN % 256 == 0, "tile shapes");

constexpr size_t MiB = 1u << 20;
constexpr size_t al(size_t x) { return (x + MiB - 1) / MiB * MiB; }
constexpr size_t WS_CTL = 0, CTL_ZERO_BYTES = 1 * MiB;
constexpr size_t WS_WIN = 1 * MiB;
constexpr size_t WS_WOA = WS_WIN + al((size_t)NIN * DM * 2);
constexpr size_t WS_WOB = WS_WOA + al((size_t)DM * MW * 2);
constexpr size_t WS_WO = WS_WOB + al((size_t)DM * DM * 2);
constexpr size_t WS_WUP = WS_WO + al((size_t)DM * DM * 2);
constexpr size_t WS_WDN = WS_WUP + al((size_t)FF * DM * 2);
constexpr size_t WS_WPG = WS_WDN + al((size_t)FF * DM * 2);
constexpr size_t WS_WPE = WS_WPG + al((size_t)DM * DM * 2);
constexpr size_t WS_WRG = WS_WPE + al((size_t)DM * PLE * 2);
constexpr size_t WS_TAB = WS_WRG + MiB;
constexpr size_t WS_HB = WS_TAB + MiB;
constexpr size_t ACT = al((size_t)M * DM * 2);
constexpr size_t WS_Q = WS_HB + ACT;
constexpr size_t QKV = (size_t)MP * AW * 2;
constexpr size_t WS_K = WS_Q + QKV, WS_V = WS_K + QKV;
constexpr size_t WS_XB = WS_V + QKV, WS_GY = WS_XB + ACT, WS_SGA = WS_GY + ACT, WS_SGB = WS_SGA + ACT;
constexpr size_t WS_QS = WS_SGB + ACT;
constexpr size_t WS_XBS = WS_QS + al((size_t)MS * AW * 4);
constexpr size_t WS_OG = WS_XBS + al((size_t)MS * DM * 4);
constexpr size_t WS_LSE = WS_OG + al((size_t)3 * MP * MW * 2);
constexpr size_t WS_ATT = WS_LSE + al((size_t)3 * MP * 4 * 4);
constexpr size_t WS_HRG = WS_ATT + al((size_t)M * MW * 2);
constexpr size_t WS_AMIX = WS_HRG + ACT, WS_MIX = WS_AMIX + ACT, WS_X1B = WS_MIX + ACT, WS_X2B = WS_X1B + ACT;
constexpr size_t WS_U = WS_X2B + ACT;
constexpr size_t WS_PB = WS_U + al((size_t)M * FF * 2);
constexpr size_t WS_PEP = WS_PB + al((size_t)M * PLE * 2);
constexpr size_t WS_SS1 = WS_PEP + ACT;
constexpr size_t WS_SS2 = WS_SS1 + al((size_t)M * 4 * 4);
constexpr size_t WS_DUMP = WS_SS2 + al((size_t)M * 4 * 4);
constexpr size_t WS_END = WS_DUMP + 32 * MiB;
constexpr int CW_Q = 16384;
constexpr int CW_BAR = 4096;

constexpr int RING_OFF = 0, RING_BYTES = 131072;
constexpr int XCH_OFF = 131072;
constexpr int MISC_OFF = 139264;
constexpr int LDS_BYTES = 147456;

#define GAS __attribute__((address_space(1)))
#define LAS __attribute__((address_space(3)))
typedef unsigned short bf16;
typedef unsigned v4u __attribute__((ext_vector_type(4)));
typedef unsigned v2u __attribute__((ext_vector_type(2)));
typedef float f32x4 __attribute__((ext_vector_type(4)));
typedef float f32x16 __attribute__((ext_vector_type(16)));
typedef short bf16x8 __attribute__((ext_vector_type(8)));
typedef short s16x4 __attribute__((ext_vector_type(4)));
typedef GAS unsigned gu32;
#define RLX_AGENT __ATOMIC_RELAXED, __HIP_MEMORY_SCOPE_AGENT
#define LDS_WAIT() asm volatile("s_waitcnt lgkmcnt(0)" ::: "memory")
#define VM_WAIT() asm volatile("s_waitcnt vmcnt(0)" ::: "memory")
__device__ __forceinline__ unsigned f2bf(float f) { unsigned u = __builtin_bit_cast(unsigned, f); return (u + 0x7fffu + ((u >> 16) & 1u)) >> 16; }
typedef float f32x2_t __attribute__((ext_vector_type(2))); typedef __bf16 bf16x2_t __attribute__((ext_vector_type(2)));
__device__ __forceinline__ unsigned pk2(float lo, float hi) { f32x2_t v = {lo, hi}; bf16x2_t b = __builtin_convertvector(v, bf16x2_t); return __builtin_bit_cast(unsigned, b); }
__device__ __forceinline__ float bflo(unsigned w) { return __uint_as_float(w << 16); }
__device__ __forceinline__ float bfhi(unsigned w) { return __uint_as_float(w & 0xffff0000u); }
__device__ __forceinline__ float fexp2(float x) { return __builtin_amdgcn_exp2f(x); }
__device__ __forceinline__ float frcp(float x) { return __builtin_amdgcn_rcpf(x); }
__device__ __forceinline__ float sigm(float x) { return frcp(1.0f + fexp2(-1.4426950408889634f * x)); }
namespace pg8 {
#define PG8_LAS __attribute__((address_space(3)))
typedef unsigned short bf16_t;
typedef short bf16x8 __attribute__((ext_vector_type(8)));
typedef float f32x4 __attribute__((ext_vector_type(4)));
typedef unsigned u32x4 __attribute__((ext_vector_type(4)));
constexpr int BM = 256, BK = 64, HALF = 128, HTB = HALF * BK * 2  , STAGE_BYTES = 8 * HTB, NXCD = 8, WGM = 4;

__host__ __device__ __forceinline__ int lds_byte(int r, int c) { const int st = (r >> 4) * 2 + (c >> 5), rr = r & 15, cc = c & 31, ob = rr * 64 + cc * 2; return st * 1024 + (ob ^ (((ob >> 9) & 1) << 5)); }
__host__ __device__ __forceinline__ void stage_rc(int b, int& R, int& C) { const int st = b / 1024, sb = b % 1024, swz = sb ^ (((sb >> 9) & 1) << 5); R = (st >> 1) * 16 + swz / 64; C = (st & 1) * 32 + (swz % 64) / 2; }
__host__ __device__ __forceinline__ int perm32(int rho) { const int n = rho >> 4, i = rho & 15; return 8 * (i >> 2) + 4 * n + (i & 3); }

struct Unit { int pm, pn; };
struct Gemm { const bf16_t* A; const bf16_t* Bt; int M, N, K; };

struct StaticOrder {
    int nM, nN, nwg, G, c;
    __host__ __device__ void init(int M, int N, int G_, int c_) { nM = M / BM; nN = N / BM; nwg = nM * nN; G = G_; c = c_; }
    __host__ __device__ bool next(int i, Unit& u) const {
        const long L = (long)i * G + c; if (L >= nwg) return false;
        int wgid = (int)L; { const int q = nwg / NXCD, r = nwg % NXCD, xcd = wgid % NXCD, off = wgid / NXCD; wgid = (xcd < r ? xcd * (q + 1) : r * (q + 1) + (xcd - r) * q) + off; }
        const int nig = WGM * nN, gid = wgid / nig, fm = gid * WGM, gsz = (nM - fm) < WGM ? (nM - fm) : WGM;
        u.pm = fm + ((wgid % nig) % gsz); u.pn = (wgid % nig) / gsz; return true;
    }
    __device__ __forceinline__ void a_ready(const Unit&) const {}
    __device__ __forceinline__ void done(const Unit&) const {}
};
__device__ __forceinline__ unsigned cvt_pk_bf16(float lo, float hi) { unsigned r; asm volatile("v_cvt_pk_bf16_f32 %0, %1, %2" : "=v"(r) : "v"(lo), "v"(hi)); return r; }
typedef float f32x2 __attribute__((ext_vector_type(2)));
typedef unsigned u32x2 __attribute__((ext_vector_type(2)));
constexpr float RMS_EPS = 1e-6f;
constexpr float QSCALE = 0.08838834764831845f * 1.4426950408889634f;
constexpr size_t O_YP = 0, O_YS = 67108864, O_KV1P = 67633152, O_KV2P = 68681728, O_KV3P = 72876032, O_CONVP = 89653248, O_LRUP = 89677824,
                 O_KV1S = 89686016, O_KV2S = 90210304, O_KV3S = 90734592, O_CONVS = 91258880, O_LRUS = 91652096, O_END = 91783168;
__device__ __forceinline__ size_t kvp_off(int g) { return g == 0 ? O_KV1P : (g == 1 ? O_KV2P : O_KV3P); }
__device__ __forceinline__ size_t kvs_off(int g) { return g == 0 ? O_KV1S : (g == 1 ? O_KV2S : O_KV3S); }

__device__ __forceinline__ float fsigmoid(float x) { return __builtin_amdgcn_rcpf(1.0f + __builtin_amdgcn_exp2f(-1.4426950408889634f * x)); }
__device__ __forceinline__ float fgelu_tanh(float x) { const float u = x + 0.044715f * x * x * x; return x * __builtin_amdgcn_rcpf(1.0f + __builtin_amdgcn_exp2f(-2.3022082232f * u)); }
__device__ __forceinline__ float bf_lo(unsigned w) { return __uint_as_float(w << 16); }
__device__ __forceinline__ float bf_hi(unsigned w) { return __uint_as_float(w & 0xffff0000u); }
__device__ __forceinline__ u32x4 pack8(const f32x4& a, const f32x4& b) { u32x4 w; w.x = cvt_pk_bf16(a[0], a[1]); w.y = cvt_pk_bf16(a[2], a[3]); w.z = cvt_pk_bf16(b[0], b[1]); w.w = cvt_pk_bf16(b[2], b[3]); return w; }
__device__ __forceinline__ void unpack8(const u32x4& w, f32x4& a, f32x4& b) { a = (f32x4){bf_lo(w.x), bf_hi(w.x), bf_lo(w.y), bf_hi(w.y)}; b = (f32x4){bf_lo(w.z), bf_hi(w.z), bf_lo(w.w), bf_hi(w.w)}; }
__device__ __forceinline__ float sq8(const f32x4& a, const f32x4& b) { return (a[0] * a[0] + a[1] * a[1]) + (a[2] * a[2] + a[3] * a[3]) + (b[0] * b[0] + b[1] * b[1]) + (b[2] * b[2] + b[3] * b[3]); }

__device__ __forceinline__ void rowss_exchange(float (&ss)[2][4][2], PG8_LAS float* P, int wr, int wc, int fr, int fq) {
#pragma unroll
    for (int ai = 0; ai < 2; ++ai)
#pragma unroll
        for (int m = 0; m < 4; ++m)
#pragma unroll
            for (int bj = 0; bj < 2; ++bj) { float s = ss[ai][m][bj]; s += __shfl_xor(s, 16); s += __shfl_xor(s, 32);
                if (fq == 0) P[(ai * HALF + wr * 64 + m * 16 + fr) * 8 + bj * 4 + wc] = s; }
    asm volatile("s_waitcnt lgkmcnt(0)" ::: "memory"); __builtin_amdgcn_s_barrier(); asm volatile("" ::: "memory");
#pragma unroll
    for (int ai = 0; ai < 2; ++ai)
#pragma unroll
        for (int m = 0; m < 4; ++m) { const PG8_LAS f32x4* p = (const PG8_LAS f32x4*)(P + (ai * HALF + wr * 64 + m * 16 + fr) * 8);
            const f32x4 a = p[0], b = p[1]; ss[ai][m][0] = (a[0] + a[1]) + (a[2] + a[3]); ss[ai][m][1] = (b[0] + b[1]) + (b[2] + b[3]); }
}

struct Epi1 {
    static constexpr bool PERM = true, AFTER_DRAIN = false; static constexpr int NST = 16;
    unsigned char* ws; float* out; const PG8_LAS float* gl; PG8_LAS float* P; int probe;
    __device__ __forceinline__ void operator()(const f32x4 (&acc)[2][2][4][2], const Unit& u, int wr, int wc, int fr, int fq) const {
        if (probe & 16) return;
        const int pn = u.pn; const bool sample = u.pm >= 256;
        asm volatile("" : "+v"(fr), "+v"(fq));
        const int colw = wc * 32 + fq * 8;
        const int row0 = u.pm * BM + wr * 64 + fr;
        if (pn < 12) {
            const bool isq = pn < 6; const int hbase = 2 * (isq ? pn : pn - 6);
            float ss[2][4][2];
#pragma unroll
            for (int ai = 0; ai < 2; ++ai)
#pragma unroll
                for (int m = 0; m < 4; ++m)
#pragma unroll
                    for (int bj = 0; bj < 2; ++bj) ss[ai][m][bj] = sq8(acc[ai][bj][m][0], acc[ai][bj][m][1]);
            rowss_exchange(ss, P, wr, wc, fr, fq);
            const f32x4 gq0 = *(const PG8_LAS f32x4*)(gl + colw), gq1 = *(const PG8_LAS f32x4*)(gl + colw + 4), gk0 = *(const PG8_LAS f32x4*)(gl + 128 + colw), gk1 = *(const PG8_LAS f32x4*)(gl + 128 + colw + 4);
            f32x4 g0, g1;
#pragma unroll
            for (int e = 0; e < 4; ++e) { g0[e] = isq ? gq0[e] * QSCALE : gk0[e]; g1[e] = isq ? gq1[e] * QSCALE : gk1[e]; }
            bf16_t* const QK = (bf16_t*)(ws + (isq ? WS_Q : WS_K)); float* const QS = (float*)(ws + WS_QS);
#pragma unroll
            for (int ai = 0; ai < 2; ++ai)
#pragma unroll
                for (int m = 0; m < 4; ++m) { const int R = row0 + ai * HALF + m * 16;
#pragma unroll
                    for (int bj = 0; bj < 2; ++bj) { const int hh = hbase + bj, grp = hh >> 2, gsh = 2 * grp;
                        const float rs = __builtin_amdgcn_rsqf(ss[ai][m][bj] * (1.0f / 128.0f) + RMS_EPS);
                        const f32x4 v0 = acc[ai][bj][m][0] * rs * g0, v1 = acc[ai][bj][m][1] * rs * g1;
                        if (!sample) { const int b = R >> 13, t = R & 8191; const int rr = t & ((1 << gsh) - 1), mm = t >> gsh;
                            const size_t rowp = ((size_t)(b * 12 + hh) << 13) + (size_t)(rr << (13 - gsh)) + mm;
                            { const u32x4 w_ = pack8(v0, v1); if (!(probe & 8) || w_.x == 0x7fc17fc1u) *(u32x4*)(QK + rowp * 128 + colw) = w_; }
                            if (!isq) { const int W = 128 << gsh, trel = t - (8192 - W);
                                if (trel >= 0) { float* o = out + kvp_off(grp) + ((((size_t)b * W + trel) * 2 + 0) * 4 + (hh & 3)) * 128 + colw; *(f32x4*)o = v0; *(f32x4*)(o + 4) = v1; } }
                        } else { const int s = R - MP;
                            float* o = isq ? QS + (size_t)s * 1536 + hh * 128 + colw : out + kvs_off(grp) + (((size_t)s * 2 + 0) * 4 + (hh & 3)) * 128 + colw;
                            *(f32x4*)o = v0; *(f32x4*)(o + 4) = v1; } } }
        } else if (pn < 18) {
            const int hbase = 2 * (pn - 12); bf16_t* const V = (bf16_t*)(ws + WS_V);
#pragma unroll
            for (int ai = 0; ai < 2; ++ai)
#pragma unroll
                for (int m = 0; m < 4; ++m) { const int R = row0 + ai * HALF + m * 16;
#pragma unroll
                    for (int bj = 0; bj < 2; ++bj) { const int hh = hbase + bj, grp = hh >> 2, gsh = 2 * grp;
                        const f32x4 v0 = acc[ai][bj][m][0], v1 = acc[ai][bj][m][1];
                        if (!sample) { const int b = R >> 13, t = R & 8191; const int rr = t & ((1 << gsh) - 1), mm = t >> gsh;
                            const size_t rowp = ((size_t)(b * 12 + hh) << 13) + (size_t)(rr << (13 - gsh)) + mm;
                            { const u32x4 w_ = pack8(v0, v1); if (!(probe & 8) || w_.x == 0x7fc17fc1u) *(u32x4*)(V + rowp * 128 + colw) = w_; }
                            const int W = 128 << gsh, trel = t - (8192 - W);
                            if (trel >= 0) { float* o = out + kvp_off(grp) + ((((size_t)b * W + trel) * 2 + 1) * 4 + (hh & 3)) * 128 + colw; *(f32x4*)o = v0; *(f32x4*)(o + 4) = v1; }
                        } else { const int s = R - MP;
                            float* o = out + kvs_off(grp) + (((size_t)s * 2 + 1) * 4 + (hh & 3)) * 128 + colw; *(f32x4*)o = v0; *(f32x4*)(o + 4) = v1; } } }
        } else if (pn < 22) {
            const int cb = (pn - 18) * BM + colw; bf16_t* const XB = (bf16_t*)(ws + WS_XB); float* const XBS = (float*)(ws + WS_XBS);
#pragma unroll
            for (int ai = 0; ai < 2; ++ai)
#pragma unroll
                for (int m = 0; m < 4; ++m) { const int R = row0 + ai * HALF + m * 16;
#pragma unroll
                    for (int bj = 0; bj < 2; ++bj) { const int col = cb + bj * HALF; const f32x4 v0 = acc[ai][bj][m][0], v1 = acc[ai][bj][m][1];
                        if (!sample) { const int b = R >> 13, t = R & 8191;
                            { const u32x4 w_ = pack8(v0, v1); if (!(probe & 8) || w_.x == 0x7fc17fc1u) *(u32x4*)(XB + (size_t)R * 1024 + col) = w_; }
                            if (t >= 8189) { float* o = out + O_CONVP + ((size_t)b * 3 + (t - 8189)) * 1024 + col; *(f32x4*)o = v0; *(f32x4*)(o + 4) = v1; }
                        } else { const int s = R - MP, b = s >> 2, t = s & 3;
                            float* o = XBS + (size_t)s * 1024 + col; *(f32x4*)o = v0; *(f32x4*)(o + 4) = v1;
                            if (t >= 1) { float* o2 = out + O_CONVS + ((size_t)b * 3 + (t - 1)) * 1024 + col; *(f32x4*)o2 = v0; *(f32x4*)(o2 + 4) = v1; } } } }
        } else {
            const int seg = (pn - 22) >> 2; const int cb = ((pn - 22) & 3) * BM + colw; bf16_t* const dst = (bf16_t*)(ws + (seg == 0 ? WS_GY : (seg == 1 ? WS_SGA : WS_SGB)));
#pragma unroll
            for (int ai = 0; ai < 2; ++ai)
#pragma unroll
                for (int m = 0; m < 4; ++m) { const int R = row0 + ai * HALF + m * 16;
#pragma unroll
                    for (int bj = 0; bj < 2; ++bj) { const int col = cb + bj * HALF; f32x4 v0 = acc[ai][bj][m][0], v1 = acc[ai][bj][m][1];
                        if (seg == 0) {
#pragma unroll
                            for (int e = 0; e < 4; ++e) { v0[e] = fgelu_tanh(v0[e]); v1[e] = fgelu_tanh(v1[e]); }
                        } else {
#pragma unroll
                            for (int e = 0; e < 4; ++e) { v0[e] = fsigmoid(v0[e]); v1[e] = fsigmoid(v1[e]); }
                        }
                        { const u32x4 w_ = pack8(v0, v1); if (!(probe & 8) || w_.x == 0x7fc17fc1u) *(u32x4*)(dst + (size_t)R * 1024 + col) = w_; } } }
        }
    }
};

enum { E_AMIX = 0, E_MIX = 1, E_X1 = 2, E_UP = 3, E_X2 = 4, E_PE = 5, E_Y = 6 };
template <int MODE> struct Epi2 {
    static constexpr bool PERM = true, AFTER_DRAIN = false; static constexpr int NST = (MODE == E_Y) ? 32 : 16;
    const bf16_t* g1; const bf16_t* g2; bf16_t* o1; float* of; const float* xp; const float* xs; float* ss_out; const float* ss_in; PG8_LAS float* P; int probe;
    static constexpr int NG = (MODE == E_MIX || MODE == E_X1 || MODE == E_Y) ? 2 : 1, GA = 2 / NG;
    __device__ __forceinline__ void operator()(const f32x4 (&acc)[2][2][4][2], const Unit& u, int wr, int wc, int fr, int fq) const {
        if (probe & 16) return;
        asm volatile("" : "+v"(fr), "+v"(fq));
        const int colw = u.pn * BM + wc * 32 + fq * 8; const int row0 = u.pm * BM + wr * 64 + fr;
        if constexpr (MODE == E_UP) {
            f32x4 SQ[2][4];
#pragma unroll
            for (int ai = 0; ai < 2; ++ai)
#pragma unroll
                for (int m = 0; m < 4; ++m) SQ[ai][m] = *(const f32x4*)(ss_in + (size_t)(row0 + ai * HALF + m * 16) * 4);
            f32x4 (&w)[2][2][4][2] = const_cast<f32x4 (&)[2][2][4][2]>(acc);
#pragma unroll
            for (int ai = 0; ai < 2; ++ai)
#pragma unroll
                for (int bj = 0; bj < 2; ++bj)
#pragma unroll
                    for (int m = 0; m < 4; ++m)
#pragma unroll
                        for (int n = 0; n < 2; ++n)
#pragma unroll
                            for (int e = 0; e < 4; ++e) { const float p = fmaxf(w[ai][bj][m][n][e], 0.f); w[ai][bj][m][n][e] = p * p; }
#pragma unroll
            for (int ai = 0; ai < 2; ++ai)
#pragma unroll
                for (int m = 0; m < 4; ++m) { const f32x4 q = SQ[ai][m]; const float rs2 = __builtin_amdgcn_rcpf(((q[0] + q[1]) + (q[2] + q[3])) * (1.0f / 1024.0f) + RMS_EPS); const int R = row0 + ai * HALF + m * 16;
#pragma unroll
                    for (int bj = 0; bj < 2; ++bj) { const u32x4 w_ = pack8(w[ai][bj][m][0] * rs2, w[ai][bj][m][1] * rs2);
                        if (!(probe & 8) || w_.x == 0x7fc17fc1u) *(u32x4*)(o1 + (size_t)R * 4096 + colw + bj * HALF) = w_; } }
            return;
        }
        float ss[2][4][2];
#pragma unroll
        for (int gi = 0; gi < NG; ++gi) {
            u32x4 L1[GA][4][2], L2[GA][4][2]; f32x4 X0[GA][4][2], X1v[GA][4][2], SQ[GA][4];
#pragma unroll
            for (int a = 0; a < GA; ++a)
#pragma unroll
                for (int m = 0; m < 4; ++m) { const int ai = gi * GA + a; const int R = row0 + ai * HALF + m * 16;
                    if (MODE == E_UP || MODE == E_Y) SQ[a][m] = *(const f32x4*)(ss_in + (size_t)R * 4);
#pragma unroll
                    for (int bj = 0; bj < 2; ++bj) { const size_t idx = (size_t)R * 1024 + colw + bj * HALF;
                        if (MODE == E_AMIX || MODE == E_MIX || MODE == E_X2 || MODE == E_Y) L1[a][m][bj] = *(const u32x4*)(g1 + idx);
                        if (MODE == E_MIX || MODE == E_Y) L2[a][m][bj] = *(const u32x4*)(g2 + idx);
                        if (MODE == E_X1) { const float* xr = (R < MP) ? xp + idx : xs + (idx - (size_t)MP * 1024); X0[a][m][bj] = *(const f32x4*)xr; X1v[a][m][bj] = *(const f32x4*)(xr + 4); } } }
#pragma unroll
            for (int a = 0; a < GA; ++a)
#pragma unroll
                for (int m = 0; m < 4; ++m) { const int ai = gi * GA + a; const int R = row0 + ai * HALF + m * 16;
                    float rs = 1.0f;
                    if (MODE == E_UP || MODE == E_Y) { const f32x4 q = SQ[a][m]; rs = __builtin_amdgcn_rsqf(((q[0] + q[1]) + (q[2] + q[3])) * (1.0f / 1024.0f) + RMS_EPS); }
#pragma unroll
                    for (int bj = 0; bj < 2; ++bj) { const int col = colw + bj * HALF; const size_t idx = (size_t)R * 1024 + col;
                        const f32x4 a0 = acc[ai][bj][m][0], a1 = acc[ai][bj][m][1];
                        if (MODE == E_AMIX) { f32x4 s0, s1; unpack8(L1[a][m][bj], s0, s1); *(u32x4*)(o1 + idx) = pack8(s0 * a0, s1 * a1); }
                        else if (MODE == E_MIX) { f32x4 s0, s1, p0, p1; unpack8(L1[a][m][bj], s0, s1); unpack8(L2[a][m][bj], p0, p1); *(u32x4*)(o1 + idx) = pack8(p0 + s0 * a0, p1 + s1 * a1); }
                        else if (MODE == E_X1) { const f32x4 v0 = X0[a][m][bj] + a0, v1 = X1v[a][m][bj] + a1;
                            *(u32x4*)(o1 + idx) = pack8(v0, v1); ss[ai][m][bj] = sq8(v0, v1); }
                        else if (MODE == E_UP) { f32x4 v0 = a0 * rs, v1 = a1 * rs;
#pragma unroll
                            for (int e = 0; e < 4; ++e) { const float p = fmaxf(v0[e], 0.f), q = fmaxf(v1[e], 0.f); v0[e] = p * p; v1[e] = q * q; }
                            const u32x4 w_ = pack8(v0, v1); if (!(probe & 8) || w_.x == 0x7fc17fc1u) *(u32x4*)(o1 + (size_t)R * 4096 + col) = w_; }
                        else if (MODE == E_X2) { f32x4 p0, p1; unpack8(L1[a][m][bj], p0, p1); const f32x4 v0 = p0 + a0, v1 = p1 + a1;
                            *(u32x4*)(o1 + idx) = pack8(v0, v1); ss[ai][m][bj] = sq8(v0, v1); }
                        else if (MODE == E_PE) { *(u32x4*)(o1 + idx) = pack8(a0, a1); }
                        else { f32x4 p0, p1, v0, v1; unpack8(L1[a][m][bj], p0, p1); unpack8(L2[a][m][bj], v0, v1);
#pragma unroll
                            for (int e = 0; e < 4; ++e) { v0[e] += fsigmoid(a0[e] * rs) * p0[e]; v1[e] += fsigmoid(a1[e] * rs) * p1[e]; }
                            *(f32x4*)(of + idx) = v0; *(f32x4*)(of + idx + 4) = v1; } } }
            if (NG > 1) asm volatile("" ::: "memory");
        }
        if (MODE == E_X1 || MODE == E_X2) {
            rowss_exchange(ss, P, wr, wc, fr, fq);
            if (wc == 0 && fq == 0) {
#pragma unroll
                for (int ai = 0; ai < 2; ++ai)
#pragma unroll
                    for (int m = 0; m < 4; ++m) ss_out[(size_t)(row0 + ai * HALF + m * 16) * 4 + u.pn] = ss[ai][m][0] + ss[ai][m][1]; }
        }
    }
};
template <class Epi, class Sched, bool ALIGN_EPI = false, bool SP2 = false>
__device__ __forceinline__ void gemm_phase(PG8_LAS unsigned char* lds, const Gemm g, const Sched& S, const Epi& E, const int wave0, const unsigned stag_ticks = 0u) {
    int tid_; asm volatile("v_mbcnt_lo_u32_b32 %0, -1, 0\n\tv_mbcnt_hi_u32_b32 %0, -1, %0" : "=v"(tid_)); tid_ |= wave0 << 6;
    const int tid = tid_, wid = __builtin_amdgcn_readfirstlane(tid >> 6), lane = tid & 63, wr = wid >> 2, wc = wid & 3, fr = lane & 15, fq = lane >> 4;
    const int K = g.K, nt = K / BK;
    unsigned voffA[2], voffB[2];
#pragma unroll
    for (int i = 0; i < 2; ++i) { int R, C; stage_rc(tid * 16 + i * 8192, R, C); const int Rb = Epi::PERM ? ((R & ~31) + perm32(R & 31)) : R;
        voffA[i] = (unsigned)(R * K + C) * 2u; voffB[i] = (unsigned)(Rb * K + C) * 2u; }
    const size_t kstep = (size_t)(BK * 2);
    const size_t hstep = (size_t)HALF * K * 2;
    const size_t tstep = 2 * hstep;
    const unsigned ldsw = (unsigned)wid * 1024u;
    const int aoff = lds_byte(wr * 64 + fr, fq * 8), boff = lds_byte(wc * 32 + fr, fq * 8);
#define PG8_SA(b, h) (((b) * 2 + (h)) * HTB)
#define PG8_SB(b, h) ((4 + (b) * 2 + (h)) * HTB)
#define PG8_STAGE(bufoff, gbase, voff) do { _Pragma("unroll") for (int _i = 0; _i < 2; ++_i) \
        __builtin_amdgcn_global_load_lds((const unsigned*)((const char*)(gbase) + (voff)[_i]), (PG8_LAS unsigned*)(lds + (bufoff) + ldsw + _i * 8192), 16, 0, 0); } while (0)
#define PG8_LDA(dst, b, h) do { _Pragma("unroll") for (int m = 0; m < 4; ++m) _Pragma("unroll") for (int k = 0; k < 2; ++k) dst[m][k] = *(const PG8_LAS bf16x8*)(lds + PG8_SA(b, h) + aoff + m * 2048 + k * 1024); } while (0)
#define PG8_LDB(dst, b, h) do { _Pragma("unroll") for (int n = 0; n < 2; ++n) _Pragma("unroll") for (int k = 0; k < 2; ++k) dst[n][k] = *(const PG8_LAS bf16x8*)(lds + PG8_SB(b, h) + boff + n * 2048 + k * 1024); } while (0)
#define PG8_MMA(ai, bj, At, Bt) do { __builtin_amdgcn_s_setprio(1); _Pragma("unroll") for (int m = 0; m < 4; ++m) _Pragma("unroll") for (int n = 0; n < 2; ++n) _Pragma("unroll") for (int k = 0; k < 2; ++k) \
        acc[ai][bj][m][n] = __builtin_amdgcn_mfma_f32_16x16x32_bf16(Bt[n][k], At[m][k], acc[ai][bj][m][n], 0, 0, 0); __builtin_amdgcn_s_setprio(0); } while (0)
#define PG8_WAIT_V(n) asm volatile("s_waitcnt vmcnt(" #n ")" ::: "memory")
#define PG8_WAIT_L(n) asm volatile("s_waitcnt lgkmcnt(" #n ")" ::: "memory")
#define PG8_WAIT_V_EPI(flag, n) asm volatile("s_cmp_eq_u32 %0, 0\n\ts_cbranch_scc1 1f\n\ts_waitcnt vmcnt(" #n ")\n\ts_branch 2f\n1:\n\ts_waitcnt vmcnt(8)\n2:" :: "s"(flag) : "memory", "scc")
#define PG8_BAR __builtin_amdgcn_s_barrier()
#define PG8_SCHED __builtin_amdgcn_sched_barrier(0)
    Unit cur, nxt; int ui = 0;
    if (!S.next(0, cur)) return;
    if (stag_ticks) {
        const unsigned long long t0_ = __builtin_amdgcn_s_memrealtime();
        while (__builtin_amdgcn_s_memrealtime() - t0_ < (unsigned long long)stag_ticks) __builtin_amdgcn_s_sleep(16);
    }
    f32x4 acc[2][2][4][2];
#pragma unroll
    for (int a = 0; a < 2; ++a)
#pragma unroll
        for (int b = 0; b < 2; ++b)
#pragma unroll
            for (int m = 0; m < 4; ++m)
#pragma unroll
                for (int n = 0; n < 2; ++n) acc[a][b][m][n] = (f32x4){0.f, 0.f, 0.f, 0.f};
    bf16x8 At[4][2], B0[2][2], B1[2][2];
    const char* cA = (const char*)g.A + (size_t)cur.pm * tstep; const char* cB = (const char*)g.Bt + (size_t)cur.pn * tstep;
    S.a_ready(cur);
    if constexpr (SP2) {
        PG8_STAGE(PG8_SB(0, 0), cB, voffB); PG8_STAGE(PG8_SB(0, 1), cB + hstep, voffB); PG8_STAGE(PG8_SA(0, 0), cA, voffA); PG8_STAGE(PG8_SA(0, 1), cA + hstep, voffA);
        if (wr == 1) PG8_BAR;
        PG8_WAIT_V(2); PG8_BAR;
        PG8_STAGE(PG8_SB(1, 0), cB + kstep, voffB); PG8_STAGE(PG8_SA(1, 0), cA + kstep, voffA); PG8_STAGE(PG8_SB(1, 1), cB + hstep + kstep, voffB);
        PG8_WAIT_V(6); PG8_BAR;
    } else {
        PG8_STAGE(PG8_SB(0, 0), cB, voffB); PG8_STAGE(PG8_SA(0, 0), cA, voffA); PG8_STAGE(PG8_SB(0, 1), cB + hstep, voffB); PG8_STAGE(PG8_SA(0, 1), cA + hstep, voffA);
        if (wr == 1) PG8_BAR;
        PG8_WAIT_V(4); PG8_BAR;
        PG8_STAGE(PG8_SB(1, 0), cB + kstep, voffB); PG8_STAGE(PG8_SA(1, 0), cA + kstep, voffA); PG8_STAGE(PG8_SB(1, 1), cB + hstep + kstep, voffB);
        PG8_WAIT_V(6); PG8_BAR;
    }
    for (;;) {
        const bool has_next = S.next(ui + 1, nxt);
        const char* nA = has_next ? (const char*)g.A + (size_t)nxt.pm * tstep : cA; const char* nB = has_next ? (const char*)g.Bt + (size_t)nxt.pn * tstep : cB;
        for (int t = 0; t < nt; t += 2) {
            const bool last = (t == nt - 2);
            const char* a1 = cA + (size_t)(t + 1) * kstep;
            const char* a2 = last ? nA : cA + (size_t)(t + 2) * kstep; const char* b2 = last ? nB : cB + (size_t)(t + 2) * kstep;
            const char* a3 = a2 + kstep; const char* b3 = b2 + kstep;
            if (last && has_next) S.a_ready(nxt);
            if constexpr (SP2) {
            const int after_epi = __builtin_amdgcn_readfirstlane(((t == 0) && (ui > 0)) ? 1 : 0);
            PG8_LDB(B0, 0, 0); PG8_LDB(B1, 0, 1); PG8_SCHED; PG8_LDA(At, 0, 0); PG8_STAGE(PG8_SA(1, 1), a1 + hstep, voffA);
            if constexpr (Epi::NST >= 32) PG8_WAIT_V_EPI(after_epi, 40); else PG8_WAIT_V_EPI(after_epi, 24);
            PG8_WAIT_L(0); PG8_BAR; PG8_MMA(0, 0, At, B0); PG8_MMA(0, 1, At, B1); PG8_BAR; PG8_SCHED;
            PG8_LDA(At, 0, 1); PG8_STAGE(PG8_SB(0, 0), b2, voffB); PG8_STAGE(PG8_SB(0, 1), b2 + hstep, voffB); PG8_STAGE(PG8_SA(0, 0), a2, voffA);
            if constexpr (Epi::NST >= 32) PG8_WAIT_V_EPI(after_epi, 40); else PG8_WAIT_V_EPI(after_epi, 24);
            PG8_WAIT_L(0); PG8_BAR; PG8_MMA(1, 0, At, B0); PG8_MMA(1, 1, At, B1); PG8_BAR; PG8_SCHED;
            PG8_LDB(B0, 1, 0); PG8_LDB(B1, 1, 1); PG8_SCHED; PG8_LDA(At, 1, 0); PG8_STAGE(PG8_SA(0, 1), a2 + hstep, voffA);
            PG8_WAIT_V(8); PG8_WAIT_L(0); PG8_BAR; PG8_MMA(0, 0, At, B0); PG8_MMA(0, 1, At, B1); PG8_BAR; PG8_SCHED;
            PG8_LDA(At, 1, 1); PG8_STAGE(PG8_SB(1, 0), b3, voffB); PG8_STAGE(PG8_SB(1, 1), b3 + hstep, voffB); PG8_STAGE(PG8_SA(1, 0), a3, voffA);
            PG8_WAIT_V(8); PG8_WAIT_L(0); PG8_BAR; PG8_MMA(1, 0, At, B0); PG8_MMA(1, 1, At, B1); PG8_BAR; PG8_SCHED;
            } else {
            PG8_LDB(B0, 0, 0); PG8_SCHED; PG8_LDA(At, 0, 0); PG8_STAGE(PG8_SA(1, 1), a1 + hstep, voffA);
            PG8_WAIT_L(8); PG8_BAR; PG8_WAIT_L(0); PG8_MMA(0, 0, At, B0); PG8_BAR; PG8_SCHED;
            PG8_LDB(B1, 0, 1); PG8_STAGE(PG8_SB(0, 0), b2, voffB);
            PG8_BAR; PG8_WAIT_L(0); PG8_MMA(0, 1, At, B1); PG8_BAR;
            PG8_LDA(At, 0, 1); PG8_STAGE(PG8_SA(0, 0), a2, voffA);
            PG8_BAR; PG8_WAIT_L(0); PG8_MMA(1, 0, At, B0); PG8_BAR; PG8_SCHED;
            PG8_STAGE(PG8_SB(0, 1), b2 + hstep, voffB);
            PG8_WAIT_V(6); PG8_BAR; PG8_MMA(1, 1, At, B1); PG8_BAR;
            PG8_LDB(B0, 1, 0); PG8_SCHED; PG8_LDA(At, 1, 0); PG8_STAGE(PG8_SA(0, 1), a2 + hstep, voffA);
            PG8_WAIT_L(8); PG8_BAR; PG8_WAIT_L(0); PG8_MMA(0, 0, At, B0); PG8_BAR; PG8_SCHED;
            PG8_LDB(B1, 1, 1); PG8_STAGE(PG8_SB(1, 0), b3, voffB);
            PG8_BAR; PG8_WAIT_L(0); PG8_MMA(0, 1, At, B1); PG8_BAR;
            PG8_LDA(At, 1, 1); PG8_STAGE(PG8_SA(1, 0), a3, voffA);
            PG8_BAR; PG8_WAIT_L(0); PG8_MMA(1, 0, At, B0); PG8_BAR; PG8_SCHED;
            PG8_STAGE(PG8_SB(1, 1), b3 + hstep, voffB);
            PG8_WAIT_V(6); PG8_BAR; PG8_MMA(1, 1, At, B1); PG8_BAR;
            }
        }
        if constexpr (ALIGN_EPI) { if (wr == 0) PG8_BAR; }
        if constexpr (!Epi::AFTER_DRAIN) { E(acc, cur, wr, wc, fr, fq); S.done(cur); }
        if (!has_next) break;
#pragma unroll
        for (int a = 0; a < 2; ++a)
#pragma unroll
            for (int b = 0; b < 2; ++b)
#pragma unroll
                for (int m = 0; m < 4; ++m)
#pragma unroll
                    for (int n = 0; n < 2; ++n) acc[a][b][m][n] = (f32x4){0.f, 0.f, 0.f, 0.f};
        cur = nxt; cA = nA; cB = nB; ++ui;
        if constexpr (ALIGN_EPI) { if (wr == 1) PG8_BAR; }
    }
    PG8_WAIT_V(0);
    if constexpr (!ALIGN_EPI) { if (wr == 0) PG8_BAR; }
    PG8_BAR;
    if constexpr (Epi::AFTER_DRAIN) { E.fused(acc, cur, wr, wc, fr, fq, lds, wid, lane); S.done(cur); }
#undef PG8_SA
#undef PG8_SB
#undef PG8_STAGE
#undef PG8_LDA
#undef PG8_LDB
#undef PG8_MMA
#undef PG8_WAIT_V
#undef PG8_WAIT_L
#undef PG8_WAIT_V_EPI
#undef PG8_BAR
#undef PG8_SCHED
}
}
#define XB_TMO      128
#define XB_XCNT(j)  (256  + 64 * (j))
#define XB_XSUB(j)  (1280 + 64 * (j))
#define XB_XGEN(j)  (2304 + 64 * (j))
#define XB_TOP      3328
#define XB_TOPGEN   3392
#define XCD_BAR_WORDS 3456
#define XB_SPIN_CAP (1u << 18)

__device__ __forceinline__ unsigned xb_ld(unsigned* p)              { return __hip_atomic_load(p, __ATOMIC_RELAXED, __HIP_MEMORY_SCOPE_AGENT); }
__device__ __forceinline__ unsigned xb_add(unsigned* p, unsigned v) { return __hip_atomic_fetch_add(p, v, __ATOMIC_RELAXED, __HIP_MEMORY_SCOPE_AGENT); }
__device__ __forceinline__ unsigned xb_xcc_id() { return (unsigned)__builtin_amdgcn_s_getreg((3 << 11) | 20) & 0xFu; }
#define XB_SPIN(cond, bar) do { unsigned _sp = 0; while (cond) { __builtin_amdgcn_s_sleep(1); \
    if ((++_sp & 255u) == 0u) { if (xb_ld(&(bar)[XB_TMO])) break; if (_sp > XB_SPIN_CAP) { atomicAdd(&(bar)[XB_TMO], 1u); break; } } } } while (0)

struct XcdBarrier {
    unsigned* bar; unsigned x;
    volatile LAS unsigned* st;
};

__device__ __forceinline__ XcdBarrier xcd_barrier_post(unsigned* bar, volatile LAS unsigned* st) {
    XcdBarrier b; b.bar = bar; b.x = xb_xcc_id(); b.st = st;
    if (threadIdx.x == 0) (void)xb_add(&bar[XB_XCNT(b.x)], 1u);
    return b;
}
__device__ __forceinline__ void xcd_barrier_complete(unsigned* bar, unsigned x, unsigned& nloc, unsigned& nx) {
    const unsigned G = gridDim.x * gridDim.y * gridDim.z;
    unsigned sum, cnt, mine, sp = 0u;
    for (;;) {
        sum = 0u; cnt = 0u; mine = 0u;
#pragma unroll
        for (unsigned j = 0; j < 16; ++j) { const unsigned c = xb_ld(&bar[XB_XCNT(j)]); sum += c; cnt += (c > 0u) ? 1u : 0u; mine = (j == x) ? c : mine; }
        if (sum == G) break;
        __builtin_amdgcn_s_sleep(1);
        if ((++sp & 255u) == 0u) { if (xb_ld(&bar[XB_TMO])) break; if (sp > XB_SPIN_CAP) { atomicAdd(&bar[XB_TMO], 1u); break; } }
    }
    nloc = mine > 0u ? mine : 1u; nx = cnt > 0u ? cnt : 1u;
}

__device__ __forceinline__ void xcd_barrier(const XcdBarrier& b) {
    asm volatile("s_waitcnt vmcnt(0)" ::: "memory");
    __syncthreads();
    if (threadIdx.x == 0) {
        unsigned* bar = b.bar;
        __builtin_amdgcn_s_waitcnt(0);
        unsigned nloc = b.st[0], nx = b.st[1];
        if (nloc == 0u) { xcd_barrier_complete(bar, b.x, nloc, nx); b.st[0] = nloc; b.st[1] = nx; }
        const unsigned old = xb_add(&bar[XB_XSUB(b.x)], 1u);
        const unsigned gen = old / nloc;
        if (old + 1u == (gen + 1u) * nloc) {
            __builtin_amdgcn_fence(__ATOMIC_RELEASE, "agent");
            asm volatile("s_waitcnt vmcnt(0)" ::: "memory");
            const unsigned og = xb_add(&bar[XB_TOP], 1u);
            const unsigned tg = og / nx;
            if (og + 1u == (tg + 1u) * nx) xb_add(&bar[XB_TOPGEN], 1u);
            else XB_SPIN(xb_ld(&bar[XB_TOPGEN]) == tg, bar);
            __builtin_amdgcn_fence(__ATOMIC_ACQUIRE, "agent");
            xb_add(&bar[XB_XGEN(b.x)], 1u);
            asm volatile("s_waitcnt vmcnt(0)" ::: "memory");
        } else {
            XB_SPIN(xb_ld(&bar[XB_XGEN(b.x)]) == gen, bar);
            __builtin_amdgcn_fence(__ATOMIC_ACQUIRE, "agent");
            asm volatile("s_waitcnt vmcnt(0)" ::: "memory");
        }
    }
    __syncthreads();
}
__device__ __forceinline__ float wave_sum(float v) {
#pragma unroll
    for (int o = 1; o < 64; o <<= 1) v += __shfl_xor(v, o);
    return v;
}
__device__ __forceinline__ float wave_max(float v) {
#pragma unroll
    for (int o = 1; o < 64; o <<= 1) v = fmaxf(v, __shfl_xor(v, o));
    return v;
}
__device__ __forceinline__ void p0_transpose_item(const float* W, int K, int N, bf16* WT, const float* ks, LAS float* scr, int item, int lane) {
    const int nblk = N / 32, kb = item / nblk, nb = item % nblk, k0 = 64 * kb, n0 = 32 * nb;
#pragma unroll 8
    for (int i = 0; i < 32; ++i) { const int kk = 2 * i + (lane >> 5); float w = W[(size_t)(k0 + kk) * N + n0 + (lane & 31)]; if (ks) w *= ks[k0 + kk]; scr[kk * 33 + (lane & 31)] = w; }
    LDS_WAIT(); asm volatile("" ::: "memory");
    const int c = lane & 7;
#pragma unroll
    for (int j = 0; j < 4; ++j) { const int n = (lane >> 3) + 8 * j; const LAS float* s = scr + (8 * c) * 33 + n;
        v4u o; o.x = pk2(s[0 * 33], s[1 * 33]); o.y = pk2(s[2 * 33], s[3 * 33]); o.z = pk2(s[4 * 33], s[5 * 33]); o.w = pk2(s[6 * 33], s[7 * 33]);
        *(GAS v4u*)(WT + (size_t)(n0 + n) * K + k0 + 8 * c) = o; }
    LDS_WAIT(); asm volatile("" ::: "memory");
}

struct Ptrs {
    const float* in[30]; float* out; unsigned char* ws;
};
#define WSP(T, off) ((T*)(P.ws + (off)))

__device__ __forceinline__ void p0_prologue(const Ptrs& P, LAS unsigned char* lds, int tid, int lane, int wave, int vcu, int G) {
    LAS float* scr = (LAS float*)(lds + RING_OFF + wave * 16384);
    const int gw = vcu * NWAVES + wave, NGW = G * NWAVES;
    constexpr int I0 = (DM / 64) * (NIN / 32), I1 = (MW / 64) * (DM / 32), I2 = (DM / 64) * (DM / 32), I3 = I2, I4 = (DM / 64) * (FF / 32), I5 = (FF / 64) * (DM / 32), I6 = I2, I7 = (PLE / 64) * (DM / 32);
    constexpr int NITEMS = I0 + I1 + I2 + I3 + I4 + I5 + I6 + I7;
    for (int it = gw; it < NITEMS; it += NGW) {
        int r = it;
        if (r < I0) { p0_transpose_item(P.in[11], DM, NIN, WSP(bf16, WS_WIN), nullptr, scr, r, lane); continue; } r -= I0;
        if (r < I1) { p0_transpose_item(P.in[14], MW, DM, WSP(bf16, WS_WOA), nullptr, scr, r, lane); continue; } r -= I1;
        if (r < I2) { p0_transpose_item(P.in[22], DM, DM, WSP(bf16, WS_WOB), nullptr, scr, r, lane); continue; } r -= I2;
        if (r < I3) { p0_transpose_item(P.in[23], DM, DM, WSP(bf16, WS_WO), nullptr, scr, r, lane); continue; } r -= I3;
        if (r < I4) { p0_transpose_item(P.in[25], DM, FF, WSP(bf16, WS_WUP), P.in[24], scr, r, lane); continue; } r -= I4;
        if (r < I5) { p0_transpose_item(P.in[26], FF, DM, WSP(bf16, WS_WDN), nullptr, scr, r, lane); continue; } r -= I5;
        if (r < I6) { p0_transpose_item(P.in[28], DM, DM, WSP(bf16, WS_WPG), P.in[27], scr, r, lane); continue; } r -= I6;
        p0_transpose_item(P.in[29], PLE, DM, WSP(bf16, WS_WPE), nullptr, scr, r, lane);
    }
    { const GAS f32x4* gm = (const GAS f32x4*)P.in[10] + lane; f32x4 g[4];
#pragma unroll
      for (int j = 0; j < 4; ++j) g[j] = gm[64 * j];
      bf16* HB = WSP(bf16, WS_HB);
      for (int m0 = gw; m0 < M; m0 += 4 * NGW) {
        f32x4 v[4][4]; float s[4];
#pragma unroll
        for (int r = 0; r < 4; ++r) { const int m = (m0 + r * NGW < M) ? m0 + r * NGW : m0; const float* xrow = (m < MP) ? P.in[0] + (size_t)m * DM : P.in[1] + (size_t)(m - MP) * DM;
            const GAS f32x4* xr = (const GAS f32x4*)xrow + lane;
#pragma unroll
            for (int j = 0; j < 4; ++j) v[r][j] = xr[64 * j]; }
#pragma unroll
        for (int r = 0; r < 4; ++r) { float t = 0.f;
#pragma unroll
            for (int j = 0; j < 4; ++j) t += (v[r][j].x * v[r][j].x + v[r][j].y * v[r][j].y) + (v[r][j].z * v[r][j].z + v[r][j].w * v[r][j].w);
            s[r] = t; }
#pragma unroll
        for (int o = 1; o < 64; o <<= 1) {
#pragma unroll
            for (int r = 0; r < 4; ++r) s[r] += __shfl_xor(s[r], o); }
#pragma unroll
        for (int r = 0; r < 4; ++r) { const int m = m0 + r * NGW; if (m < M) { const float rs = 1.0f / sqrtf(s[r] * (1.f / DM) + 1e-6f);
            GAS v2u* o8 = (GAS v2u*)(HB + (size_t)m * DM) + lane;
#pragma unroll
            for (int j = 0; j < 4; ++j) { v2u w; w.x = pk2(v[r][j].x * rs * g[j].x, v[r][j].y * rs * g[j].y); w.y = pk2(v[r][j].z * rs * g[j].z, v[r][j].w * rs * g[j].w); o8[64 * j] = w; } } }
      }
      bf16* PB = WSP(bf16, WS_PB);
      for (int m0 = gw; m0 < M; m0 += 8 * NGW) {
        f32x4 pv[8];
#pragma unroll
        for (int r = 0; r < 8; ++r) { const int m = (m0 + r * NGW < M) ? m0 + r * NGW : m0; const float* prow = (m < MP) ? P.in[2] + (size_t)m * PLE : P.in[3] + (size_t)(m - MP) * PLE; pv[r] = ((const GAS f32x4*)prow)[lane]; }
#pragma unroll
        for (int r = 0; r < 8; ++r) { const int m = m0 + r * NGW; if (m < M) { v2u w; w.x = pk2(pv[r].x, pv[r].y); w.y = pk2(pv[r].z, pv[r].w); ((GAS v2u*)(PB + (size_t)m * PLE))[lane] = w; } }
      }
    }
    const int gt = vcu * (NWAVES * 64) + tid, NT = G * NWAVES * 64;
    { bf16* WRG = WSP(bf16, WS_WRG);
      for (int e = gt; e < 2 * 65536; e += NT) { const int mat = e >> 16, n = (e >> 12) & 15, o = (e >> 6) & 63, i = e & 63;
          WRG[e] = (bf16)f2bf(P.in[mat ? 19 : 17][(n * 64 + i) * 64 + o] * -1.4426950408889634f); }
      float* TAB = WSP(float, WS_TAB);
      for (int e = gt; e < 12 * 132; e += NT) { const int hh = e / 132, j = e % 132; float v = 0.f;
          if (j <= 128) { const int g = hh >> 2, dist = j << (2 * g); int bk;
              if (dist < 16) bk = dist; else { const double lg = log((double)dist / 16.0) / log(128.0) * 16.0; bk = 16 + (int)lg; if (bk > 31) bk = 31; }
              v = P.in[9][bk * 12 + hh] * 1.4426950408889634f; }
          TAB[e] = v; }
      for (int e = gt; e < 1024; e += NT) { const double x = (double)P.in[21][e]; const double ls = (x >= 0.0) ? -log1p(exp(-x)) : x - log1p(exp(x)); TAB[2048 + e] = (float)(8.0 * ls); }
    }
}

__device__ __forceinline__ unsigned offb(unsigned row, unsigned ch) { return 256u * row + 16u * (ch ^ (((row & 3u) << 2) | ((row >> 2) & 3u))); }
__device__ __forceinline__ s16x4 vtr(LAS const unsigned char* p) { typedef short v4i16_t __attribute__((ext_vector_type(4))); return __builtin_bit_cast(s16x4, __builtin_amdgcn_ds_read_tr16_b64_v4i16((LAS v4i16_t*)p)); }

__device__ __forceinline__ void attn_unit(const Ptrs& P, LAS unsigned char* lds, int uid, bool have_prev, int tid, int lane, int w, int probe) {
    const int blk = uid & 63, h4 = (uid >> 6) & 3, b = (uid >> 8) & 7, g = uid >> 11;
    const int gsh = 2 * g, hh = 4 * g + h4;
    const int nb = blk & ((64 >> gsh) - 1); const bool first = nb == 0;
    const int par = nb & 1; const unsigned xr = par ? 0u : 32768u;
    const size_t qrow0 = ((size_t)(b * 12 + hh) << 13) + (size_t)blk * 128;
    const bf16* Qb = WSP(bf16, WS_Q); const bf16* Kb = WSP(bf16, WS_K); const bf16* Vb = WSP(bf16, WS_V);
    LAS unsigned char* Kimg = lds; LAS unsigned char* Vimg = lds + 65536;
    const LAS float* bias = (const LAS float*)(lds + XCH_OFF) + hh * 132;
    const int qi = lane & 15, g4 = lane >> 4;
    {
        const int lr = lane >> 4, sl = lane & 15;
#pragma unroll
        for (int i = 0; i < 4; ++i) { const int pl = w * 4 + i, p = 32 * par + pl; const int ch = sl ^ ((lr << 2) | (p & 3));
            const size_t srow = qrow0 + 4 * pl + lr;
            __builtin_amdgcn_global_load_lds((const unsigned*)((const char*)Kb + srow * 256 + ch * 16), (LAS unsigned*)(Kimg + p * 1024), 16, 0, 0);
            __builtin_amdgcn_global_load_lds((const unsigned*)((const char*)Vb + srow * 256 + ch * 16), (LAS unsigned*)(Vimg + p * 1024), 16, 0, 0); }
        if (!first && !have_prev) {
#pragma unroll
            for (int i = 0; i < 4; ++i) { const int pl = w * 4 + i, p = 32 * (par ^ 1) + pl; const int ch = sl ^ ((lr << 2) | (p & 3));
                const size_t srow = qrow0 - 128 + 4 * pl + lr;
                __builtin_amdgcn_global_load_lds((const unsigned*)((const char*)Kb + srow * 256 + ch * 16), (LAS unsigned*)(Kimg + p * 1024), 16, 0, 0);
                __builtin_amdgcn_global_load_lds((const unsigned*)((const char*)Vb + srow * 256 + ch * 16), (LAS unsigned*)(Vimg + p * 1024), 16, 0, 0); } }
        if (first) {
#pragma unroll
            for (int i = 0; i < 4; ++i) *(LAS v4u*)(Vimg + 32768 * (par ^ 1) + (i * 512 + tid) * 16) = (v4u){0u, 0u, 0u, 0u}; }
    }
    bf16x8 Qf[4];
    { const bf16* qp = Qb + (qrow0 + 16 * w + qi) * 128 + 8 * g4;
#pragma unroll
      for (int s = 0; s < 4; ++s) Qf[s] = *(const bf16x8*)(qp + 32 * s); }
    VM_WAIT(); LDS_WAIT(); __syncthreads();
    f32x4 S[9];
    { const unsigned fl = ((lane & 3) << 2) | ((lane >> 2) & 3);
      const unsigned kb = 256u * (unsigned)(16 * w + qi);
#pragma unroll
      for (int jb = 0; jb < 9; ++jb) { S[jb] = (f32x4){0.f, 0.f, 0.f, 0.f};
#pragma unroll
          for (int s = 0; s < 4; ++s) { const bf16x8 a = *(const LAS bf16x8*)(Kimg + (((kb + jb * 4096u) ^ xr) + 16u * ((unsigned)(4 * s + g4) ^ fl)));
              S[jb] = __builtin_amdgcn_mfma_f32_16x16x32_bf16(a, Qf[s], S[jb], 0, 0, 0); } } }
    if (probe & 16) { float t_ = 0.f;
#pragma unroll
        for (int jb = 0; jb < 9; ++jb) t_ += S[jb][0] + S[jb][1] + S[jb][2] + S[jb][3];
        if (t_ == 1.2345e-30f) WSP(float, WS_LSE)[tid] = t_; __syncthreads(); return; }
    float mx = -1e30f;
#pragma unroll
    for (int jb = 0; jb < 9; ++jb)
#pragma unroll
        for (int i = 0; i < 4; ++i) { const int ki = 4 * g4 + i, rel = 16 * jb + ki - qi;
            int slot = 128 - rel; slot = slot < 0 ? 0 : (slot > 128 ? 128 : slot);
            bool ok = true; if (jb == 0) ok = rel >= 0; if (jb == 8) ok = rel <= 128;
            if (first) ok = ok && (16 * w + 16 * jb + ki >= 128);
            const float v = ok ? S[jb][i] + bias[slot] : -1e30f; S[jb][i] = v; mx = fmaxf(mx, v); }
    mx = fmaxf(mx, __shfl_xor(mx, 16)); mx = fmaxf(mx, __shfl_xor(mx, 32));
    float tot = 0.f;
#pragma unroll
    for (int jb = 0; jb < 9; ++jb)
#pragma unroll
        for (int i = 0; i < 4; ++i) { const float p = fexp2(S[jb][i] - mx); S[jb][i] = p; tot += p; }
    tot += __shfl_xor(tot, 16); tot += __shfl_xor(tot, 32);
    bf16x8 Pf[5];
#pragma unroll
    for (int ks = 0; ks < 5; ++ks) { v4u pk; pk.x = pk2(S[2 * ks][0], S[2 * ks][1]); pk.y = pk2(S[2 * ks][2], S[2 * ks][3]);
        if (ks < 4) { pk.z = pk2(S[2 * ks + 1][0], S[2 * ks + 1][1]); pk.w = pk2(S[2 * ks + 1][2], S[2 * ks + 1][3]); } else { pk.z = 0u; pk.w = 0u; }
        Pf[ks] = __builtin_bit_cast(bf16x8, pk); }
    f32x4 O[8];
#pragma unroll
    for (int c = 0; c < 8; ++c) O[c] = (f32x4){0.f, 0.f, 0.f, 0.f};
    { const int q = (lane & 15) >> 2, p = lane & 3; const unsigned fl = ((unsigned)q << 2) | (unsigned)g4;
      const unsigned vb = 256u * (unsigned)(16 * w + 4 * g4 + q);
#pragma unroll
      for (int ks = 0; ks < 5; ++ks)
#pragma unroll
          for (int c = 0; c < 8; ++c) { const unsigned co = 16u * (((unsigned)(2 * c + (p >> 1))) ^ fl) + 8u * (unsigned)(p & 1);
              const s16x4 lo = vtr(Vimg + (((vb + 256u * (32 * ks)) ^ xr) + co));
              const s16x4 hi = vtr(Vimg + (((vb + 256u * (32 * ks + (ks < 4 ? 16 : 0))) ^ xr) + co));
              const bf16x8 a = (bf16x8){lo[0], lo[1], lo[2], lo[3], hi[0], hi[1], hi[2], hi[3]};
              O[c] = __builtin_amdgcn_mfma_f32_16x16x32_bf16(a, Pf[ks], O[c], 0, 0, 0); } }
    const float inv = frcp(tot);
    const int mq = nb * 128 + 16 * w + qi, rr = blk >> (6 - gsh);
    const size_t R = (size_t)b * SEQ + ((size_t)mq << gsh) + rr;
    bf16* og = WSP(bf16, WS_OG) + ((size_t)g * MP + R) * MW + h4 * 128 + 4 * g4;
#pragma unroll
    for (int c = 0; c < 8; ++c) { v2u o; o.x = pk2(O[c][0] * inv, O[c][1] * inv); o.y = pk2(O[c][2] * inv, O[c][3] * inv); if (!(probe & 8) || o.x == 0x7fc17fc1u) *(GAS v2u*)(og + 16 * c) = o; }
    if (g4 == 0) WSP(float, WS_LSE)[((size_t)g * MP + R) * 4 + h4] = mx + __log2f(tot);
    __syncthreads();
}

__device__ __forceinline__ void glds16(const void* gsrc, unsigned lds_dst) { unsigned keep;
    asm volatile("s_mov_b32 %0, m0\n\ts_mov_b32 m0, %2\n\ts_nop 0\n\tglobal_load_lds_dwordx4 %1, off\n\ts_mov_b32 m0, %0" : "=&s"(keep) : "v"(gsrc), "s"(lds_dst) : "memory"); }
__device__ __forceinline__ void attn_dma_half(const bf16* src, LAS unsigned char* img, size_t row0, int half, int lane, int w) {
    const int lr = lane >> 4, sl = lane & 15; const unsigned img0 = (unsigned)(uintptr_t)img;
#pragma unroll
    for (int i = 0; i < 4; ++i) { const int pl = w * 4 + i, p = 32 * half + pl; const int ch = sl ^ ((lr << 2) | (p & 3));
        glds16((const char*)src + (row0 + 4 * pl + lr) * 256 + ch * 16, (unsigned)__builtin_amdgcn_readfirstlane((int)(img0 + p * 1024))); }
}
__device__ __forceinline__ void attn_qload(bf16x8 (&Qf)[4], const bf16* qp) {
    asm volatile("global_load_dwordx4 %0, %4, off\n\tglobal_load_dwordx4 %1, %4, off offset:64\n\tglobal_load_dwordx4 %2, %4, off offset:128\n\tglobal_load_dwordx4 %3, %4, off offset:192"
                 : "=&v"(Qf[0]), "=&v"(Qf[1]), "=&v"(Qf[2]), "=&v"(Qf[3]) : "v"(qp) : "memory"); }
#define ATT_WAIT(n) asm volatile("s_waitcnt vmcnt(" #n ")" ::: "memory")
#define ATT_WAITQ(n) asm volatile("s_waitcnt vmcnt(" #n ")" : "+v"(Qf[0]), "+v"(Qf[1]), "+v"(Qf[2]), "+v"(Qf[3]) :: "memory")
#define ATT_BAR() do { asm volatile("s_waitcnt lgkmcnt(0)" ::: "memory"); __builtin_amdgcn_s_barrier(); asm volatile("" ::: "memory"); } while (0)
__device__ __forceinline__ void attn_run(const Ptrs& P, LAS unsigned char* lds, int u0, int n, int tid, int lane, int w) {
    const bf16* Qb = WSP(bf16, WS_Q); const bf16* Kb = WSP(bf16, WS_K); const bf16* Vb = WSP(bf16, WS_V);
    LAS unsigned char* Kimg = lds; LAS unsigned char* Vimg = lds + 65536;
    const int qi = lane & 15, g4 = lane >> 4;
    const int blk0 = u0 & 63, h4 = (u0 >> 6) & 3, b = (u0 >> 8) & 7, g = u0 >> 11; const int gsh = 2 * g, hh = 4 * g + h4;
    const int nb0 = blk0 & ((64 >> gsh) - 1); const bool first0 = nb0 == 0;
    const size_t q00 = ((size_t)(b * 12 + hh) << 13) + (size_t)blk0 * 128;
    float bm[9][4];
    { const LAS float* bias = (const LAS float*)(lds + XCH_OFF) + hh * 132;
#pragma unroll
      for (int jb = 0; jb < 9; ++jb)
#pragma unroll
          for (int i = 0; i < 4; ++i) { const int ki = 4 * g4 + i, rel = 16 * jb + ki - qi; int slot = 128 - rel; slot = slot < 0 ? 0 : (slot > 128 ? 128 : slot);
              bool ok = true; if (jb == 0) ok = rel >= 0; if (jb == 8) ok = rel <= 128;
              bm[jb][i] = ok ? bias[slot] : -1e30f; } }
    bf16x8 Qf[4];
    { const int par = nb0 & 1;
      attn_dma_half(Kb, Kimg, q00, par, lane, w); attn_dma_half(Vb, Vimg, q00, par, lane, w);
      if (!first0) { attn_dma_half(Kb, Kimg, q00 - 128, par ^ 1, lane, w); attn_dma_half(Vb, Vimg, q00 - 128, par ^ 1, lane, w); }
      else {
#pragma unroll
          for (int i = 0; i < 4; ++i) *(LAS v4u*)(Vimg + 32768 * (par ^ 1) + (i * 512 + tid) * 16) = (v4u){0u, 0u, 0u, 0u}; }
      attn_qload(Qf, Qb + (q00 + 16 * w + qi) * 128 + 8 * g4);
      ATT_WAIT(0); }
#pragma unroll 1
    for (int it = 0; it < n; ++it) {
        const bool has_next = it + 1 < n; const bool first = first0 && it == 0;
        const int nb = nb0 + it, par = nb & 1; const unsigned xr = par ? 0u : 32768u; const size_t qrow0 = q00 + (size_t)it * 128;
        ATT_WAITQ(9);
        ATT_BAR();
        if (it > 0) attn_dma_half(Vb, Vimg, qrow0, par, lane, w);
        f32x4 S[9];
        { const unsigned fl = ((lane & 3) << 2) | ((lane >> 2) & 3);
          const unsigned kb = 256u * (unsigned)(16 * w + qi);
          unsigned ko[4];
#pragma unroll
          for (int s = 0; s < 4; ++s) ko[s] = 16u * ((unsigned)(4 * s + g4) ^ fl);
          bf16x8 kf[2][4];
#pragma unroll
          for (int s = 0; s < 4; ++s) kf[0][s] = *(const LAS bf16x8*)(Kimg + ((kb ^ xr) + ko[s]));
#pragma unroll
          for (int jb = 0; jb < 9; ++jb) {
              if (jb < 8) {
#pragma unroll
                  for (int s = 0; s < 4; ++s) kf[(jb + 1) & 1][s] = *(const LAS bf16x8*)(Kimg + (((kb + (jb + 1) * 4096u) ^ xr) + ko[s])); }
              S[jb] = (f32x4){0.f, 0.f, 0.f, 0.f};
#pragma unroll
              for (int s = 0; s < 4; ++s) S[jb] = __builtin_amdgcn_mfma_f32_16x16x32_bf16(kf[jb & 1][s], Qf[s], S[jb], 0, 0, 0); } }
        if (first) {
#pragma unroll
            for (int jb = 0; jb < 8; ++jb) if (w + jb < 8) S[jb] = (f32x4){-1e30f, -1e30f, -1e30f, -1e30f}; }
        float mx = -1e30f;
#pragma unroll
        for (int jb = 0; jb < 9; ++jb)
#pragma unroll
            for (int i = 0; i < 4; ++i) { const float v = S[jb][i] + bm[jb][i]; S[jb][i] = v; mx = fmaxf(mx, v); }
        mx = fmaxf(mx, __shfl_xor(mx, 16)); mx = fmaxf(mx, __shfl_xor(mx, 32));
        float tot = 0.f;
#pragma unroll
        for (int jb = 0; jb < 9; ++jb)
#pragma unroll
            for (int i = 0; i < 4; ++i) { const float p = fexp2(S[jb][i] - mx); S[jb][i] = p; tot += p; }
        tot += __shfl_xor(tot, 16); tot += __shfl_xor(tot, 32);
        bf16x8 Pf[5];
#pragma unroll
        for (int ks = 0; ks < 5; ++ks) { v4u pk; pk.x = pk2(S[2 * ks][0], S[2 * ks][1]); pk.y = pk2(S[2 * ks][2], S[2 * ks][3]);
            if (ks < 4) { pk.z = pk2(S[2 * ks + 1][0], S[2 * ks + 1][1]); pk.w = pk2(S[2 * ks + 1][2], S[2 * ks + 1][3]); } else { pk.z = 0u; pk.w = 0u; }
            Pf[ks] = __builtin_bit_cast(bf16x8, pk); }
        ATT_WAIT(0);
        ATT_BAR();
        if (has_next) attn_dma_half(Kb, Kimg, qrow0 + 128, par ^ 1, lane, w);
        attn_qload(Qf, Qb + (qrow0 + (has_next ? 128 : 0) + 16 * w + qi) * 128 + 8 * g4);
        f32x4 O[8];
#pragma unroll
        for (int c = 0; c < 8; ++c) O[c] = (f32x4){0.f, 0.f, 0.f, 0.f};
        { const int q = (lane & 15) >> 2, p = lane & 3; const unsigned fl = ((unsigned)q << 2) | (unsigned)g4;
          const unsigned vb = 256u * (unsigned)(16 * w + 4 * g4 + q);
          unsigned co[8];
#pragma unroll
          for (int c = 0; c < 8; ++c) co[c] = 16u * (((unsigned)(2 * c + (p >> 1))) ^ fl) + 8u * (unsigned)(p & 1);
          s16x4 lo[2][8], hi[2][8];
          { const unsigned r0 = vb ^ xr, r1 = (vb + 256u * 16u) ^ xr;
#pragma unroll
            for (int c = 0; c < 8; ++c) { lo[0][c] = vtr(Vimg + (r0 + co[c])); hi[0][c] = vtr(Vimg + (r1 + co[c])); } }
#pragma unroll
          for (int ks = 0; ks < 5; ++ks) {
              if (ks < 4) { const unsigned r0 = (vb + 256u * (32 * (ks + 1))) ^ xr, r1 = (vb + 256u * (32 * (ks + 1) + (ks + 1 < 4 ? 16 : 0))) ^ xr;
#pragma unroll
                  for (int c = 0; c < 8; ++c) { lo[(ks + 1) & 1][c] = vtr(Vimg + (r0 + co[c])); hi[(ks + 1) & 1][c] = vtr(Vimg + (r1 + co[c])); } }
#pragma unroll
              for (int c = 0; c < 8; ++c) { const s16x4 l_ = lo[ks & 1][c], h_ = hi[ks & 1][c];
                  const bf16x8 va = (bf16x8){l_[0], l_[1], l_[2], l_[3], h_[0], h_[1], h_[2], h_[3]};
                  O[c] = __builtin_amdgcn_mfma_f32_16x16x32_bf16(va, Pf[ks], O[c], 0, 0, 0); } } }
        const float inv = frcp(tot);
        const int mq = nb * 128 + 16 * w + qi, rr = blk0 >> (6 - gsh);
        const size_t R = (size_t)b * SEQ + ((size_t)mq << gsh) + rr;
        bf16* og = WSP(bf16, WS_OG) + ((size_t)g * MP + R) * MW + h4 * 128 + 4 * g4;
#pragma unroll
        for (int c = 0; c < 8; ++c) { v2u o; o.x = pk2(O[c][0] * inv, O[c][1] * inv); o.y = pk2(O[c][2] * inv, O[c][3] * inv); *(GAS v2u*)(og + 16 * c) = o; }
        WSP(float, WS_LSE)[((size_t)g * MP + R) * 4 + h4] = mx + __log2f(tot);
    }
    ATT_WAIT(0); ATT_BAR();
}

__device__ __forceinline__ const float* sattn_row(const float* cache, const float* knew, int b, int t, int gsh, int j) {
    const int nbuf = 128 << gsh, jj = j < 129 ? j : 128, ridx = nbuf + t - (jj << gsh);
    return (ridx >= nbuf) ? knew + (size_t)(b * 4 + (ridx - nbuf)) * 1024 : cache + ((size_t)b * nbuf + ridx) * 1024;
}
__device__ __forceinline__ void sattn_unit(const Ptrs& P, LAS unsigned char* lds, int su, int tid, int lane, int w) {
    constexpr int NSB = 4;
    const int b = su >> 2, t = su & 3; const int h = lane >> 4, sub = lane & 15;
    LAS float* LG = (LAS float*)lds;
    LAS float* PART = (LAS float*)(lds + 8192);
    const LAS float* bias = (const LAS float*)(lds + XCH_OFF);
    const float* QS = WSP(float, WS_QS) + (size_t)su * AW;
    const int lo = h * 128 + 8 * sub;
#pragma unroll
    for (int g = 0; g < 3; ++g) {
        const int gsh = 2 * g; const float* cache = g == 0 ? P.in[4] : (g == 1 ? P.in[5] : P.in[6]); const float* knew = P.out + pg8::kvs_off(g);
        const f32x4 q0 = *(const f32x4*)(QS + (4 * g + h) * 128 + 8 * sub), q1 = *(const f32x4*)(QS + (4 * g + h) * 128 + 8 * sub + 4);
        f32x4 n0[NSB], n1[NSB];
#pragma unroll
        for (int u = 0; u < NSB; ++u) { const float* rp = sattn_row(cache, knew, b, t, gsh, w + 8 * u) + lo; n0[u] = *(const f32x4*)rp; n1[u] = *(const f32x4*)(rp + 4); }
#pragma unroll 1
        for (int j0 = w; j0 < 129; j0 += 8 * NSB) {
            f32x4 k0[NSB], k1[NSB];
#pragma unroll
            for (int u = 0; u < NSB; ++u) { k0[u] = n0[u]; k1[u] = n1[u]; }
            if (j0 + 8 * NSB < 129) {
#pragma unroll
                for (int u = 0; u < NSB; ++u) { const float* rp = sattn_row(cache, knew, b, t, gsh, j0 + 8 * NSB + 8 * u) + lo; n0[u] = *(const f32x4*)rp; n1[u] = *(const f32x4*)(rp + 4); } }
#pragma unroll
            for (int u = 0; u < NSB; ++u) { const int j = j0 + 8 * u;
                float d = (q0[0] * k0[u][0] + q0[1] * k0[u][1]) + (q0[2] * k0[u][2] + q0[3] * k0[u][3]) + (q1[0] * k1[u][0] + q1[1] * k1[u][1]) + (q1[2] * k1[u][2] + q1[3] * k1[u][3]);
                d += __shfl_xor(d, 1); d += __shfl_xor(d, 2); d += __shfl_xor(d, 4); d += __shfl_xor(d, 8);
                if (sub == 0 && j < 129) LG[h * 392 + g * 129 + j] = d + bias[(4 * g + h) * 132 + j]; } }
    }
    LDS_WAIT(); __syncthreads();
    float mxh = 0.f, invh = 0.f;
#pragma unroll
    for (int hd = 0; hd < 4; ++hd) { float m = -1e30f;
        for (int i = lane; i < 387; i += 64) m = fmaxf(m, LG[hd * 392 + i]);
        m = wave_max(m); float s = 0.f;
        for (int i = lane; i < 387; i += 64) s += fexp2(LG[hd * 392 + i] - m);
        s = wave_sum(s); if (hd == h) { mxh = m; invh = 1.0f / s; } }
    float acc[8];
#pragma unroll
    for (int i = 0; i < 8; ++i) acc[i] = 0.f;
#pragma unroll
    for (int g = 0; g < 3; ++g) {
        const int gsh = 2 * g; const float* cache = g == 0 ? P.in[4] : (g == 1 ? P.in[5] : P.in[6]); const float* knew = P.out + pg8::kvs_off(g);
        f32x4 n0[NSB], n1[NSB];
#pragma unroll
        for (int u = 0; u < NSB; ++u) { const float* rp = sattn_row(cache, knew, b, t, gsh, w + 8 * u) + 512 + lo; n0[u] = *(const f32x4*)rp; n1[u] = *(const f32x4*)(rp + 4); }
#pragma unroll 1
        for (int j0 = w; j0 < 129; j0 += 8 * NSB) {
            f32x4 v0[NSB], v1[NSB];
#pragma unroll
            for (int u = 0; u < NSB; ++u) { v0[u] = n0[u]; v1[u] = n1[u]; }
            if (j0 + 8 * NSB < 129) {
#pragma unroll
                for (int u = 0; u < NSB; ++u) { const float* rp = sattn_row(cache, knew, b, t, gsh, j0 + 8 * NSB + 8 * u) + 512 + lo; n0[u] = *(const f32x4*)rp; n1[u] = *(const f32x4*)(rp + 4); } }
#pragma unroll
            for (int u = 0; u < NSB; ++u) { const int j = j0 + 8 * u;
                const float p = (j < 129) ? fexp2(LG[h * 392 + g * 129 + (j < 129 ? j : 128)] - mxh) * invh : 0.f;
#pragma unroll
                for (int i = 0; i < 4; ++i) { acc[i] += p * v0[u][i]; acc[4 + i] += p * v1[u][i]; } } }
    }
#pragma unroll
    for (int i = 0; i < 8; ++i) PART[w * 512 + lane * 8 + i] = acc[i];
    LDS_WAIT(); __syncthreads();
    { float s = 0.f;
#pragma unroll
      for (int k = 0; k < 8; ++k) s += PART[k * 512 + tid];
      WSP(bf16, WS_ATT)[(size_t)(MP + su) * MW + tid] = (bf16)f2bf(s); }
    __syncthreads();
}

struct CombItem { v4u a, b, c; float l0, l1, l2; };
__device__ __forceinline__ void comb_load(const Ptrs& P, int it, CombItem& x) {
    const bf16* OG = WSP(bf16, WS_OG); const float* LSE = WSP(float, WS_LSE); const int R = it >> 6, ck = it & 63, h4 = ck >> 4;
    x.l0 = LSE[((size_t)0 * MP + R) * 4 + h4]; x.l1 = LSE[((size_t)1 * MP + R) * 4 + h4]; x.l2 = LSE[((size_t)2 * MP + R) * 4 + h4];
    x.a = *(const v4u*)(OG + ((size_t)0 * MP + R) * MW + ck * 8); x.b = *(const v4u*)(OG + ((size_t)1 * MP + R) * MW + ck * 8); x.c = *(const v4u*)(OG + ((size_t)2 * MP + R) * MW + ck * 8);
}
__device__ __forceinline__ void comb_finish(const Ptrs& P, int it, const CombItem& x) {
    const float mx = fmaxf(x.l0, fmaxf(x.l1, x.l2)); float w0 = fexp2(x.l0 - mx), w1 = fexp2(x.l1 - mx), w2 = fexp2(x.l2 - mx); const float inv = frcp(w0 + w1 + w2); w0 *= inv; w1 *= inv; w2 *= inv;
    v4u o;
    o.x = pk2(w0 * bflo(x.a.x) + w1 * bflo(x.b.x) + w2 * bflo(x.c.x), w0 * bfhi(x.a.x) + w1 * bfhi(x.b.x) + w2 * bfhi(x.c.x));
    o.y = pk2(w0 * bflo(x.a.y) + w1 * bflo(x.b.y) + w2 * bflo(x.c.y), w0 * bfhi(x.a.y) + w1 * bfhi(x.b.y) + w2 * bfhi(x.c.y));
    o.z = pk2(w0 * bflo(x.a.z) + w1 * bflo(x.b.z) + w2 * bflo(x.c.z), w0 * bfhi(x.a.z) + w1 * bfhi(x.b.z) + w2 * bfhi(x.c.z));
    o.w = pk2(w0 * bflo(x.a.w) + w1 * bflo(x.b.w) + w2 * bflo(x.c.w), w0 * bfhi(x.a.w) + w1 * bfhi(x.b.w) + w2 * bfhi(x.c.w));
    *(v4u*)(WSP(bf16, WS_ATT) + (size_t)(it >> 6) * MW + (it & 63) * 8) = o;
}
__device__ __forceinline__ int crow(int r, int hi) { return (r & 3) + 8 * (r >> 2) + 4 * hi; }
constexpr int TAB_HC = 4096, TAB_SA = 12288, TAB_SB = 20480;
template <bool OUT> __device__ __forceinline__ void lru_unit(const Ptrs& P, LAS unsigned char* lds, int b, int n, int rg, int tid, int lane, int w, int comb_base = -1) {
    LAS unsigned char* AIMG = lds;
    LAS float* XC32 = (LAS float*)(lds + 16384);
    LAS float* HST = (LAS float*)(lds + 49152);
    LAS float* SUM = (LAS float*)(lds + 81920);
    LAS float* WC = (LAS float*)(lds + 84992);
    const int ch0 = 64 * n, tb = w >> 1, cb = w & 1, cl = lane & 31, hi = lane >> 5, mych = ch0 + 32 * cb + cl;
    if (tid < 320) { const int k = tid >> 6, i = tid & 63; WC[tid] = (k < 4) ? P.in[15][k * 1024 + ch0 + i] : P.in[16][ch0 + i]; }
    const bf16* WRG = WSP(bf16, WS_WRG);
    bf16x8 Bfa[4], Bfi[4];
#pragma unroll
    for (int s = 0; s < 4; ++s) { Bfa[s] = *(const bf16x8*)(WRG + ((size_t)(n * 64 + 32 * cb + cl) * 64 + 16 * s + 8 * hi));
                                  Bfi[s] = *(const bf16x8*)(WRG + 65536 + ((size_t)(n * 64 + 32 * cb + cl) * 64 + 16 * s + 8 * hi)); }
    const float ba = P.in[18][mych] * -1.4426950408889634f, bi = P.in[20][mych] * -1.4426950408889634f, c8l = WSP(float, WS_TAB)[2048 + mych] * 1.4426950408889634f;
    float hstate = 0.f, astate = 1.f;
    if (OUT && rg >= 1) { const float* T = WSP(float, WS_TAB) + b * 1024 + mych; hstate = T[TAB_HC]; if (rg == 2) hstate = T[TAB_SA] * hstate + T[TAB_SB]; }
    const int nch = (rg == 0) ? 32 : 16;
    const int tl = tid >> 2, cg = tid & 3;
    const bf16* XB = WSP(bf16, WS_XB); const bf16* GY = WSP(bf16, WS_GY); bf16* HRG = WSP(bf16, WS_HRG);
    v4u xv[4][2];
    const int tbase = (rg == 0) ? 0 : (rg == 1 ? 4096 : 6144);
    { const int t0 = tbase;
#pragma unroll
      for (int k = 0; k < 4; ++k) { const int t = t0 + tl - 3 + k;
          if (t >= 0) { const v4u* p = (const v4u*)(XB + ((size_t)b * SEQ + t) * DM + ch0 + 16 * cg); xv[k][0] = p[0]; xv[k][1] = p[1]; }
          else { xv[k][0] = (v4u){0u, 0u, 0u, 0u}; xv[k][1] = (v4u){0u, 0u, 0u, 0u}; } } }
    LDS_WAIT(); __syncthreads();
    for (int ci = 0; ci < nch; ++ci) {
        const int t0 = tbase + ci * 128; const size_t R0 = (size_t)b * SEQ + t0;
        {
            float xc[16];
#pragma unroll
            for (int q = 0; q < 4; ++q) { const f32x4 bc = *(const LAS f32x4*)(WC + 256 + 16 * cg + 4 * q); xc[4 * q] = bc[0]; xc[4 * q + 1] = bc[1]; xc[4 * q + 2] = bc[2]; xc[4 * q + 3] = bc[3]; }
#pragma unroll
            for (int k = 0; k < 4; ++k)
#pragma unroll
                for (int q = 0; q < 4; ++q) { const f32x4 wv = *(const LAS f32x4*)(WC + 64 * k + 16 * cg + 4 * q);
                    const unsigned u0 = xv[k][q >> 1][(q & 1) * 2], u1 = xv[k][q >> 1][(q & 1) * 2 + 1];
                    xc[4 * q] += wv[0] * bflo(u0); xc[4 * q + 1] += wv[1] * bfhi(u0); xc[4 * q + 2] += wv[2] * bflo(u1); xc[4 * q + 3] += wv[3] * bfhi(u1); }
#pragma unroll
            for (int q = 0; q < 4; ++q) *(LAS f32x4*)(XC32 + tl * 64 + 4 * ((4 * cg + q) ^ (tl & 15))) = (f32x4){xc[4 * q], xc[4 * q + 1], xc[4 * q + 2], xc[4 * q + 3]};
#pragma unroll
            for (int e = 0; e < 2; ++e) { v4u o; o.x = pk2(xc[8 * e], xc[8 * e + 1]); o.y = pk2(xc[8 * e + 2], xc[8 * e + 3]); o.z = pk2(xc[8 * e + 4], xc[8 * e + 5]); o.w = pk2(xc[8 * e + 6], xc[8 * e + 7]);
                *(LAS v4u*)(AIMG + tl * 128 + 16 * ((2 * cg + e) ^ ((tl >> 1) & 7))) = o; }
        }
        v4u gy0, gy1;
        if (OUT) { const v4u* p = (const v4u*)(GY + (R0 + tl) * DM + ch0 + 16 * cg); gy0 = p[0]; gy1 = p[1]; }
        CombItem cb0, cb1; const int cit = (comb_base + ci) * 1024 + tid;
        if (OUT && comb_base >= 0) { comb_load(P, cit, cb0); comb_load(P, cit + 512, cb1); }
        if (ci + 1 < nch) {
#pragma unroll
            for (int k = 0; k < 4; ++k) { const v4u* p = (const v4u*)(XB + (R0 + 128 + tl - 3 + k) * DM + ch0 + 16 * cg); xv[k][0] = p[0]; xv[k][1] = p[1]; } }
        LDS_WAIT(); __builtin_amdgcn_s_barrier(); asm volatile("" ::: "memory");
        f32x16 za, zi;
#pragma unroll
        for (int i = 0; i < 16; ++i) { za[i] = 0.f; zi[i] = 0.f; }
        { const int row = 32 * tb + cl;
#pragma unroll
          for (int s = 0; s < 4; ++s) { const bf16x8 a = *(const LAS bf16x8*)(AIMG + row * 128 + 16 * ((2 * s + hi) ^ ((row >> 1) & 7)));
              za = __builtin_amdgcn_mfma_f32_32x32x16_bf16(a, Bfa[s], za, 0, 0, 0); zi = __builtin_amdgcn_mfma_f32_32x32x16_bf16(a, Bfi[s], zi, 0, 0, 0); } }
        float av[16], bv[16];
#pragma unroll
        for (int i = 0; i < 16; ++i) { const int tk_ = 32 * tb + crow(i, hi); const float xcv = XC32[tk_ * 64 + 4 * (((32 * cb + cl) >> 2) ^ (tk_ & 15)) + (cl & 3)];
            const float r = frcp(1.0f + fexp2(za[i] + ba)), ig = frcp(1.0f + fexp2(zi[i] + bi)); const float a = fexp2(c8l * r); av[i] = a; bv[i] = __builtin_amdgcn_sqrtf(fmaf(-a, a, 1.0f)) * (ig * xcv); }
        float As[4], Bs[4], pAs[4], pBs[4], preA[4], preB[4];
#pragma unroll
        for (int sg = 0; sg < 4; ++sg) { float A = 1.f, B = 0.f;
#pragma unroll
            for (int e = 0; e < 4; ++e) { B = av[4 * sg + e] * B + bv[4 * sg + e]; A = av[4 * sg + e] * A; }
            As[sg] = A; Bs[sg] = B; pAs[sg] = __shfl_xor(A, 32); pBs[sg] = __shfl_xor(B, 32); }
        float PA = 1.f, PB = 0.f;
#pragma unroll
        for (int sg = 0; sg < 4; ++sg) {
            const float fA = hi ? pAs[sg] : As[sg], fB = hi ? pBs[sg] : Bs[sg], sA = hi ? As[sg] : pAs[sg], sB = hi ? Bs[sg] : pBs[sg];
            const float PB1 = fA * PB + fB, PA1 = fA * PA;
            preA[sg] = hi ? PA1 : PA; preB[sg] = hi ? PB1 : PB;
            PB = sA * PB1 + sB; PA = sA * PA1; }
        if (hi == 0) { SUM[(tb * 64 + 32 * cb + cl) * 2] = PA; SUM[(tb * 64 + 32 * cb + cl) * 2 + 1] = PB; }
        LDS_WAIT(); __builtin_amdgcn_s_barrier(); asm volatile("" ::: "memory");
        float hin = hstate, hnew = hstate;
#pragma unroll
        for (int t = 0; t < 4; ++t) { const float A = SUM[(t * 64 + 32 * cb + cl) * 2], B = SUM[(t * 64 + 32 * cb + cl) * 2 + 1];
            hnew = A * hnew + B; if (t < tb) hin = hnew; if (!OUT) astate *= A; }
        hstate = hnew;
        if (OUT) {
#pragma unroll
            for (int sg = 0; sg < 4; ++sg) { float hc = preA[sg] * hin + preB[sg];
#pragma unroll
                for (int e = 0; e < 4; ++e) { hc = av[4 * sg + e] * hc + bv[4 * sg + e]; const int tk_ = 32 * tb + 8 * sg + 4 * hi + e; HST[tk_ * 64 + 4 * (((32 * cb + cl) >> 2) ^ (tk_ & 15)) + (cl & 3)] = hc; } }
            LDS_WAIT(); __builtin_amdgcn_s_barrier(); asm volatile("" ::: "memory");
            f32x4 hv[4];
#pragma unroll
            for (int q = 0; q < 4; ++q) hv[q] = *(const LAS f32x4*)(HST + tl * 64 + 4 * ((4 * cg + q) ^ (tl & 15)));
            v4u o0, o1;
            o0.x = pk2(hv[0][0] * bflo(gy0.x), hv[0][1] * bfhi(gy0.x)); o0.y = pk2(hv[0][2] * bflo(gy0.y), hv[0][3] * bfhi(gy0.y));
            o0.z = pk2(hv[1][0] * bflo(gy0.z), hv[1][1] * bfhi(gy0.z)); o0.w = pk2(hv[1][2] * bflo(gy0.w), hv[1][3] * bfhi(gy0.w));
            o1.x = pk2(hv[2][0] * bflo(gy1.x), hv[2][1] * bfhi(gy1.x)); o1.y = pk2(hv[2][2] * bflo(gy1.y), hv[2][3] * bfhi(gy1.y));
            o1.z = pk2(hv[3][0] * bflo(gy1.z), hv[3][1] * bfhi(gy1.z)); o1.w = pk2(hv[3][2] * bflo(gy1.w), hv[3][3] * bfhi(gy1.w));
            v4u* op = (v4u*)(HRG + (R0 + tl) * DM + ch0 + 16 * cg); op[0] = o0; op[1] = o1;
            if (comb_base >= 0) { comb_finish(P, cit, cb0); comb_finish(P, cit + 512, cb1); }
        }
    }
    if (tb == 0 && hi == 0) {
        float* T = WSP(float, WS_TAB) + b * 1024 + mych;
        if (!OUT) { T[TAB_SA] = astate; T[TAB_SB] = hstate; }
        else if (rg == 0) T[TAB_HC] = hstate;
        else if (rg == 2) P.out[pg8::O_LRUP + (size_t)b * 1024 + mych] = hstate;
    }
    __syncthreads();
}

__device__ __forceinline__ void lru_sample(const Ptrs& P, int gt) {
    const int b = __builtin_amdgcn_readfirstlane(gt >> 10), ch = gt & 1023, n = __builtin_amdgcn_readfirstlane(ch >> 6), o = ch & 63;
    const float* XBS = WSP(float, WS_XBS); const float* sc = P.in[7] + (size_t)b * 3 * 1024; const float* wcv = P.in[15]; const float* bcv = P.in[16];
    float za[4] = {0.f, 0.f, 0.f, 0.f}, zi[4] = {0.f, 0.f, 0.f, 0.f}, xo[4] = {0.f, 0.f, 0.f, 0.f};
    for (int i = 0; i < 64; ++i) { const int c = 64 * n + i;
        float xcat[7];
#pragma unroll
        for (int k = 0; k < 3; ++k) xcat[k] = sc[k * 1024 + c];
#pragma unroll
        for (int k = 0; k < 4; ++k) xcat[3 + k] = XBS[(size_t)(4 * b + k) * 1024 + c];
        const float w0 = wcv[c], w1 = wcv[1024 + c], w2 = wcv[2048 + c], w3 = wcv[3072 + c], bc = bcv[c];
        const float wa = P.in[17][(n * 64 + i) * 64 + o], wi = P.in[19][(n * 64 + i) * 64 + o];
#pragma unroll
        for (int t = 0; t < 4; ++t) { const float xc = bc + w0 * xcat[t] + w1 * xcat[t + 1] + w2 * xcat[t + 2] + w3 * xcat[t + 3];
            za[t] += xc * wa; zi[t] += xc * wi; xo[t] = (i == o) ? xc : xo[t]; } }
    const float ba = P.in[18][ch], bi = P.in[20][ch], c8l = WSP(float, WS_TAB)[2048 + ch] * 1.4426950408889634f;
    float h = P.in[8][(size_t)b * 1024 + ch];
    const bf16* GY = WSP(bf16, WS_GY); bf16* HRG = WSP(bf16, WS_HRG);
#pragma unroll
    for (int t = 0; t < 4; ++t) { const float r = sigm(za[t] + ba), ig = sigm(zi[t] + bi), a = fexp2(c8l * r);
        h = a * h + sqrtf(fmaxf(1.0f - a * a, 0.f)) * (ig * xo[t]);
        const size_t idx = (size_t)(MP + 4 * b + t) * DM + ch;
        HRG[idx] = (bf16)f2bf(h * __uint_as_float((unsigned)GY[idx] << 16)); }
    P.out[pg8::O_LRUS + (size_t)b * 1024 + ch] = h;
}

enum { SG_AMIX = 0, SG_MIX = 1, SG_X1 = 2, SG_UP = 3, SG_X2 = 4, SG_PE = 5, SG_Y = 6 };
constexpr size_t TAB_SSS1 = 32768, TAB_SSS2 = 40960;
template <int MODE, int N, int K> __device__ __forceinline__ void sgemm_tile(const Ptrs& P, LAS unsigned char* lds, int tile, const bf16* A, const bf16* Bt, int tid, int lane, int w) {
    constexpr int NTC = N / 64, NKS = K / 128;
    const int tr = tile / NTC, tc = tile % NTC, s0 = 32 * tr, c0 = 64 * tc;
    const int r = lane & 31, h = lane >> 5;
    const bf16* ap = A + (size_t)(MP + s0 + r) * K + w * (K / 8) + 8 * h;
    const bf16* bp0 = Bt + (size_t)(c0 + r) * K + w * (K / 8) + 8 * h; const bf16* bp1 = bp0 + (size_t)32 * K;
    f32x16 acc0, acc1;
#pragma unroll
    for (int i = 0; i < 16; ++i) { acc0[i] = 0.f; acc1[i] = 0.f; }
#pragma unroll 4
    for (int ks = 0; ks < NKS; ++ks) { const bf16x8 a = *(const bf16x8*)(ap + 16 * ks), b0 = *(const bf16x8*)(bp0 + 16 * ks), b1 = *(const bf16x8*)(bp1 + 16 * ks);
        acc0 = __builtin_amdgcn_mfma_f32_32x32x16_bf16(a, b0, acc0, 0, 0, 0); acc1 = __builtin_amdgcn_mfma_f32_32x32x16_bf16(a, b1, acc1, 0, 0, 0); }
    LAS float* PART = (LAS float*)lds;
#pragma unroll
    for (int i = 0; i < 16; ++i) { const int row = crow(i, h); PART[(w * 32 + row) * 64 + r] = acc0[i]; PART[(w * 32 + row) * 64 + 32 + r] = acc1[i]; }
    LDS_WAIT(); __syncthreads();
    const int row = tid >> 4, c4 = (tid & 15) * 4;
    f32x4 v = (f32x4){0.f, 0.f, 0.f, 0.f};
#pragma unroll
    for (int k = 0; k < 8; ++k) v += *(const LAS f32x4*)(PART + (k * 32 + row) * 64 + c4);
    const int s = s0 + row, col = c0 + c4; const size_t R = (size_t)MP + s; const size_t idx = R * DM + col;
    float* TAB = WSP(float, WS_TAB);
    if (MODE == SG_AMIX) { const v2u g = *(const v2u*)(WSP(bf16, WS_SGA) + idx); v2u o; o.x = pk2(bflo(g.x) * v[0], bfhi(g.x) * v[1]); o.y = pk2(bflo(g.y) * v[2], bfhi(g.y) * v[3]); *(v2u*)(WSP(bf16, WS_AMIX) + idx) = o; }
    else if (MODE == SG_MIX) { const v2u g = *(const v2u*)(WSP(bf16, WS_SGB) + idx), m = *(const v2u*)(WSP(bf16, WS_AMIX) + idx); v2u o;
        o.x = pk2(bflo(m.x) + bflo(g.x) * v[0], bfhi(m.x) + bfhi(g.x) * v[1]); o.y = pk2(bflo(m.y) + bflo(g.y) * v[2], bfhi(m.y) + bfhi(g.y) * v[3]); *(v2u*)(WSP(bf16, WS_MIX) + idx) = o; }
    else if (MODE == SG_X1 || MODE == SG_X2) { f32x4 x;
        if (MODE == SG_X1) x = *(const f32x4*)(P.in[1] + (size_t)s * DM + col); else { const v2u m = *(const v2u*)(WSP(bf16, WS_X1B) + idx); x = (f32x4){bflo(m.x), bfhi(m.x), bflo(m.y), bfhi(m.y)}; }
        const f32x4 y = x + v; v2u o; o.x = pk2(y[0], y[1]); o.y = pk2(y[2], y[3]); *(v2u*)(WSP(bf16, MODE == SG_X1 ? WS_X1B : WS_X2B) + idx) = o;
        float ss = (y[0] * y[0] + y[1] * y[1]) + (y[2] * y[2] + y[3] * y[3]); ss += __shfl_xor(ss, 1); ss += __shfl_xor(ss, 2); ss += __shfl_xor(ss, 4); ss += __shfl_xor(ss, 8);
        if ((tid & 15) == 0) TAB[(MODE == SG_X1 ? TAB_SSS1 : TAB_SSS2) + s * 16 + tc] = ss; }
    else if (MODE == SG_PE) { v2u o; o.x = pk2(v[0], v[1]); o.y = pk2(v[2], v[3]); *(v2u*)(WSP(bf16, WS_PEP) + idx) = o; }
    else { const f32x4* q = (const f32x4*)(TAB + (MODE == SG_UP ? TAB_SSS1 : TAB_SSS2) + s * 16); const f32x4 q0 = q[0], q1 = q[1], q2 = q[2], q3 = q[3];
        const float tot = ((q0[0] + q0[1]) + (q0[2] + q0[3])) + ((q1[0] + q1[1]) + (q1[2] + q1[3])) + ((q2[0] + q2[1]) + (q2[2] + q2[3])) + ((q3[0] + q3[1]) + (q3[2] + q3[3]));
        const float rs = 1.0f / sqrtf(tot * (1.0f / 1024.0f) + 1e-6f);
        if (MODE == SG_UP) { v2u o; float u0 = fmaxf(v[0] * rs, 0.f), u1 = fmaxf(v[1] * rs, 0.f), u2 = fmaxf(v[2] * rs, 0.f), u3 = fmaxf(v[3] * rs, 0.f);
            o.x = pk2(u0 * u0, u1 * u1); o.y = pk2(u2 * u2, u3 * u3); *(v2u*)(WSP(bf16, WS_U) + R * FF + col) = o; }
        else { const v2u m = *(const v2u*)(WSP(bf16, WS_X2B) + idx), pe = *(const v2u*)(WSP(bf16, WS_PEP) + idx);
            f32x4 y; y[0] = bflo(m.x) + sigm(v[0] * rs) * bflo(pe.x); y[1] = bfhi(m.x) + sigm(v[1] * rs) * bfhi(pe.x); y[2] = bflo(m.y) + sigm(v[2] * rs) * bflo(pe.y); y[3] = bfhi(m.y) + sigm(v[3] * rs) * bfhi(pe.y);
            *(f32x4*)(P.out + idx) = y; } }
    __syncthreads();
}
#if defined(PROBE_DUP)
#define MK_PROBE_BITS(s) ((s) & 24)
#else
#define MK_PROBE_BITS(s) 0
#endif
__device__ __forceinline__ int opq_s(int v) { v = __builtin_amdgcn_readfirstlane(v); asm volatile("" : "+s"(v)); return v; }
struct Args { const float* in[30]; float* out; unsigned char* ws; int ph_lo, ph_hi, li, sub; };
__global__ void __launch_bounds__(NWAVES * 64, 2) fwd_kernel(Args args) {
    extern __shared__ __attribute__((aligned(16))) unsigned char lds_raw[];
    LAS unsigned char* lds = (LAS unsigned char*)lds_raw;
    volatile LAS unsigned* MISC = (volatile LAS unsigned*)(lds + MISC_OFF);
    const int tid0 = threadIdx.x; const int wave0 = __builtin_amdgcn_readfirstlane(tid0 >> 6);
    const int G = gridDim.x, bx = blockIdx.x; const int vcu = (G % 8 == 0) ? (bx % 8) * (G / 8) + bx / 8 : bx;
    typedef __attribute__((address_space(4))) const Args* KArgs;
    KArgs ap0 = (KArgs)__builtin_amdgcn_kernarg_segment_ptr();
    gu32* ctl = (gu32*)(args.ws + WS_CTL);
    for (int u = tid0; u < 32; u += NWAVES * 64) MISC[u] = 0u;
    __syncthreads();
    XcdBarrier bar; bar.bar = (unsigned*)(ctl + CW_BAR) + args.li * XCD_BAR_WORDS; bar.x = 0; bar.st = nullptr;
    if (N_LAUNCHES != PER_PHASE) bar = xcd_barrier_post((unsigned*)(ctl + CW_BAR) + args.li * XCD_BAR_WORDS, MISC + 8);
#define GRID_BAR() do { if (N_LAUNCHES != PER_PHASE) xcd_barrier(bar); } while (0)
    const int lo = args.ph_lo, hi = args.ph_hi, sub = args.sub;
#ifndef PH_MASK
#define PH_MASK 0x1ff
#endif
#define IN(k) (((PH_MASK >> (k)) & 1) && lo <= (k) && (k) < hi)
#define BOTH(k) (IN(k) && IN((k) + 1))
    LAS float* XCH = (LAS float*)(lds + XCH_OFF);
    const int NT = G * NWAVES * 64;

#define LOAD_P() KArgs ap = ap0; asm volatile("" : "+s"(ap)); Ptrs P; _Pragma("unroll") for (int i_ = 0; i_ < 30; ++i_) P.in[i_] = ap->in[i_]; P.out = ap->out; P.ws = ap->ws
#define OPAQUE_TID2() int tid; asm volatile("v_mbcnt_lo_u32_b32 %0, -1, 0\n\tv_mbcnt_hi_u32_b32 %0, -1, %0" : "=v"(tid)); tid |= wave0 << 6; const int lane = tid & 63, wave = wave0
#define OPAQUE_TID() LOAD_P(); int tid; asm volatile("v_mbcnt_lo_u32_b32 %0, -1, 0\n\tv_mbcnt_hi_u32_b32 %0, -1, %0" : "=v"(tid)); tid |= wave0 << 6; const int lane = tid & 63, wave = wave0; const int gt = vcu * (NWAVES * 64) + tid
    if (IN(0)) { OPAQUE_TID(); p0_prologue(P, lds, tid, lane, wave, vcu, G); if (BOTH(0)) GRID_BAR(); }

    if (IN(1)) {
        LOAD_P();
        pg8::Gemm g{WSP(pg8::bf16_t, WS_HB), WSP(pg8::bf16_t, WS_WIN), M, NIN, DM}; pg8::StaticOrder S; S.init(M, NIN, G, opq_s(blockIdx.x));
        LAS float* GL = (LAS float*)(lds + MISC_OFF + 1024);
        { OPAQUE_TID2(); (void)lane; (void)wave; if (tid < 256) GL[tid] = (tid < 128) ? P.in[12][tid] : P.in[13][tid - 128]; LDS_WAIT(); __syncthreads(); }
        pg8::Epi1 E{P.ws, P.out, GL, XCH, MK_PROBE_BITS(sub)};
        pg8::gemm_phase<pg8::Epi1, pg8::StaticOrder, true, true>(lds + RING_OFF, g, S, E, wave0);
        if (BOTH(1)) GRID_BAR();
    }

    if (IN(2)) {
        OPAQUE_TID();
        { const float* TAB = WSP(float, WS_TAB); for (int e = tid; e < 12 * 132; e += NWAVES * 64) XCH[e] = TAB[e]; }
        LDS_WAIT(); __syncthreads();
#define TASK_LOOP(QI, NTASK, BODY) { gu32* qw = ctl + CW_Q + 64 * (4 * args.li + (QI)); volatile LAS unsigned* QT = MISC + 16; unsigned nxt = 0u; \
          if (tid == 0) nxt = __hip_atomic_fetch_add(qw, 1u, RLX_AGENT); \
          for (;;) { if (tid == 0) QT[0] = nxt; LDS_WAIT(); __syncthreads(); const int task = (int)__builtin_amdgcn_readfirstlane(QT[0]); __syncthreads(); if (task >= (NTASK)) break; \
              if (tid == 0) nxt = __hip_atomic_fetch_add(qw, 1u, RLX_AGENT); BODY } }
        if (sub & 1) TASK_LOOP(0, 128, lru_unit<true>(P, lds, task >> 4, task & 15, 0, tid, lane, wave);)
        if (sub & 1) TASK_LOOP(3, 128, lru_unit<false>(P, lds, task >> 4, task & 15, 1, tid, lane, wave);)
        if (sub & 2) TASK_LOOP(1, 512, sattn_unit(P, lds, task, tid, lane, wave);)
        if (sub & 4) TASK_LOOP(2, 1536, attn_run(P, lds, 4 * task, 4, tid, lane, wave);)
#undef TASK_LOOP
        if (BOTH(2)) GRID_BAR();
    }

    if (IN(3)) {
        OPAQUE_TID();
        if (sub & 1) for (int u = vcu; u < 256; u += G) lru_unit<true>(P, lds, u >> 5, (u >> 1) & 15, 1 + (u & 1), tid, lane, wave, 16 * u);
        if (sub & 2) for (int t = gt; t < DBATCH * 1024; t += NT) lru_sample(P, t);
        if (BOTH(3)) GRID_BAR();
    }

    if (IN(4)) {
        LOAD_P();
        { OPAQUE_TID2();
          for (int t = vcu; t < 256; t += G) sgemm_tile<SG_AMIX, DM, MW>(P, lds, t, WSP(bf16, WS_ATT), WSP(bf16, WS_WOA), tid, lane, wave);
          for (int t = vcu; t < 256; t += G) sgemm_tile<SG_MIX, DM, DM>(P, lds, t, WSP(bf16, WS_HRG), WSP(bf16, WS_WOB), tid, lane, wave); }
        { pg8::Gemm g{WSP(pg8::bf16_t, WS_ATT), WSP(pg8::bf16_t, WS_WOA), MP, DM, MW}; pg8::StaticOrder S; S.init(MP, DM, G, opq_s(blockIdx.x));
          pg8::Epi2<pg8::E_AMIX> E{WSP(pg8::bf16_t, WS_SGA), nullptr, WSP(pg8::bf16_t, WS_AMIX), nullptr, nullptr, nullptr, nullptr, nullptr, XCH, 0};
          pg8::gemm_phase<pg8::Epi2<pg8::E_AMIX>, pg8::StaticOrder, true, true>(lds + RING_OFF, g, S, E, wave0); }
        VM_WAIT(); __syncthreads();
        { pg8::Gemm g{WSP(pg8::bf16_t, WS_HRG), WSP(pg8::bf16_t, WS_WOB), MP, DM, DM}; pg8::StaticOrder S; S.init(MP, DM, G, opq_s(blockIdx.x));
          pg8::Epi2<pg8::E_MIX> E{WSP(pg8::bf16_t, WS_SGB), WSP(pg8::bf16_t, WS_AMIX), WSP(pg8::bf16_t, WS_MIX), nullptr, nullptr, nullptr, nullptr, nullptr, XCH, 0};
          pg8::gemm_phase<pg8::Epi2<pg8::E_MIX>, pg8::StaticOrder, true, true>(lds + RING_OFF, g, S, E, wave0); }
        if (BOTH(4)) GRID_BAR();
    }

    if (IN(5)) {
        LOAD_P();
        { OPAQUE_TID2(); for (int t = vcu; t < 256; t += G) sgemm_tile<SG_X1, DM, DM>(P, lds, t, WSP(bf16, WS_MIX), WSP(bf16, WS_WO), tid, lane, wave); }
        pg8::Gemm g{WSP(pg8::bf16_t, WS_MIX), WSP(pg8::bf16_t, WS_WO), MP, DM, DM}; pg8::StaticOrder S; S.init(MP, DM, G, opq_s(blockIdx.x));
        pg8::Epi2<pg8::E_X1> E{nullptr, nullptr, WSP(pg8::bf16_t, WS_X1B), nullptr, P.in[0], P.in[1], WSP(float, WS_SS1), nullptr, XCH, 0};
        pg8::gemm_phase<pg8::Epi2<pg8::E_X1>, pg8::StaticOrder, true, true>(lds + RING_OFF, g, S, E, wave0);
        if (BOTH(5)) GRID_BAR();
    }

    if (IN(6)) {
        LOAD_P();
        { OPAQUE_TID2(); for (int t = vcu; t < 1024; t += G) sgemm_tile<SG_UP, FF, DM>(P, lds, t, WSP(bf16, WS_X1B), WSP(bf16, WS_WUP), tid, lane, wave); }
        pg8::Gemm g{WSP(pg8::bf16_t, WS_X1B), WSP(pg8::bf16_t, WS_WUP), MP, FF, DM}; pg8::StaticOrder S; S.init(MP, FF, G, opq_s(blockIdx.x));
        pg8::Epi2<pg8::E_UP> E{nullptr, nullptr, WSP(pg8::bf16_t, WS_U), nullptr, nullptr, nullptr, nullptr, WSP(float, WS_SS1), XCH, MK_PROBE_BITS(sub)};
        pg8::gemm_phase<pg8::Epi2<pg8::E_UP>, pg8::StaticOrder, true, true>(lds + RING_OFF, g, S, E, wave0);
        if (BOTH(6)) GRID_BAR();
    }

    if (IN(7)) {
        LOAD_P();
        { OPAQUE_TID2(); for (int t = vcu; t < 256; t += G) sgemm_tile<SG_X2, DM, FF>(P, lds, t, WSP(bf16, WS_U), WSP(bf16, WS_WDN), tid, lane, wave); }
        pg8::Gemm g{WSP(pg8::bf16_t, WS_U), WSP(pg8::bf16_t, WS_WDN), MP, DM, FF}; pg8::StaticOrder S; S.init(MP, DM, G, opq_s(blockIdx.x));
        pg8::Epi2<pg8::E_X2> E{WSP(pg8::bf16_t, WS_X1B), nullptr, WSP(pg8::bf16_t, WS_X2B), nullptr, nullptr, nullptr, WSP(float, WS_SS2), nullptr, XCH, 0};
        pg8::gemm_phase<pg8::Epi2<pg8::E_X2>, pg8::StaticOrder, true, true>(lds + RING_OFF, g, S, E, wave0);
        if (BOTH(7)) GRID_BAR();
    }

    if (IN(8)) {
        LOAD_P();
        { OPAQUE_TID2();
          for (int t = vcu; t < 256; t += G) sgemm_tile<SG_PE, DM, PLE>(P, lds, t, WSP(bf16, WS_PB), WSP(bf16, WS_WPE), tid, lane, wave);
          for (int t = vcu; t < 256; t += G) sgemm_tile<SG_Y, DM, DM>(P, lds, t, WSP(bf16, WS_X2B), WSP(bf16, WS_WPG), tid, lane, wave); }
        { pg8::Gemm g{WSP(pg8::bf16_t, WS_PB), WSP(pg8::bf16_t, WS_WPE), MP, DM, PLE}; pg8::StaticOrder S; S.init(MP, DM, G, opq_s(blockIdx.x));
          pg8::Epi2<pg8::E_PE> E{nullptr, nullptr, WSP(pg8::bf16_t, WS_PEP), nullptr, nullptr, nullptr, nullptr, nullptr, XCH, 0};
          pg8::gemm_phase<pg8::Epi2<pg8::E_PE>, pg8::StaticOrder, true, true>(lds + RING_OFF, g, S, E, wave0); }
        VM_WAIT(); __syncthreads();
        { pg8::Gemm g{WSP(pg8::bf16_t, WS_X2B), WSP(pg8::bf16_t, WS_WPG), MP, DM, DM}; pg8::StaticOrder S; S.init(MP, DM, G, opq_s(blockIdx.x));
          pg8::Epi2<pg8::E_Y> E{WSP(pg8::bf16_t, WS_PEP), WSP(pg8::bf16_t, WS_X2B), nullptr, P.out, nullptr, nullptr, nullptr, WSP(float, WS_SS2), XCH, 0};
          pg8::gemm_phase<pg8::Epi2<pg8::E_Y>, pg8::StaticOrder, true, true>(lds + RING_OFF, g, S, E, wave0); }
    }
#undef IN
#undef BOTH
#undef GRID_BAR
}

extern "C" void kernel_launch(void* const* d_in, const int* in_sizes, int n_in, void* d_out, int out_size, void* d_ws, size_t ws_size, hipStream_t stream) {
    static int grid = 0;
    if (grid == 0) {
        if (n_in != 30 || in_sizes[0] != MP * DM || out_size != (int)pg8::O_END || ws_size < WS_END) {
            fprintf(stderr, "kernel_launch: unexpected shapes (n_in %d, in0 %d, out %d, ws %zu, need %zu); nothing launched\n", n_in, n_in > 0 ? in_sizes[0] : -1, out_size, ws_size, (size_t)WS_END); grid = -1; return; }
        int dev = 0, cus = 0, per_cu = 0;
        if (hipGetDevice(&dev) != hipSuccess || hipDeviceGetAttribute(&cus, hipDeviceAttributeMultiprocessorCount, dev) != hipSuccess) { grid = -1; return; }
        if (hipFuncSetAttribute((const void*)fwd_kernel, hipFuncAttributeMaxDynamicSharedMemorySize, LDS_BYTES) != hipSuccess) { fprintf(stderr, "kernel_launch: hipFuncSetAttribute failed\n"); grid = -1; return; }
        if (hipOccupancyMaxActiveBlocksPerMultiprocessor(&per_cu, (const void*)fwd_kernel, NWAVES * 64, LDS_BYTES) != hipSuccess || per_cu < 1)
            fprintf(stderr, "kernel_launch: note: occupancy query reports %d workgroups per CU\n", per_cu);
        (void)hipGetLastError();
        grid = cus;
    }
    if (grid < 0) return;
    if (hipMemsetAsync((char*)d_ws + WS_CTL, 0, CTL_ZERO_BYTES, stream) != hipSuccess) { fprintf(stderr, "kernel_launch: hipMemsetAsync failed\n"); return; }
    Args a{};
    for (int i = 0; i < 30; ++i) a.in[i] = (const float*)d_in[i];
    a.out = (float*)d_out; a.ws = (unsigned char*)d_ws;
#if defined(PROBE_DUP)
    const int cut[4] = {0, PROBE_DUP + 1, PROBE_DUP + 1, PER_PHASE};
    for (int li = 0; li < 3; ++li) {
        a.ph_lo = (li == 1) ? PROBE_DUP : cut[li]; a.ph_hi = (li == 1) ? PROBE_DUP + 1 : cut[li + 1]; a.li = li; a.sub = (li == 1) ? PROBE_SUB : 7;
        if (a.ph_lo >= a.ph_hi) continue;
        hipLaunchKernelGGL(fwd_kernel, dim3(grid), dim3(NWAVES * 64), LDS_BYTES, stream, a);
    }
#else
    for (int li = 0; li < N_LAUNCHES; ++li) {
        a.ph_lo = (N_LAUNCHES == PER_PHASE) ? li : 0; a.ph_hi = (N_LAUNCHES == PER_PHASE) ? li + 1 : PER_PHASE; a.li = (N_LAUNCHES == PER_PHASE) ? 0 : li; a.sub = 7;
        hipLaunchKernelGGL(fwd_kernel, dim3(grid), dim3(NWAVES * 64), LDS_BYTES, stream, a);
        const hipError_t le = hipPeekAtLastError();
        if (le != hipSuccess) { fprintf(stderr, "kernel_launch: launch %d failed: %s\n", li, hipGetErrorName(le)); break; }
    }
#endif
}
```
